# Optimizing an MI355X kernel written in HIP

```python
import jax
import jax.numpy as jnp
from jax import lax
import numpy as np

D_MODEL = 1024
BATCH = 16
SEQ = 2048
DEPTH = 4

GRID_W = 64
CTX_LEN = 256
N_MIXERS = 3
N_ATTN_LAYERS = (DEPTH + 2) // 3
N_CONV_LAYERS = (DEPTH + 1) // 3
N_NAT_LAYERS = DEPTH // 3

A_HEAD_DIM = 64
A_HEADS = D_MODEL // A_HEAD_DIM
A_KV_HEADS = A_HEADS // 4
A_GROUP = A_HEADS // A_KV_HEADS
A_Q = A_HEADS * A_HEAD_DIM
A_KV = A_KV_HEADS * A_HEAD_DIM
A_WINDOW = 128
A_BLOCK = 128
ROPE_BASE = 10000.0
CONV_WIDTH = 3
NA_HEAD_DIM = 64
NA_HEADS = D_MODEL // NA_HEAD_DIM
NA_KH_MAX = 8
NA_KW = 16
N_GROUPS = 4
EXPERTS_PER_GROUP = 8
N_EXPERTS = N_GROUPS * EXPERTS_PER_GROUP
TOP_K = 2
EXPERT_FF = D_MODEL // 2
MOE_BLOCK = 128
ALPHA = (2 * DEPTH) ** 0.25
BETA = (8 * DEPTH) ** -0.25
LN_EPS = 1e-5
NEG_INF = -1e30

kernel_name = 'hybrid_dit_window_conv_nat_hmoe'


def layer_norm(x, g, b):
    xf = x.astype(jnp.float32)
    mu = jnp.mean(xf, axis=-1, keepdims=True)
    var = jnp.mean(jnp.square(xf - mu), axis=-1, keepdims=True)
    return ((xf - mu) * lax.rsqrt(var + LN_EPS) * g + b).astype(x.dtype)


def modulate(x, shift, scale):
    return x * (1.0 + scale) + shift


def axial_rope(x, rows, cols):
    half = x.shape[-1] // 2
    quarter = half // 2
    inv_freq = ROPE_BASE ** (-jnp.arange(quarter, dtype=jnp.float32) / quarter)

    def rotate(xp, pos):
        ang = pos.astype(jnp.float32)[:, None] * inv_freq
        cos = jnp.cos(ang)[None, :, None, :]
        sin = jnp.sin(ang)[None, :, None, :]
        x1 = xp[..., :quarter].astype(jnp.float32)
        x2 = xp[..., quarter:].astype(jnp.float32)
        return jnp.concatenate([x1 * cos - x2 * sin, x1 * sin + x2 * cos], axis=-1)

    out = jnp.concatenate([rotate(x[..., :half], rows), rotate(x[..., half:], cols)], axis=-1)
    return out.astype(x.dtype)


def sink_softmax(s, sink):
    sk = jnp.broadcast_to(sink, s.shape[:-1] + (1,))
    p = jax.nn.softmax(jnp.concatenate([s, sk], axis=-1), axis=-1)
    return p[..., :-1]


def windowed_gqa(h_lat, h_ctx, w_qkv, w_o, sink, with_ctx_out):
    B, S, _ = h_lat.shape
    L = h_ctx.shape[1]
    nb = S // A_BLOCK
    span = 3 * A_BLOCK
    scale = A_HEAD_DIM ** -0.5

    def split_qkv(h):
        qkv = h @ w_qkv
        n = h.shape[1]
        q = qkv[..., :A_Q].reshape(B, n, A_HEADS, A_HEAD_DIM)
        k = qkv[..., A_Q:A_Q + A_KV].reshape(B, n, A_KV_HEADS, A_HEAD_DIM)
        v = qkv[..., A_Q + A_KV:].reshape(B, n, A_KV_HEADS, A_HEAD_DIM)
        return q, k, v

    q, k, v = split_qkv(h_lat)
    qc, kc, vc = split_qkv(h_ctx)
    t = jnp.arange(S)
    q = axial_rope(q, t // GRID_W, t % GRID_W)
    k = axial_rope(k, t // GRID_W, t % GRID_W)
    sink_f = sink.astype(jnp.float32).reshape(A_KV_HEADS, A_GROUP, 1, 1)

    pad = ((0, 0), (A_BLOCK, A_BLOCK), (0, 0), (0, 0))
    kp = jnp.pad(k, pad)
    vp = jnp.pad(v, pad)
    qb = q.reshape(B, nb, A_BLOCK, A_KV_HEADS, A_GROUP, A_HEAD_DIM).transpose(1, 0, 2, 3, 4, 5)
    rel = jnp.arange(span)[None, :] - A_BLOCK - jnp.arange(A_BLOCK)[:, None]
    band = jnp.abs(rel) <= A_WINDOW
    ctx_ok = jnp.ones((A_BLOCK, L), dtype=bool)

    def block(args):
        b, qi = args
        kb = lax.dynamic_slice_in_dim(kp, b * A_BLOCK, span, axis=1)
        vb = lax.dynamic_slice_in_dim(vp, b * A_BLOCK, span, axis=1)
        kpos = b * A_BLOCK - A_BLOCK + jnp.arange(span)
        valid = band & ((kpos >= 0) & (kpos < S))[None, :]
        mask = jnp.concatenate([valid, ctx_ok], axis=1)
        k_all = jnp.concatenate([kb, kc], axis=1)
        v_all = jnp.concatenate([vb, vc], axis=1)
        s = jnp.einsum('bqkgd,bskd->bkgqs', qi, k_all).astype(jnp.float32) * scale
        p = sink_softmax(jnp.where(mask, s, NEG_INF), sink_f)
        return jnp.einsum('bkgqs,bskd->bqkgd', p.astype(v_all.dtype), v_all)

    o = lax.map(block, (jnp.arange(nb), qb))
    o_lat = o.transpose(1, 0, 2, 3, 4, 5).reshape(B, S, A_Q) @ w_o
    if not with_ctx_out:
        return o_lat, None
    qcg = qc.reshape(B, L, A_KV_HEADS, A_GROUP, A_HEAD_DIM)
    s = jnp.einsum('blkgd,bmkd->bkglm', qcg, kc).astype(jnp.float32) * scale
    p = sink_softmax(s, sink_f)
    o_ctx = jnp.einsum('bkglm,bmkd->blkgd', p.astype(vc.dtype), vc).reshape(B, L, A_Q) @ w_o
    return o_lat, o_ctx


def depthwise_conv(u, w):
    return lax.conv_general_dilated(
        u, w[:, None, :].astype(u.dtype), window_strides=(1,),
        padding=[(CONV_WIDTH // 2, CONV_WIDTH // 2)],
        dimension_numbers=('NWC', 'WIO', 'NWC'), feature_group_count=u.shape[-1])


def gated_short_conv(h_lat, h_ctx, w_in, conv_w, w_out, with_ctx_out):
    def run(h):
        gb, gc, u = jnp.split(h @ w_in, 3, axis=-1)
        return (gb * depthwise_conv(gc * u, conv_w)) @ w_out
    return run(h_lat), (run(h_ctx) if with_ctx_out else None)


def neighbourhood_attention(h_lat, h_ctx, w_qkv, w_o, rpb, with_ctx_out):
    B, S, _ = h_lat.shape
    L = h_ctx.shape[1]
    rows = S // GRID_W
    kh = min(NA_KH_MAX, rows)
    ncb = GRID_W // NA_KW
    span = 2 * NA_KW
    scale = NA_HEAD_DIM ** -0.5

    def split_qkv(h):
        q, k, v = jnp.split(h @ w_qkv, 3, axis=-1)
        shp = (B, h.shape[1], NA_HEADS, NA_HEAD_DIM)
        return q.reshape(shp), k.reshape(shp), v.reshape(shp)

    q, k, v = split_qkv(h_lat)
    qc, kc, vc = split_qkv(h_ctx)
    grid = (B, rows, GRID_W, NA_HEADS, NA_HEAD_DIM)
    qg = jnp.moveaxis(q.reshape(grid), 1, 0)
    kg = k.reshape(grid)
    vg = v.reshape(grid)

    cb = jnp.arange(ncb)
    key_cols = jnp.clip(cb * NA_KW - NA_KW // 2, 0, GRID_W - span)[:, None] + jnp.arange(span)
    q_cols = cb[:, None] * NA_KW + jnp.arange(NA_KW)
    q_start = jnp.clip(q_cols - NA_KW // 2, 0, GRID_W - NA_KW)
    col_ok = (key_cols[:, None, :] >= q_start[:, :, None]) & (key_cols[:, None, :] < q_start[:, :, None] + NA_KW)
    loc_mask = jnp.broadcast_to(col_ok[:, None, :, None, :], (ncb, 1, NA_KW, kh, span)).reshape(ncb, 1, NA_KW, kh * span)
    dc_idx = jnp.clip(key_cols[:, None, :] - q_cols[:, :, None] + NA_KW - 1, 0, 2 * NA_KW - 2)
    rpb_f = rpb.astype(jnp.float32)

    def row_step(args):
        r, q_row = args
        rs = jnp.clip(r - kh // 2, 0, rows - kh)

        def gather(t):
            t_rows = lax.dynamic_slice_in_dim(t, rs, kh, axis=1)
            t_blk = t_rows[:, :, key_cols]
            return t_blk.transpose(0, 2, 1, 3, 4, 5).reshape(B, ncb, kh * span, NA_HEADS, NA_HEAD_DIM)

        kb = gather(kg)
        vb = gather(vg)
        qb = q_row.reshape(B, ncb, NA_KW, NA_HEADS, NA_HEAD_DIM)
        dr_idx = rs + jnp.arange(kh) - r + NA_KH_MAX - 1
        bias = rpb_f[:, dr_idx][:, :, dc_idx]
        bias = bias.transpose(2, 0, 3, 1, 4).reshape(ncb, NA_HEADS, NA_KW, kh * span)
        s_loc = jnp.einsum('bnqhd,bnkhd->bnhqk', qb, kb).astype(jnp.float32) * scale + bias
        s_ctx = jnp.einsum('bnqhd,bmhd->bnhqm', qb, kc).astype(jnp.float32) * scale
        s = jnp.concatenate([jnp.where(loc_mask, s_loc, NEG_INF), s_ctx], axis=-1)
        p = jax.nn.softmax(s, axis=-1).astype(vb.dtype)
        o = (jnp.einsum('bnhqk,bnkhd->bnqhd', p[..., :kh * span], vb)
             + jnp.einsum('bnhqm,bmhd->bnqhd', p[..., kh * span:], vc))
        return o.reshape(B, GRID_W, NA_HEADS * NA_HEAD_DIM)

    o = lax.map(row_step, (jnp.arange(rows), qg))
    o_lat = jnp.moveaxis(o, 0, 1).reshape(B, S, D_MODEL) @ w_o
    if not with_ctx_out:
        return o_lat, None
    s = jnp.einsum('blhd,bmhd->bhlm', qc, kc).astype(jnp.float32) * scale
    p = jax.nn.softmax(s, axis=-1).astype(vc.dtype)
    o_ctx = jnp.einsum('bhlm,bmhd->blhd', p, vc).reshape(B, L, D_MODEL) @ w_o
    return o_lat, o_ctx


def hier_moe(h, w_group, b_group, w_expert, b_expert, w_gate, w_up, w_down):
    T, D = h.shape
    g_logits = (h @ w_group).astype(jnp.float32) + b_group.astype(jnp.float32)
    g_idx = jnp.argmax(g_logits, axis=-1)
    g_prob = jnp.take_along_axis(jax.nn.softmax(g_logits, axis=-1), g_idx[:, None], axis=-1)
    e_logits = ((h @ w_expert).astype(jnp.float32) + b_expert.astype(jnp.float32)).reshape(T, N_GROUPS, EXPERTS_PER_GROUP)
    e_logits = jnp.take_along_axis(e_logits, g_idx[:, None, None], axis=1)[:, 0]
    top_v, top_i = lax.top_k(e_logits, TOP_K)
    gates = (jax.nn.softmax(top_v, axis=-1) * g_prob).reshape(-1)
    eid = (g_idx[:, None] * EXPERTS_PER_GROUP + top_i).reshape(-1)
    tok = jnp.repeat(jnp.arange(T), TOP_K)
    n_assign = T * TOP_K

    order = jnp.argsort(eid)
    s_eid, s_tok, s_gate = eid[order], tok[order], gates[order]
    counts = jnp.bincount(eid, length=N_EXPERTS)
    pcounts = (counts + MOE_BLOCK - 1) // MOE_BLOCK * MOE_BLOCK
    offs = jnp.cumsum(counts) - counts
    pend = jnp.cumsum(pcounts)
    poffs = pend - pcounts
    dest = poffs[s_eid] + jnp.arange(n_assign) - offs[s_eid]
    n_blocks = -(-n_assign // MOE_BLOCK) + N_EXPERTS
    xs = jnp.zeros((n_blocks * MOE_BLOCK, D), h.dtype).at[dest].set(h[s_tok])
    blk_e = jnp.minimum(jnp.searchsorted(pend, jnp.arange(n_blocks) * MOE_BLOCK, side='right'), N_EXPERTS - 1)

    def expert_block(args):
        xb, e = args
        return (jax.nn.silu(xb @ w_gate[e]) * (xb @ w_up[e])) @ w_down[e]

    ys = lax.map(expert_block, (xs.reshape(n_blocks, MOE_BLOCK, D), blk_e)).reshape(n_blocks * MOE_BLOCK, D)
    return jax.ops.segment_sum(ys[dest] * s_gate[:, None].astype(ys.dtype), s_tok, num_segments=T)


def setup_inputs(seed: int = 0) -> dict:
    key = jax.random.key(seed)
    ks = iter(jax.random.split(key, 32))

    def nrm(shape, scale):
        return scale * jax.random.normal(next(ks), shape, jnp.float32)

    D = D_MODEL
    inv = D ** -0.5
    a_col = jnp.concatenate([jnp.ones((A_Q + A_KV,), jnp.float32), jnp.full((A_KV,), BETA, jnp.float32)])
    n_col = jnp.concatenate([jnp.ones((2 * D,), jnp.float32), jnp.full((D,), BETA, jnp.float32)])
    return {
        'x': nrm((BATCH, SEQ, D), 1.0),
        'c': nrm((BATCH, D), 1.0),
        'ctx': nrm((BATCH, CTX_LEN, D), 1.0),
        'c_ctx': nrm((D,), 1.0),
        'w_ada': nrm((DEPTH, D, 6 * D), 0.5 * inv),
        'b_ada': nrm((DEPTH, 6 * D), 0.02),
        'ln1_g': 1.0 + nrm((DEPTH, D), 0.02),
        'ln1_b': nrm((DEPTH, D), 0.02),
        'ln2_g': 1.0 + nrm((DEPTH, D), 0.02),
        'ln2_b': nrm((DEPTH, D), 0.02),
        'attn_w_qkv': nrm((N_ATTN_LAYERS, D, A_Q + 2 * A_KV), inv) * a_col,
        'attn_w_o': nrm((N_ATTN_LAYERS, A_Q, D), BETA * A_Q ** -0.5),
        'attn_sink': nrm((N_ATTN_LAYERS, A_HEADS), 0.5),
        'conv_w_in': nrm((N_CONV_LAYERS, D, 3 * D), inv),
        'conv_w': nrm((N_CONV_LAYERS, CONV_WIDTH, D), CONV_WIDTH ** -0.5),
        'conv_w_out': nrm((N_CONV_LAYERS, D, D), BETA * inv),
        'nat_w_qkv': nrm((N_NAT_LAYERS, D, 3 * D), inv) * n_col,
        'nat_w_o': nrm((N_NAT_LAYERS, D, D), BETA * inv),
        'nat_rpb': nrm((N_NAT_LAYERS, NA_HEADS, 2 * NA_KH_MAX - 1, 2 * NA_KW - 1), 0.1),
        'router_w_group': nrm((DEPTH, D, N_GROUPS), inv),
        'router_b_group': nrm((DEPTH, N_GROUPS), 0.01),
        'router_w_expert': nrm((DEPTH, D, N_EXPERTS), inv),
        'router_b_expert': nrm((DEPTH, N_EXPERTS), 0.01),
        'expert_w_gate': nrm((DEPTH, N_EXPERTS, D, EXPERT_FF), inv),
        'expert_w_up': nrm((DEPTH, N_EXPERTS, D, EXPERT_FF), inv),
        'expert_w_down': nrm((DEPTH, N_EXPERTS, EXPERT_FF, D), BETA * EXPERT_FF ** -0.5),
    }


def reference(x, c, ctx, c_ctx, w_ada, b_ada, ln1_g, ln1_b, ln2_g, ln2_b,
              attn_w_qkv, attn_w_o, attn_sink, conv_w_in, conv_w, conv_w_out,
              nat_w_qkv, nat_w_o, nat_rpb,
              router_w_group, router_b_group, router_w_expert, router_b_expert,
              expert_w_gate, expert_w_up, expert_w_down):
    B, S, D = x.shape
    xc = ctx
    silu_c = jax.nn.silu(c)
    silu_cc = jax.nn.silu(c_ctx)
    for i in range(DEPTH):
        last = i == DEPTH - 1
        j = i // N_MIXERS
        kind = i % N_MIXERS
        mod_lat = jnp.split((silu_c @ w_ada[i] + b_ada[i])[:, None, :], 6, axis=-1)
        mod_ctx = jnp.split(silu_cc @ w_ada[i] + b_ada[i], 6, axis=-1)

        h_lat = modulate(x, mod_lat[0], mod_lat[1])
        h_ctx = modulate(xc, mod_ctx[0], mod_ctx[1])
        if kind == 0:
            o_lat, o_ctx = windowed_gqa(h_lat, h_ctx, attn_w_qkv[j], attn_w_o[j], attn_sink[j], not last)
        elif kind == 1:
            o_lat, o_ctx = gated_short_conv(h_lat, h_ctx, conv_w_in[j], conv_w[j], conv_w_out[j], not last)
        else:
            o_lat, o_ctx = neighbourhood_attention(h_lat, h_ctx, nat_w_qkv[j], nat_w_o[j], nat_rpb[j], not last)
        x = layer_norm(ALPHA * x + mod_lat[2] * o_lat, ln1_g[i], ln1_b[i])

        h_lat = modulate(x, mod_lat[3], mod_lat[4]).reshape(B * S, D)
        moe_args = (router_w_group[i], router_b_group[i], router_w_expert[i], router_b_expert[i],
                    expert_w_gate[i], expert_w_up[i], expert_w_down[i])
        if last:
            y_lat = hier_moe(h_lat, *moe_args)
        else:
            xc = layer_norm(ALPHA * xc + mod_ctx[2] * o_ctx, ln1_g[i], ln1_b[i])
            h_ctx = modulate(xc, mod_ctx[3], mod_ctx[4]).reshape(-1, D)
            y = hier_moe(jnp.concatenate([h_lat, h_ctx], axis=0), *moe_args)
            y_lat = y[:B * S]
            xc = layer_norm(ALPHA * xc + mod_ctx[5] * y[B * S:].reshape(xc.shape), ln2_g[i], ln2_b[i])
        x = layer_norm(ALPHA * x + mod_lat[5] * y_lat.reshape(B, S, D), ln2_g[i], ln2_b[i])
    return x
```

```cpp
#include <hip/hip_runtime.h>
#include <cstdio>
#include <cstdint>

constexpr int D = 1024, NB = 16, SEQ = 2048, CTXL = 256, DEPTH = 4;
constexpr int NLAT = NB * SEQ;
constexpr int NCTX = NB * CTXL;
constexpr int MTOT = NLAT + NCTX;
constexpr int KVTOK = SEQ + CTXL;
constexpr int NEXP = 32, EFF = 512;
constexpr float LN_EPS = 1e-5f;
constexpr float ALPHA = 1.681792830507429f;
constexpr float LOG2E = 1.4426950408889634f;
constexpr float QSCALE = 0.125f * LOG2E;
constexpr float NEGBIG = -1e30f;
namespace pg8 {
#define PG8_LAS __attribute__((address_space(3)))
typedef unsigned short bf16_t;
typedef short bf16x8 __attribute__((ext_vector_type(8)));
typedef float f32x4 __attribute__((ext_vector_type(4)));
typedef unsigned u32x4 __attribute__((ext_vector_type(4)));
constexpr int BM = 256, BK = 64, HALF = 128, HTB = HALF * BK * 2  , STAGE_BYTES = 8 * HTB, NXCD = 8, WGM = 8;

__host__ __device__ __forceinline__ int lds_byte(int r, int c) { const int st = (r >> 4) * 2 + (c >> 5), rr = r & 15, cc = c & 31, ob = rr * 64 + cc * 2; return st * 1024 + (ob ^ (((ob >> 9) & 1) << 5)); }
__host__ __device__ __forceinline__ void stage_rc(int b, int& R, int& C) { const int st = b / 1024, sb = b % 1024, swz = sb ^ (((sb >> 9) & 1) << 5); R = (st >> 1) * 16 + swz / 64; C = (st & 1) * 32 + (swz % 64) / 2; }
__host__ __device__ __forceinline__ int perm32(int rho) { const int n = rho >> 4, i = rho & 15; return 8 * (i >> 2) + 4 * n + (i & 3); }

struct Unit { int pm, pn; };
struct Gemm { const bf16_t* A; const bf16_t* Bt; int M, N, K; };

struct StaticOrder {
    int nM, nN, nwg, G, c;
    __host__ __device__ void init(int M, int N, int G_, int c_) { nM = M / BM; nN = N / BM; nwg = nM * nN; G = G_; c = c_; }
    __host__ __device__ bool next(int i, Unit& u) const {
        const long L = (long)i * G + c; if (L >= nwg) return false;
        int wgid = (int)L; { const int q = nwg / NXCD, r = nwg % NXCD, xcd = wgid % NXCD, off = wgid / NXCD; wgid = (xcd < r ? xcd * (q + 1) : r * (q + 1) + (xcd - r) * q) + off; }
        const int nig = WGM * nN, gid = wgid / nig, fm = gid * WGM, gsz = (nM - fm) < WGM ? (nM - fm) : WGM;
        u.pm = fm + ((wgid % nig) % gsz); u.pn = (wgid % nig) / gsz; return true;
    }
    __device__ __forceinline__ void a_ready(const Unit&) const {}
    __device__ __forceinline__ void done(const Unit&) const {}
};


__device__ __forceinline__ unsigned cvt_pk_bf16(float lo, float hi) { unsigned r; asm volatile("v_cvt_pk_bf16_f32 %0, %1, %2" : "=v"(r) : "v"(lo), "v"(hi)); return r; }
typedef unsigned u32x2 __attribute__((ext_vector_type(2)));
__device__ __forceinline__ u32x2 pk4(const f32x4 v) { u32x2 w; w.x = cvt_pk_bf16(v[0], v[1]); w.y = cvt_pk_bf16(v[2], v[3]); return w; }
__device__ __forceinline__ u32x4 pk8(const f32x4 a, const f32x4 b) { u32x4 w; w.x = cvt_pk_bf16(a[0], a[1]); w.y = cvt_pk_bf16(a[2], a[3]); w.z = cvt_pk_bf16(b[0], b[1]); w.w = cvt_pk_bf16(b[2], b[3]); return w; }
#ifndef WT_STORES
#define WT_STORES 1
#endif
__device__ __forceinline__ void st16(bf16_t* p, const u32x4 v) {
#if WT_STORES
    asm volatile("global_store_dwordx4 %0, %1, off sc1\n\ts_nop 1" :: "v"(p), "v"(v) : "memory");
#else
    *(u32x4*)p = v;
#endif
}
__device__ __forceinline__ void st8(bf16_t* p, const u32x2 v) {
#if WT_STORES
    asm volatile("global_store_dwordx2 %0, %1, off sc1\n\ts_nop 1" :: "v"(p), "v"(v) : "memory");
#else
    *(u32x2*)p = v;
#endif
}
__device__ __forceinline__ void row_bt(int row, int& b, int& tok) { if (row < NLAT) { b = row >> 11; tok = row & 2047; } else { const int r = row - NLAT; b = r >> 8; tok = SEQ + (r & 255); } }

struct EpiQK {
    static constexpr bool PERM = false, AFTER_DRAIN = false;
    bf16_t* Q; bf16_t* Kb; const float* rope; int nkvh; float qscale;
    __device__ __forceinline__ void operator()(const f32x4 (&acc)[2][2][4][2], const Unit& u, int wr, int wc, int fr, int fq) const {
        const bool isQ = u.pn < 4, dorope = (rope != nullptr) && (u.pm < NLAT / BM);
        const int qi_ = fr & 3;
#pragma unroll
        for (int ai = 0; ai < 2; ++ai)
#pragma unroll
            for (int m = 0; m < 4; ++m) {
                const int row = u.pm * BM + ai * HALF + wr * 64 + m * 16 + fr;
                int b, tok; row_bt(row, b, tok);
                u32x2 pc[4];
#pragma unroll
                for (int bj = 0; bj < 2; ++bj) {
                    f32x4 cs = {1.f, 1.f, 1.f, 1.f}, sn = {0.f, 0.f, 0.f, 0.f};
                    if (dorope) { const int pos = bj ? (tok & 63) : (tok >> 6); const float* t = rope + (pos * 16 + 4 * fq) * 2;
                        const f32x4 t0 = *(const f32x4*)t, t1 = *(const f32x4*)(t + 4); cs = (f32x4){t0[0], t0[2], t1[0], t1[2]}; sn = (f32x4){t0[1], t0[3], t1[1], t1[3]}; }
                    const f32x4 x1 = acc[ai][bj][m][0], x2 = acc[ai][bj][m][1];
                    f32x4 o1 = x1 * cs - x2 * sn, o2 = x1 * sn + x2 * cs;
                    if (isQ) { o1 = o1 * qscale; o2 = o2 * qscale; }
                    pc[2 * bj] = pk4(o1); pc[2 * bj + 1] = pk4(o2);
                }
#pragma unroll
                for (int q = 0; q < 2; ++q) {
                    u32x2 snd = (qi_ & 1) ? pc[2 * q] : pc[2 * q + 1], rcv;
                    rcv.x = (unsigned)__builtin_amdgcn_mov_dpp((int)snd.x, 0xB1, 0xF, 0xF, true); rcv.y = (unsigned)__builtin_amdgcn_mov_dpp((int)snd.y, 0xB1, 0xF, 0xF, true);
                    if (qi_ & 1) pc[2 * q] = rcv; else pc[2 * q + 1] = rcv; }
#pragma unroll
                for (int q = 0; q < 2; ++q) {
                    u32x2 snd = (qi_ & 2) ? pc[q] : pc[q + 2], rcv;
                    rcv.x = (unsigned)__builtin_amdgcn_mov_dpp((int)snd.x, 0x4E, 0xF, 0xF, true); rcv.y = (unsigned)__builtin_amdgcn_mov_dpp((int)snd.y, 0x4E, 0xF, 0xF, true);
                    if (qi_ & 2) pc[q] = rcv; else pc[q + 2] = rcv; }
                if (isQ) { bf16_t* dst = Q + (size_t)(row - qi_) * D + u.pn * BM + wc * 64 + 16 * qi_ + 4 * fq;
#pragma unroll
                    for (int r = 0; r < 4; ++r) st8(dst + (size_t)r * D, pc[r]); }
                else { const int head = (u.pn - 4) * 4 + wc; bf16_t* dst = Kb + ((size_t)(b * nkvh + head) * KVTOK + (tok - qi_)) * 64 + 16 * qi_ + 4 * fq;
#pragma unroll
                    for (int r = 0; r < 4; ++r) st8(dst + r * 64, pc[r]); }
            }
    }
};

__device__ __forceinline__ void store_pair_rows(bf16_t* rowp_even, size_t ld, const u32x4 w0, const u32x4 w1, int odd) {
    u32x4 snd, rcv, s1, s2;
#pragma unroll
    for (int q = 0; q < 4; ++q) { snd[q] = odd ? w0[q] : w1[q]; rcv[q] = (unsigned)__builtin_amdgcn_mov_dpp((int)snd[q], 0xB1, 0xF, 0xF, true); }
#pragma unroll
    for (int q = 0; q < 4; ++q) { s1[q] = odd ? rcv[q] : w0[q]; s2[q] = odd ? w1[q] : rcv[q]; }
    st16(rowp_even, s1); st16(rowp_even + ld, s2);
}
template <int MODE> struct EpiP {
    static constexpr bool PERM = true, AFTER_DRAIN = false;
    bf16_t* O; bf16_t* O2; int ldc, pnmask, sub, nkvh;
    __device__ __forceinline__ void operator()(const f32x4 (&acc)[2][2][4][2], const Unit& u, int wr, int wc, int fr, int fq) const {
        if constexpr (MODE == 9) {
#pragma unroll
            for (int ai = 0; ai < 2; ++ai)
#pragma unroll
                for (int m = 0; m < 4; ++m)
#pragma unroll
                    for (int bj = 0; bj < 2; ++bj) asm volatile("" :: "v"(acc[ai][bj][m][0]), "v"(acc[ai][bj][m][1]));
        } else if constexpr (MODE == 0) {
            const int odd = fr & 1, col0 = (u.pn & pnmask) * BM + wc * 64 + 8 * fq + 32 * odd;
#pragma unroll
            for (int ai = 0; ai < 2; ++ai)
#pragma unroll
                for (int m = 0; m < 4; ++m) { bf16_t* rowp = O + (size_t)(u.pm * BM + ai * HALF + wr * 64 + m * 16 + fr - odd) * ldc + col0;
                    store_pair_rows(rowp, (size_t)ldc, pk8(acc[ai][0][m][0], acc[ai][0][m][1]), pk8(acc[ai][1][m][0], acc[ai][1][m][1]), odd); }
        } else if constexpr (MODE == 1) {
            bf16_t* blk = O + (size_t)u.pm * (BM * 512) + (size_t)((u.pn & 3) * 4 + wc) * (BM * 32) + (size_t)wr * (64 * 32);
            const unsigned lo = (unsigned)(fr * 32 + 8 * fq);
#pragma unroll
            for (int ai = 0; ai < 2; ++ai)
#pragma unroll
                for (int m = 0; m < 4; ++m) { bf16_t* rowp = blk + (ai * HALF + m * 16) * 32 + lo;
                    f32x4 h[2];
#pragma unroll
                    for (int n = 0; n < 2; ++n) { const f32x4 g = acc[ai][0][m][n], up = acc[ai][1][m][n];
#pragma unroll
                        for (int j = 0; j < 4; ++j) { const float e = __builtin_amdgcn_exp2f(-g[j] * LOG2E); h[n][j] = g[j] * __builtin_amdgcn_rcpf(1.0f + e) * up[j]; } }
                    st16(rowp, pk8(h[0], h[1])); }
        } else {
            if (sub == 0) {
                int b, tok0; row_bt(u.pn * BM, b, tok0);
                const int odd = fr & 1, tcol = tok0 + wc * 64 + 8 * fq + 32 * odd;
#pragma unroll
                for (int ai = 0; ai < 2; ++ai)
#pragma unroll
                    for (int m = 0; m < 4; ++m) { const int f = u.pm * BM + ai * HALF + wr * 64 + m * 16 + fr - odd; const int head = f >> 6, d = f & 63;
                        bf16_t* rowp = O + ((size_t)(b * nkvh + head) * 64 + d) * KVTOK + tcol;
                        store_pair_rows(rowp, (size_t)KVTOK, pk8(acc[ai][0][m][0], acc[ai][0][m][1]), pk8(acc[ai][1][m][0], acc[ai][1][m][1]), odd); }
            } else {
                if (u.pn < 8) {
                    const int col0 = u.pn * HALF + wc * 32 + 8 * fq;
#pragma unroll
                    for (int ai = 0; ai < 2; ++ai)
#pragma unroll
                        for (int m = 0; m < 4; ++m) { bf16_t* rowp = O + (size_t)(u.pm * BM + ai * HALF + wr * 64 + m * 16 + fr) * D + col0;
                            st16(rowp, pk8(acc[ai][0][m][0] * acc[ai][1][m][0], acc[ai][0][m][1] * acc[ai][1][m][1])); }
                } else {
                    const int odd = fr & 1, col0 = (u.pn - 8) * BM + wc * 64 + 8 * fq + 32 * odd;
#pragma unroll
                    for (int ai = 0; ai < 2; ++ai)
#pragma unroll
                        for (int m = 0; m < 4; ++m) { bf16_t* rowp = O2 + (size_t)(u.pm * BM + ai * HALF + wr * 64 + m * 16 + fr - odd) * D + col0;
                            store_pair_rows(rowp, (size_t)D, pk8(acc[ai][0][m][0], acc[ai][0][m][1]), pk8(acc[ai][1][m][0], acc[ai][1][m][1]), odd); }
                }
            }
        }
    }
};

struct MoeOrder {
    const PG8_LAS int* tile_e; const PG8_LAS int* rows; int ntiles, c;
    __device__ __forceinline__ bool next(int i, Unit& u) const {
        const int tile = i * 64 + (c & 7) * 8 + (c >> 5); if (tile >= ntiles) return false;
        u.pm = tile; u.pn = __builtin_amdgcn_readfirstlane(tile_e[tile]) * 4 + ((c >> 3) & 3); return true;
    }
    __device__ __forceinline__ int row(int ui, int r) const { return rows[ui * 256 + r]; }
    __device__ __forceinline__ void a_ready(const Unit&) const {}
    __device__ __forceinline__ void done(const Unit&) const {}
};
template <class Epi, class Sched, bool ALIGN_EPI = false, bool SP2 = true, bool GATHER = false, bool ABLK = false>
__device__ __forceinline__ void gemm_phase(PG8_LAS unsigned char* lds, const Gemm g, const Sched& S, const Epi& E, int wv  ) {
    int tid_; asm volatile("v_mbcnt_lo_u32_b32 %0, -1, 0\n\tv_mbcnt_hi_u32_b32 %0, -1, %0" : "=v"(tid_)); tid_ += wv * 64;
    static_assert(SP2, "the 64-column-per-wave B mapping reads both of a wave's B fragments from ONE half buffer in SP1: only the two-super-phase loop has them retired together");
    const int tid = tid_, wid = __builtin_amdgcn_readfirstlane(tid >> 6), lane = tid & 63, wr = wid >> 2, wc = wid & 3, fr = lane & 15, fq = lane >> 4;
    const int K = g.K, nt = K / BK;
    unsigned voffA[2][2], voffB[2];
#pragma unroll
    for (int i = 0; i < 2; ++i) { int R, C; stage_rc(tid * 16 + i * 8192, R, C); const int Rb = Epi::PERM ? ((R & ~31) + perm32(R & 31)) : R;
        voffA[0][i] = ABLK ? (unsigned)((C >> 5) * 16384 + R * 64 + (C & 31) * 2) : (unsigned)(R * K + C) * 2u; voffA[1][i] = voffA[0][i];     voffB[i] = (unsigned)(Rb * K + C) * 2u; }
#define PG8_GOFF(dst, uidx) do { _Pragma("unroll") for (int _i = 0; _i < 2; ++_i) { int R_, C_; stage_rc(tid * 16 + _i * 8192, R_, C_); \
        dst[0][_i] = (unsigned)(S.row(uidx, R_) * K + C_) * 2u; dst[1][_i] = (unsigned)(S.row(uidx, R_ + HALF) * K + C_) * 2u; } } while (0)
    const size_t kstep = (size_t)(BK * 2);
    const size_t kstepA = ABLK ? (size_t)32768 : kstep;
    const size_t hstep = (size_t)HALF * K * 2;
    const size_t hstepA = GATHER ? (size_t)0 : (ABLK ? (size_t)(HALF * 64) : hstep);
    const size_t tstep = 2 * hstep;
    const unsigned ldsw = (unsigned)wid * 1024u;
    const int aoff = lds_byte(wr * 64 + fr, fq * 8), boff = lds_byte((wc & 1) * 64 + fr, fq * 8) + (wc >> 1) * HTB;
#define PG8_SA(b, h) (((b) * 2 + (h)) * HTB)
#define PG8_SB(b, h) ((4 + (b) * 2 + (h)) * HTB)
#define PG8_STAGE(bufoff, gbase, voff) do { _Pragma("unroll") for (int _i = 0; _i < 2; ++_i) \
        __builtin_amdgcn_global_load_lds((const unsigned*)((const char*)(gbase) + (voff)[_i]), (PG8_LAS unsigned*)(lds + (bufoff) + ldsw + _i * 8192), 16, 0, 0); } while (0)
#define PG8_LDA(dst, b, h) do { _Pragma("unroll") for (int m = 0; m < 4; ++m) _Pragma("unroll") for (int k = 0; k < 2; ++k) dst[m][k] = *(const PG8_LAS bf16x8*)(lds + PG8_SA(b, h) + aoff + m * 2048 + k * 1024); } while (0)
#define PG8_LDB(dst, b, h) do { _Pragma("unroll") for (int n = 0; n < 2; ++n) _Pragma("unroll") for (int k = 0; k < 2; ++k) dst[n][k] = *(const PG8_LAS bf16x8*)(lds + PG8_SB(b, 0) + boff + (h) * 4096 + n * 2048 + k * 1024); } while (0)
#define PG8_MMA(ai, bj, At, Bt) do { __builtin_amdgcn_s_setprio(1); _Pragma("unroll") for (int m = 0; m < 4; ++m) _Pragma("unroll") for (int n = 0; n < 2; ++n) _Pragma("unroll") for (int k = 0; k < 2; ++k) \
        acc[ai][bj][m][n] = __builtin_amdgcn_mfma_f32_16x16x32_bf16(Bt[n][k], At[m][k], acc[ai][bj][m][n], 0, 0, 0); __builtin_amdgcn_s_setprio(0); } while (0)
#define PG8_WAIT_V(n) asm volatile("s_waitcnt vmcnt(" #n ")" ::: "memory")
#define PG8_WAIT_L(n) asm volatile("s_waitcnt lgkmcnt(" #n ")" ::: "memory")
#define PG8_BAR __builtin_amdgcn_s_barrier()
#define PG8_SCHED __builtin_amdgcn_sched_barrier(0)
    Unit cur, nxt; int ui = 0;
    if (!S.next(0, cur)) return;
    f32x4 acc[2][2][4][2];
#pragma unroll
    for (int a = 0; a < 2; ++a)
#pragma unroll
        for (int b = 0; b < 2; ++b)
#pragma unroll
            for (int m = 0; m < 4; ++m)
#pragma unroll
                for (int n = 0; n < 2; ++n) acc[a][b][m][n] = (f32x4){0.f, 0.f, 0.f, 0.f};
    bf16x8 At[4][2], B0[2][2], B1[2][2];
    const char* cA = (const char*)g.A + (GATHER ? (size_t)0 : (size_t)cur.pm * tstep); const char* cB = (const char*)g.Bt + (size_t)cur.pn * tstep;
    if constexpr (GATHER) PG8_GOFF(voffA, 0);
    S.a_ready(cur);
    if constexpr (SP2) {
        PG8_STAGE(PG8_SB(0, 0), cB, voffB); PG8_STAGE(PG8_SB(0, 1), cB + hstep, voffB); PG8_STAGE(PG8_SA(0, 0), cA, voffA[0]); PG8_STAGE(PG8_SA(0, 1), cA + hstepA, voffA[1]);
        if (wr == 1) PG8_BAR;
        PG8_WAIT_V(2); PG8_BAR;
        PG8_STAGE(PG8_SB(1, 0), cB + kstep, voffB); PG8_STAGE(PG8_SA(1, 0), cA + kstepA, voffA[0]); PG8_STAGE(PG8_SB(1, 1), cB + hstep + kstep, voffB);
        PG8_WAIT_V(6); PG8_BAR;
    } else {
        PG8_STAGE(PG8_SB(0, 0), cB, voffB); PG8_STAGE(PG8_SA(0, 0), cA, voffA[0]); PG8_STAGE(PG8_SB(0, 1), cB + hstep, voffB); PG8_STAGE(PG8_SA(0, 1), cA + hstepA, voffA[1]);
        if (wr == 1) PG8_BAR;
        PG8_WAIT_V(4); PG8_BAR;
        PG8_STAGE(PG8_SB(1, 0), cB + kstep, voffB); PG8_STAGE(PG8_SA(1, 0), cA + kstepA, voffA[0]); PG8_STAGE(PG8_SB(1, 1), cB + hstep + kstep, voffB);
        PG8_WAIT_V(6); PG8_BAR;
    }
    for (;;) {
        const bool has_next = S.next(ui + 1, nxt);
        const char* nA = (has_next && !GATHER) ? (const char*)g.A + (size_t)nxt.pm * tstep : cA; const char* nB = has_next ? (const char*)g.Bt + (size_t)nxt.pn * tstep : cB;
#pragma nounroll
        for (int t = 0; t < nt; t += 2) {
            const bool last = (t == nt - 2);
            const char* a1 = cA + (size_t)(t + 1) * kstepA;
            const char* a2 = last ? nA : cA + (size_t)(t + 2) * kstepA; const char* b2 = last ? nB : cB + (size_t)(t + 2) * kstep;
            const char* a3 = a2 + kstepA; const char* b3 = b2 + kstep;
            if (last && has_next) S.a_ready(nxt);
            if constexpr (SP2) {
            PG8_LDB(B0, 0, 0); PG8_LDB(B1, 0, 1); PG8_SCHED; PG8_LDA(At, 0, 0); PG8_STAGE(PG8_SA(1, 1), a1 + hstepA, voffA[1]);
            if constexpr (GATHER) { if (last && has_next) PG8_GOFF(voffA, ui + 1); }
            PG8_WAIT_V(8); PG8_WAIT_L(0); PG8_BAR; PG8_MMA(0, 0, At, B0); PG8_MMA(0, 1, At, B1); PG8_BAR; PG8_SCHED;
            PG8_LDA(At, 0, 1); PG8_STAGE(PG8_SB(0, 0), b2, voffB); PG8_STAGE(PG8_SB(0, 1), b2 + hstep, voffB); PG8_STAGE(PG8_SA(0, 0), a2, voffA[0]);
            PG8_WAIT_V(8); PG8_WAIT_L(0); PG8_BAR; PG8_MMA(1, 0, At, B0); PG8_MMA(1, 1, At, B1); PG8_BAR; PG8_SCHED;
            PG8_LDB(B0, 1, 0); PG8_LDB(B1, 1, 1); PG8_SCHED; PG8_LDA(At, 1, 0); PG8_STAGE(PG8_SA(0, 1), a2 + hstepA, voffA[1]);
            PG8_WAIT_V(8); PG8_WAIT_L(0); PG8_BAR; PG8_MMA(0, 0, At, B0); PG8_MMA(0, 1, At, B1); PG8_BAR; PG8_SCHED;
            PG8_LDA(At, 1, 1); PG8_STAGE(PG8_SB(1, 0), b3, voffB); PG8_STAGE(PG8_SB(1, 1), b3 + hstep, voffB); PG8_STAGE(PG8_SA(1, 0), a3, voffA[0]);
            PG8_WAIT_V(8); PG8_WAIT_L(0); PG8_BAR; PG8_MMA(1, 0, At, B0); PG8_MMA(1, 1, At, B1); PG8_BAR; PG8_SCHED;
            } else {
            PG8_LDB(B0, 0, 0); PG8_SCHED; PG8_LDA(At, 0, 0); PG8_STAGE(PG8_SA(1, 1), a1 + hstepA, voffA[1]);
            PG8_WAIT_L(8); PG8_BAR; PG8_WAIT_L(0); PG8_MMA(0, 0, At, B0); PG8_BAR; PG8_SCHED;
            PG8_LDB(B1, 0, 1); PG8_STAGE(PG8_SB(0, 0), b2, voffB);
            PG8_BAR; PG8_WAIT_L(0); PG8_MMA(0, 1, At, B1); PG8_BAR;
            PG8_LDA(At, 0, 1); PG8_STAGE(PG8_SA(0, 0), a2, voffA[0]);
            PG8_BAR; PG8_WAIT_L(0); PG8_MMA(1, 0, At, B0); PG8_BAR; PG8_SCHED;
            PG8_STAGE(PG8_SB(0, 1), b2 + hstep, voffB);
            PG8_WAIT_V(6); PG8_BAR; PG8_MMA(1, 1, At, B1); PG8_BAR;
            PG8_LDB(B0, 1, 0); PG8_SCHED; PG8_LDA(At, 1, 0); PG8_STAGE(PG8_SA(0, 1), a2 + hstepA, voffA[1]);
            PG8_WAIT_L(8); PG8_BAR; PG8_WAIT_L(0); PG8_MMA(0, 0, At, B0); PG8_BAR; PG8_SCHED;
            PG8_LDB(B1, 1, 1); PG8_STAGE(PG8_SB(1, 0), b3, voffB);
            PG8_BAR; PG8_WAIT_L(0); PG8_MMA(0, 1, At, B1); PG8_BAR;
            PG8_LDA(At, 1, 1); PG8_STAGE(PG8_SA(1, 0), a3, voffA[0]);
            PG8_BAR; PG8_WAIT_L(0); PG8_MMA(1, 0, At, B0); PG8_BAR; PG8_SCHED;
            PG8_STAGE(PG8_SB(1, 1), b3 + hstep, voffB);
            PG8_WAIT_V(6); PG8_BAR; PG8_MMA(1, 1, At, B1); PG8_BAR;
            }
        }
        if constexpr (ALIGN_EPI) { if (wr == 0) PG8_BAR; }
        if constexpr (!Epi::AFTER_DRAIN) { E(acc, cur, wr, wc, fr, fq); S.done(cur); }
        if (!has_next) break;
#pragma unroll
        for (int a = 0; a < 2; ++a)
#pragma unroll
            for (int b = 0; b < 2; ++b)
#pragma unroll
                for (int m = 0; m < 4; ++m)
#pragma unroll
                    for (int n = 0; n < 2; ++n) acc[a][b][m][n] = (f32x4){0.f, 0.f, 0.f, 0.f};
        cur = nxt; cA = nA; cB = nB; ++ui;
        if constexpr (ALIGN_EPI) { if (wr == 1) PG8_BAR; }
    }
    PG8_WAIT_V(0);
    if constexpr (!ALIGN_EPI) { if (wr == 0) PG8_BAR; }
    PG8_BAR;
    if constexpr (Epi::AFTER_DRAIN) { E.fused(acc, cur, wr, wc, fr, fq, lds, wid, lane); S.done(cur); }
#undef PG8_SA
#undef PG8_SB
#undef PG8_STAGE
#undef PG8_GOFF
#undef PG8_LDA
#undef PG8_LDB
#undef PG8_MMA
#undef PG8_WAIT_V
#undef PG8_WAIT_L
#undef PG8_BAR
#undef PG8_SCHED
}
}

constexpr size_t MiB = 1u << 20;
constexpr size_t WS_CTL = 0, CTL_ZERO_BYTES = 1 * MiB;
constexpr size_t WS_MOD = 1 * MiB;
constexpr size_t WS_ROPE = 3 * MiB;
constexpr size_t WS_ROUT = 4 * MiB;
constexpr size_t WS_X = 8 * MiB;
constexpr size_t WS_H = 152 * MiB;
constexpr size_t WS_R1 = 224 * MiB;
constexpr size_t WS_R2 = 440 * MiB;
constexpr size_t WS_R3 = 520 * MiB;
constexpr size_t WS_WM = 680 * MiB;
constexpr size_t WS_W1 = 688 * MiB;
constexpr size_t WS_W2 = 752 * MiB;
constexpr size_t WS_END = 784 * MiB;
constexpr int CW_BAR = 4096;
constexpr int CW_CNT = 16384;
constexpr int CW_Q = 20480;
constexpr int CW_DONE = 24576;
constexpr int LDS_BYTES = 155648;
constexpr int LDS_MOE = 131072;
constexpr int LDS_MISC = LDS_BYTES - 256;

#define GAS __attribute__((address_space(1)))
#define LAS __attribute__((address_space(3)))
typedef unsigned short bf16;
typedef unsigned v4u __attribute__((ext_vector_type(4)));
typedef unsigned v2u __attribute__((ext_vector_type(2)));
typedef float f32x4 __attribute__((ext_vector_type(4)));
typedef float f32x2 __attribute__((ext_vector_type(2)));
typedef float f32x16 __attribute__((ext_vector_type(16)));
typedef short bf16x8 __attribute__((ext_vector_type(8)));
typedef _Float16 f16;
typedef _Float16 h16x4 __attribute__((ext_vector_type(4)));
typedef _Float16 h16x8 __attribute__((ext_vector_type(8)));
#ifndef WT_PHASE
#define WT_PHASE 1
#endif
__device__ __forceinline__ __amdgpu_buffer_rsrc_t mkrs(const void* p) { return __builtin_amdgcn_make_buffer_rsrc((void*)p, 0, 0x7fffffff, 0x00020000); }
__device__ __forceinline__ void gst16(void* base, size_t boff, const v4u v) {
#if WT_PHASE
    __builtin_amdgcn_raw_buffer_store_b128(v, mkrs(base), (int)boff, 0, 16);
#else
    *(v4u*)((char*)base + boff) = v;
#endif
}
__device__ __forceinline__ void gst8(void* base, size_t boff, const v2u v) {
#if WT_PHASE
    __builtin_amdgcn_raw_buffer_store_b64(v, mkrs(base), (int)boff, 0, 16);
#else
    *(v2u*)((char*)base + boff) = v;
#endif
}
__device__ __forceinline__ void pst16(void* base, size_t boff, const v4u v) { *(v4u*)((char*)base + boff) = v; }
__device__ __forceinline__ void pst8(void* base, size_t boff, const v2u v) { *(v2u*)((char*)base + boff) = v; }
__device__ __forceinline__ void pst16_nt(void* base, size_t boff, const v4u v) { __builtin_nontemporal_store(v, (v4u*)((char*)base + boff)); }
__device__ __forceinline__ void gst16_nt(void* base, size_t boff, const v4u v) {
#if WT_PHASE
    __builtin_amdgcn_raw_buffer_store_b128(v, mkrs(base), (int)boff, 0, 18);
#else
    __builtin_nontemporal_store(v, (v4u*)((char*)base + boff));
#endif
}
#define LDS_WAIT() asm volatile("s_waitcnt lgkmcnt(0)" ::: "memory")
__device__ __forceinline__ unsigned f2bf(float f) { unsigned u = __builtin_bit_cast(unsigned, f); return (u + 0x7fffu + ((u >> 16) & 1u)) >> 16; }
__device__ __forceinline__ unsigned pk2(float lo, float hi) { return pg8::cvt_pk_bf16(lo, hi); }
typedef __bf16 bf16x2_t __attribute__((ext_vector_type(2)));
__device__ __forceinline__ unsigned pk2c(float lo, float hi) { const f32x2 v = {lo, hi}; return __builtin_bit_cast(unsigned, __builtin_convertvector(v, bf16x2_t)); }
__device__ __forceinline__ float bflo(unsigned w) { return __uint_as_float(w << 16); }
__device__ __forceinline__ float bfhi(unsigned w) { return __uint_as_float(w & 0xffff0000u); }
__device__ __forceinline__ f32x4 bf4(v2u w) { return (f32x4){bflo(w.x), bfhi(w.x), bflo(w.y), bfhi(w.y)}; }
__device__ __forceinline__ int lane_id_fresh() { int ln; asm volatile("v_mbcnt_lo_u32_b32 %0, -1, 0\n\tv_mbcnt_hi_u32_b32 %0, -1, %0" : "=v"(ln)); return ln; }
template <int CTRL, int RM> __device__ __forceinline__ float dpp0(float src) {
    return __builtin_bit_cast(float, __builtin_amdgcn_update_dpp(0, __builtin_bit_cast(int, src), CTRL, RM, 0xF, true)); }
__device__ __forceinline__ float wave_sum(float v) {
    v += dpp0<0xB1, 0xF>(v); v += dpp0<0x4E, 0xF>(v); v += dpp0<0x141, 0xF>(v); v += dpp0<0x140, 0xF>(v);
    v += dpp0<0x142, 0xA>(v); v += dpp0<0x143, 0xC>(v);
    return __builtin_bit_cast(float, __builtin_amdgcn_readlane(__builtin_bit_cast(int, v), 63));
}
__device__ __forceinline__ float xor32_max(float v) { const auto rr = __builtin_amdgcn_permlane32_swap(__float_as_uint(v), __float_as_uint(v), false, false); return fmaxf(__uint_as_float(rr[0]), __uint_as_float(rr[1])); }
__device__ __forceinline__ float xor32_sum(float v) { const auto rr = __builtin_amdgcn_permlane32_swap(__float_as_uint(v), __float_as_uint(v), false, false); return __uint_as_float(rr[0]) + __uint_as_float(rr[1]); }
#define XB_TMO      128
#define XB_XCNT(j)  (256  + 64 * (j))
#define XB_XSUB(j)  (1280 + 64 * (j))
#define XB_XGEN(j)  (2304 + 64 * (j))
#define XB_TOP      3328
#define XB_TOPGEN   3392
#define XCD_BAR_WORDS 3456
#define XB_SPIN_CAP (1u << 18)

__device__ __forceinline__ unsigned xb_ld(unsigned* p)              { return __hip_atomic_load(p, __ATOMIC_RELAXED, __HIP_MEMORY_SCOPE_AGENT); }
__device__ __forceinline__ unsigned xb_add(unsigned* p, unsigned v) { return __hip_atomic_fetch_add(p, v, __ATOMIC_RELAXED, __HIP_MEMORY_SCOPE_AGENT); }
__device__ __forceinline__ unsigned xb_xcc_id() { return (unsigned)__builtin_amdgcn_s_getreg((3 << 11) | 20) & 0xFu; }
#define XB_SPIN(cond, bar) do { unsigned _sp = 0; while (cond) { __builtin_amdgcn_s_sleep(1); \
    if ((++_sp & 255u) == 0u) { if (xb_ld(&(bar)[XB_TMO])) break; if (_sp > XB_SPIN_CAP) { atomicAdd(&(bar)[XB_TMO], 1u); break; } } } } while (0)

struct XcdBarrier {
    unsigned* bar; unsigned x;
    volatile LAS unsigned* st;
};

__device__ __forceinline__ XcdBarrier xcd_barrier_post(unsigned* bar, volatile LAS unsigned* st) {
    XcdBarrier b; b.bar = bar; b.x = xb_xcc_id(); b.st = st;
    if (threadIdx.x == 0) (void)xb_add(&bar[XB_XCNT(b.x)], 1u);
    return b;
}
__device__ __forceinline__ void xcd_barrier_complete(unsigned* bar, unsigned x, unsigned& nloc, unsigned& nx) {
    const unsigned G = gridDim.x * gridDim.y * gridDim.z;
    unsigned sum, cnt, mine, sp = 0u;
    for (;;) {
        sum = 0u; cnt = 0u; mine = 0u;
#pragma unroll
        for (unsigned j = 0; j < 16; ++j) { const unsigned c = xb_ld(&bar[XB_XCNT(j)]); sum += c; cnt += (c > 0u) ? 1u : 0u; mine = (j == x) ? c : mine; }
        if (sum == G) break;
        __builtin_amdgcn_s_sleep(1);
        if ((++sp & 255u) == 0u) { if (xb_ld(&bar[XB_TMO])) break; if (sp > XB_SPIN_CAP) { atomicAdd(&bar[XB_TMO], 1u); break; } }
    }
    nloc = mine > 0u ? mine : 1u; nx = cnt > 0u ? cnt : 1u;
}

__device__ __forceinline__ void xcd_barrier(const XcdBarrier& b) {
    asm volatile("s_waitcnt vmcnt(0)" ::: "memory");
    __syncthreads();
    if (threadIdx.x == 0) {
        unsigned* bar = b.bar;
        __builtin_amdgcn_s_waitcnt(0);
        unsigned nloc = b.st[0], nx = b.st[1];
        if (nloc == 0u) { xcd_barrier_complete(bar, b.x, nloc, nx); b.st[0] = nloc; b.st[1] = nx; }
        const unsigned old = xb_add(&bar[XB_XSUB(b.x)], 1u);
        const unsigned gen = old / nloc;
        if (old + 1u == (gen + 1u) * nloc) {
            __builtin_amdgcn_fence(__ATOMIC_RELEASE, "agent");
            asm volatile("s_waitcnt vmcnt(0)" ::: "memory");
            const unsigned og = xb_add(&bar[XB_TOP], 1u);
            const unsigned tg = og / nx;
            if (og + 1u == (tg + 1u) * nx) xb_add(&bar[XB_TOPGEN], 1u);
            else XB_SPIN(xb_ld(&bar[XB_TOPGEN]) == tg, bar);
            __builtin_amdgcn_fence(__ATOMIC_ACQUIRE, "agent");
            xb_add(&bar[XB_XGEN(b.x)], 1u);
            asm volatile("s_waitcnt vmcnt(0)" ::: "memory");
        } else {
            XB_SPIN(xb_ld(&bar[XB_XGEN(b.x)]) == gen, bar);
            __builtin_amdgcn_fence(__ATOMIC_ACQUIRE, "agent");
            asm volatile("s_waitcnt vmcnt(0)" ::: "memory");
        }
    }
    __syncthreads();
}
struct Args { const float* in[26]; float* out; unsigned char* ws; int ph_lo, ph_hi; };
typedef const Args __attribute__((address_space(4)))* KArgs;
__device__ __forceinline__ KArgs kargs() { KArgs p = (KArgs)__builtin_amdgcn_kernarg_segment_ptr(); asm volatile("" : "+s"(p)); return p; }
#define P_x (ap->in[0])
#define P_c (ap->in[1])
#define P_ctx (ap->in[2])
#define P_c_ctx (ap->in[3])
#define P_w_ada (ap->in[4])
#define P_b_ada (ap->in[5])
#define P_ln1_g (ap->in[6])
#define P_ln1_b (ap->in[7])
#define P_ln2_g (ap->in[8])
#define P_ln2_b (ap->in[9])
#define P_attn_w_qkv (ap->in[10])
#define P_attn_w_o (ap->in[11])
#define P_attn_sink (ap->in[12])
#define P_conv_w_in (ap->in[13])
#define P_conv_w (ap->in[14])
#define P_conv_w_out (ap->in[15])
#define P_nat_w_qkv (ap->in[16])
#define P_nat_w_o (ap->in[17])
#define P_nat_rpb (ap->in[18])
#define P_r_wg (ap->in[19])
#define P_r_bg (ap->in[20])
#define P_r_we (ap->in[21])
#define P_r_be (ap->in[22])
#define P_e_wg (ap->in[23])
#define P_e_wu (ap->in[24])
#define P_e_wd (ap->in[25])
#define P_out (ap->out)
#define P_ctl ((unsigned*)(ap->ws + WS_CTL))
#define P_mod ((float*)(ap->ws + WS_MOD))
#define P_rope ((float*)(ap->ws + WS_ROPE))
#define P_r_eid ((int*)(ap->ws + WS_ROUT))
#define P_r_gate ((float*)(ap->ws + WS_ROUT) + 2 * MTOT)
#define P_r_rank ((int*)(ap->ws + WS_ROUT) + 4 * MTOT)
#define P_r_dest ((int*)(ap->ws + WS_ROUT) + 6 * MTOT)
#define P_X ((f16*)(ap->ws + WS_X))
#define P_tokrow ((int*)(ap->ws + WS_R1))
constexpr int TOKCAP = 2 * MTOT;
#define P_H ((bf16*)(ap->ws + WS_H))
#define P_R1 ((bf16*)(ap->ws + WS_R1))
#define P_R2 ((bf16*)(ap->ws + WS_R2))
#define P_R3 ((bf16*)(ap->ws + WS_R3))
#define P_WM_IN ((bf16*)(ap->ws + WS_WM))
#define P_WM_O ((bf16*)(ap->ws + WS_WM + 6 * MiB))
#define P_W1 ((bf16*)(ap->ws + WS_W1))
#define P_W2 ((bf16*)(ap->ws + WS_W2))

struct Ctx {
    LAS unsigned char* lds; int tid, lane, wave, G, bid, gw, ngw;
};
__device__ __forceinline__ const float* xin_row(KArgs ap, const Ctx& C, int row) {
    return row < NLAT ? P_x + (size_t)row * D : P_ctx + (size_t)(row - NLAT) * D;
}
__device__ __forceinline__ f32x4 ldx4(KArgs ap, const Ctx& C, int layer, int row, int off) {
    if (layer == 0) return *(const f32x4*)(xin_row(ap, C, row) + off);
    return __builtin_convertvector(*(const h16x4*)(P_X + (size_t)row * D + off), f32x4);
}
__device__ __forceinline__ void stx4(KArgs ap, int row, int off, const f32x4 v, size_t dry = 0) { pst8(dry ? (f16*)(ap->ws + WS_R1) : P_X, ((size_t)row * D + off) * 2, __builtin_bit_cast(v2u, __builtin_convertvector(v, h16x4))); }
__device__ __forceinline__ int row_bidx(int row) { return row < NLAT ? (row >> 11) : 16; }

__device__ __forceinline__ void phase_mod(KArgs ap, Ctx& C) {
    LAS float* sl = (LAS float*)C.lds;
    LAS float* part = (LAS float*)(C.lds + 69632);
    {
        f32x4 cv[9];
#pragma unroll
        for (int j = 0; j < 9; ++j) { const int idx = (j * 512 + C.tid) * 4; const int r = idx >> 10, k = idx & 1023;
            cv[j] = idx < 17 * 1024 ? *(const f32x4*)(r < 16 ? P_c + r * 1024 + k : P_c_ctx + k) : (f32x4){0.f, 0.f, 0.f, 0.f}; }
#pragma unroll
        for (int j = 0; j < 9; ++j) { const int idx = (j * 512 + C.tid) * 4;
            if (idx < 17 * 1024) { f32x4 o;
#pragma unroll
                for (int q = 0; q < 4; ++q) o[q] = cv[j][q] * __builtin_amdgcn_rcpf(1.0f + __builtin_amdgcn_exp2f(-cv[j][q] * LOG2E));
                *(LAS f32x4*)(sl + idx) = o; } }
    }
    __syncthreads();
    for (int unit = C.bid; unit < DEPTH * 48; unit += C.G) {
        const int layer = unit / 48, nb = (unit % 48) * 128;
        const float* W = P_w_ada + (size_t)layer * 1024 * 6144 + nb + 2 * C.lane;
        float a0[17], a1[17];
#pragma unroll
        for (int r = 0; r < 17; ++r) { a0[r] = 0.f; a1[r] = 0.f; }
        const int k0 = C.wave * 128;
#pragma nounroll
        for (int kk = 0; kk < 128; kk += 16) {
            f32x2 w[16];
#pragma unroll
            for (int j = 0; j < 16; ++j) w[j] = *(const f32x2*)(W + (size_t)(k0 + kk + j) * 6144);
#pragma unroll
            for (int r = 0; r < 17; ++r) {
#pragma unroll
                for (int q = 0; q < 4; ++q) { const f32x4 s = *(const LAS f32x4*)(sl + r * 1024 + k0 + kk + 4 * q);
                    a0[r] += s[0] * w[4 * q].x + s[1] * w[4 * q + 1].x + s[2] * w[4 * q + 2].x + s[3] * w[4 * q + 3].x;
                    a1[r] += s[0] * w[4 * q].y + s[1] * w[4 * q + 1].y + s[2] * w[4 * q + 2].y + s[3] * w[4 * q + 3].y; } }
        }
#pragma unroll
        for (int r = 0; r < 17; ++r) *(LAS f32x2*)(part + (C.wave * 17 + r) * 128 + 2 * C.lane) = (f32x2){a0[r], a1[r]};
        __syncthreads();
        for (int idx = C.tid; idx < 17 * 128; idx += 512) { const int r = idx >> 7, cc = idx & 127; float s = P_b_ada[layer * 6144 + nb + cc];
#pragma unroll
            for (int w = 0; w < 8; ++w) s += part[(w * 17 + r) * 128 + cc];
            P_mod[(size_t)(layer * 17 + r) * 6144 + nb + cc] = s; }
        __syncthreads();
    }
    if (C.bid == C.G - 1) for (int idx = C.tid; idx < 1024; idx += 512) { const int pos = idx >> 4, i = idx & 15;
        const float inv = exp2f(-(float)i * (13.287712379549449f / 16.0f)); const float ang = (float)pos * inv;
        P_rope[idx * 2] = cosf(ang); P_rope[idx * 2 + 1] = sinf(ang); }
}

__device__ __forceinline__ void tr_item(const float* W, int N, int k0, int n0, bf16* WT, int Kd, int drow0, LAS float* scr, int lane) {
    float wv[32];
#pragma unroll
    for (int i = 0; i < 32; ++i) { const int kk = 2 * i + (lane >> 5); wv[i] = W[(size_t)(k0 + kk) * N + n0 + (lane & 31)]; }
#pragma unroll
    for (int i = 0; i < 32; ++i) { const int kk = 2 * i + (lane >> 5); scr[kk * 33 + (lane & 31)] = wv[i]; }
    LDS_WAIT(); asm volatile("" ::: "memory");
    const int c = lane & 7;
#pragma unroll
    for (int j = 0; j < 4; ++j) { const int n = (lane >> 3) + 8 * j; const LAS float* s = scr + (8 * c) * 33 + n;
        v4u o; o.x = pk2(s[0 * 33], s[1 * 33]); o.y = pk2(s[2 * 33], s[3 * 33]); o.z = pk2(s[4 * 33], s[5 * 33]); o.w = pk2(s[6 * 33], s[7 * 33]);
        *(v4u*)(WT + (size_t)(drow0 + n) * Kd + k0 + 8 * c) = o; }
    LDS_WAIT(); asm volatile("" ::: "memory");
}
__device__ __forceinline__ int convert_nitems(int layer) { return 3 * 32 * 256 + 16 * ((layer % 3) == 0 ? 48 : 96) + 512; }
__device__ __forceinline__ void convert_item(KArgs ap, Ctx& C, int layer, int it, LAS float* scr) {
    const int kind = layer % 3, j = layer / 3;
    if (it < 3 * 32 * 256) {
        const int which = it >> 13, r = it & 8191, e = r >> 8, q = r & 255;
        if (which < 2) { const float* W = (which ? P_e_wu : P_e_wg) + (size_t)(layer * 32 + e) * 1024 * 512; const int kb = q >> 4, n0 = 32 * (q & 15);
            tr_item(W, 512, 64 * kb, n0, P_W1, 1024, e * 1024 + 256 * (n0 >> 7) + 64 * ((n0 >> 5) & 3) + 32 * which, scr, C.lane); }
        else { const float* W = P_e_wd + (size_t)(layer * 32 + e) * 512 * 1024; const int kb = q >> 5, n0 = 32 * (q & 31);
            tr_item(W, 1024, 64 * kb, n0, P_W2, 512, e * 1024 + n0, scr, C.lane); }
        return;
    }
    it -= 3 * 32 * 256;
    const int nblk = kind == 0 ? 48 : 96;
    if (it < 16 * nblk) {
        const float* W; int N;
        if (kind == 0) { W = P_attn_w_qkv + (size_t)j * 1024 * 1536; N = 1536; }
        else if (kind == 1) { W = P_conv_w_in + (size_t)j * 1024 * 3072; N = 3072; }
        else { W = P_nat_w_qkv + (size_t)j * 1024 * 3072; N = 3072; }
        const int kb = it / nblk, n0 = 32 * (it % nblk); int drow0 = n0;
        if (kind == 1) { if (n0 < 1024) drow0 = 2048 + n0; else if (n0 < 2048) { const int jj = n0 - 1024; drow0 = 256 * (jj >> 7) + 64 * ((jj >> 5) & 3); } else { const int jj = n0 - 2048; drow0 = 256 * (jj >> 7) + 64 * ((jj >> 5) & 3) + 32; } }
        tr_item(W, N, 64 * kb, n0, P_WM_IN, 1024, drow0, scr, C.lane);
        return;
    }
    it -= 16 * nblk;
    const float* W = (kind == 0 ? P_attn_w_o : kind == 1 ? P_conv_w_out : P_nat_w_o) + (size_t)j * 1024 * 1024;
    const int kb = it >> 5, n0 = 32 * (it & 31); tr_item(W, 1024, 64 * kb, n0, P_WM_O, 1024, n0, scr, C.lane);
}
struct CvItem { const float* src; bf16* dst; int N, Kd; };
__device__ __forceinline__ CvItem convert_addr(KArgs ap, int layer, int it) {
    const int kind = layer % 3, j = layer / 3; CvItem r;
    if (it < 3 * 32 * 256) {
        const int which = it >> 13, rr = it & 8191, e = rr >> 8, q = rr & 255;
        if (which < 2) { const float* W = (which ? P_e_wu : P_e_wg) + (size_t)(layer * 32 + e) * 1024 * 512; const int kb = q >> 4, n0 = 32 * (q & 15);
            r.src = W + (size_t)(64 * kb) * 512 + n0; r.N = 512; r.dst = P_W1 + (size_t)(e * 1024 + 256 * (n0 >> 7) + 64 * ((n0 >> 5) & 3) + 32 * which) * 1024 + 64 * kb; r.Kd = 1024; }
        else { const float* W = P_e_wd + (size_t)(layer * 32 + e) * 512 * 1024; const int kb = q >> 5, n0 = 32 * (q & 31);
            r.src = W + (size_t)(64 * kb) * 1024 + n0; r.N = 1024; r.dst = P_W2 + (size_t)(e * 1024 + n0) * 512 + 64 * kb; r.Kd = 512; }
        return r;
    }
    it -= 3 * 32 * 256;
    const int nblk = kind == 0 ? 48 : 96;
    if (it < 16 * nblk) {
        const float* W; int N;
        if (kind == 0) { W = P_attn_w_qkv + (size_t)j * 1024 * 1536; N = 1536; }
        else if (kind == 1) { W = P_conv_w_in + (size_t)j * 1024 * 3072; N = 3072; }
        else { W = P_nat_w_qkv + (size_t)j * 1024 * 3072; N = 3072; }
        const int kb = it / nblk, n0 = 32 * (it % nblk); int drow0 = n0;
        if (kind == 1) { if (n0 < 1024) drow0 = 2048 + n0; else if (n0 < 2048) { const int jj = n0 - 1024; drow0 = 256 * (jj >> 7) + 64 * ((jj >> 5) & 3); } else { const int jj = n0 - 2048; drow0 = 256 * (jj >> 7) + 64 * ((jj >> 5) & 3) + 32; } }
        r.src = W + (size_t)(64 * kb) * N + n0; r.N = N; r.dst = P_WM_IN + (size_t)drow0 * 1024 + 64 * kb; r.Kd = 1024;
        return r;
    }
    it -= 16 * nblk;
    const float* W = (kind == 0 ? P_attn_w_o : kind == 1 ? P_conv_w_out : P_nat_w_o) + (size_t)j * 1024 * 1024;
    const int kb = it >> 5, n0 = 32 * (it & 31);
    r.src = W + (size_t)(64 * kb) * 1024 + n0; r.N = 1024; r.dst = P_WM_O + (size_t)n0 * 1024 + 64 * kb; r.Kd = 1024;
    return r;
}
__device__ __forceinline__ void tr_load(const CvItem& I, f32x4 (&wv)[8], int lane) {
    const float* p = I.src + (size_t)(lane >> 3) * I.N + 4 * (lane & 7);
#pragma unroll
    for (int i = 0; i < 8; ++i) wv[i] = __builtin_nontemporal_load((const f32x4*)(p + (size_t)(8 * i) * I.N));
}
__device__ __forceinline__ void tr_store(const CvItem& I, const f32x4 (&wv)[8], LAS float* scr, int lane) {
    LAS float* wp = scr + (lane >> 3) * 33 + 4 * (lane & 7);
#pragma unroll
    for (int i = 0; i < 8; ++i) { wp[(8 * i) * 33] = wv[i][0]; wp[(8 * i) * 33 + 1] = wv[i][1]; wp[(8 * i) * 33 + 2] = wv[i][2]; wp[(8 * i) * 33 + 3] = wv[i][3]; }
    LDS_WAIT(); asm volatile("" ::: "memory");
    const int c = lane & 7;
#pragma unroll
    for (int j = 0; j < 4; ++j) { const int n = (lane >> 3) + 8 * j; const LAS float* s = scr + (8 * c) * 33 + n;
        v4u o; o.x = pk2(s[0 * 33], s[1 * 33]); o.y = pk2(s[2 * 33], s[3 * 33]); o.z = pk2(s[4 * 33], s[5 * 33]); o.w = pk2(s[6 * 33], s[7 * 33]);
        pst16_nt(I.dst, ((size_t)n * I.Kd + 8 * c) * 2, o); }
    LDS_WAIT(); asm volatile("" ::: "memory");
}
__device__ __forceinline__ void convert_seq(KArgs ap, Ctx& C, int layer, int first, int stride, int hi) {
    LAS float* scr = (LAS float*)(C.lds + C.wave * 16384);
    if (first >= hi) return;
    f32x4 w0[8], w1[8], w2[8], w3[8]; CvItem i0, i1, i2, i3;
    int it = first;
    i0 = convert_addr(ap, layer, it); tr_load(i0, w0, C.lane);
    if (it + stride < hi) { i1 = convert_addr(ap, layer, it + stride); tr_load(i1, w1, C.lane); }
    if (it + 2 * stride < hi) { i2 = convert_addr(ap, layer, it + 2 * stride); tr_load(i2, w2, C.lane); }
#pragma unroll 1
    for (;;) {
        if (it + 3 * stride < hi) { i3 = convert_addr(ap, layer, it + 3 * stride); tr_load(i3, w3, C.lane); }
        tr_store(i0, w0, scr, C.lane);
        if (it + 4 * stride < hi) { i0 = convert_addr(ap, layer, it + 4 * stride); tr_load(i0, w0, C.lane); }
        if (it + stride >= hi) break;
        tr_store(i1, w1, scr, C.lane);
        if (it + 5 * stride < hi) { i1 = convert_addr(ap, layer, it + 5 * stride); tr_load(i1, w1, C.lane); }
        if (it + 2 * stride >= hi) break;
        tr_store(i2, w2, scr, C.lane);
        if (it + 6 * stride < hi) { i2 = convert_addr(ap, layer, it + 6 * stride); tr_load(i2, w2, C.lane); }
        if (it + 3 * stride >= hi) break;
        tr_store(i3, w3, scr, C.lane);
        it += 4 * stride;
        if (it >= hi) break;
    }
}
__device__ __forceinline__ void convert_pull(KArgs ap, Ctx& C, int layer, const unsigned* done) {
    LAS float* scr = (LAS float*)(C.lds + C.wave * 16384); volatile LAS int* slot = (volatile LAS int*)(C.lds + LDS_MISC + 64);
    const int nit = convert_nitems(layer); unsigned* qh = P_ctl + CW_Q + 64 * layer;
    for (;;) {
        if (C.tid == 0) { int base = -1;
            if (!(done && __hip_atomic_load(done, __ATOMIC_RELAXED, __HIP_MEMORY_SCOPE_AGENT) >= (unsigned)C.G)) { const unsigned b = __hip_atomic_fetch_add(qh, 16u, __ATOMIC_RELAXED, __HIP_MEMORY_SCOPE_AGENT); if (b < (unsigned)nit) base = (int)b; }
            slot[0] = base; }
        __syncthreads();
        const int base = __builtin_amdgcn_readfirstlane(slot[0]);
        if (base < 0) break;
#pragma unroll 1
        for (int k = 0; k < 2; ++k) { const int it = base + 8 * k + C.wave; if (it < nit) convert_item(ap, C, layer, it, scr); }
        __syncthreads();
    }
}
#ifndef FA0
#define FA0 10240
#endif
#ifndef FA12
#define FA12 0
#endif
#ifndef FA3
#define FA3 20480
#endif
#ifndef FB0
#define FB0 14336
#endif
#ifndef FB12
#define FB12 24576
#endif
__device__ __forceinline__ int fill_a(int layer) { return layer == 0 ? FA0 : layer == 3 ? FA3 : FA12; }
__device__ __forceinline__ int fill_b(int layer) { return layer == 0 ? FB0 : layer == DEPTH - 1 ? 0 : FB12; }
__device__ __forceinline__ void convert_rest(KArgs ap, Ctx& C, int layer) {
    convert_seq(ap, C, layer, fill_a(layer) + fill_b(layer) + C.gw, C.ngw, convert_nitems(layer));
}
__device__ __forceinline__ void convert_fill(KArgs ap, Ctx& C, int layer, int lo, int hi, int l0, int nl, int tl) {
    convert_seq(ap, C, layer, lo + l0 * 8 + C.wave, tl * 8, hi);
}
__device__ __forceinline__ void tail_convert(KArgs ap, Ctx& C, int layer_next, int phase) {
    unsigned* done = P_ctl + CW_DONE + 64 * phase;
    __syncthreads();
    if (C.tid == 0) __hip_atomic_fetch_add(done, 1u, __ATOMIC_RELAXED, __HIP_MEMORY_SCOPE_AGENT);
    convert_pull(ap, C, layer_next, done);
}
__device__ __forceinline__ void phase_hprep(KArgs ap, Ctx& C) {
    for (int row = C.gw; row < MTOT; row += C.ngw) {
        const float* xr = xin_row(ap, C, row); const float* md = P_mod + (size_t)row_bidx(row) * 6144;
#pragma unroll
        for (int i = 0; i < 4; ++i) { const int off = 4 * C.lane + 256 * i; const f32x4 x = *(const f32x4*)(xr + off), sh = *(const f32x4*)(md + off), sc = *(const f32x4*)(md + 1024 + off);
            const f32x4 h = x * (1.0f + sc) + sh; v2u w; w.x = pk2(h[0], h[1]); w.y = pk2(h[2], h[3]); pst8(P_H, ((size_t)row * D + off) * 2, w);
            pst8(P_X, ((size_t)row * D + off) * 2, __builtin_bit_cast(v2u, __builtin_convertvector(x, h16x4))); }
    }
}

__device__ __forceinline__ int crow(int r, int hi) { return (r & 3) + 8 * (r >> 2) + 4 * hi; }
__device__ __forceinline__ int clampi(int v, int lo, int hi) { return v < lo ? lo : (v > hi ? hi : v); }
#define MFMA32(a, b, c) __builtin_amdgcn_mfma_f32_32x32x16_bf16(a, b, c, 0, 0, 0)
struct TileArg { int a, kr, r_q, c_q, rs_q, qs_q; };
__device__ __forceinline__ int kidx(int reg, int hi) { return (reg & 3) + 4 * ((reg >> 2) & 1) + 8 * hi + 16 * (reg >> 3); }
template <int MODE, int FIX = 0>
__device__ __forceinline__ void attn_tile(f32x16& o0, f32x16& o1, float& m, float& l, const LAS unsigned char* ck, int koff, const bf16x8 (&qf)[4], int r32, int hi, const TileArg& T, const LAS float* bias, const float (&cmm)[16]) {
    const int row = koff + ((r32 & 3) | ((r32 & 4) << 1) | ((r32 & 8) >> 1) | (r32 & 16)); const LAS unsigned char* kp = ck + row * 128; const int sw = (row >> 1) & 7;
    const bf16x8 kf0 = *(const LAS bf16x8*)(kp + (((0 + hi) ^ sw) << 4)), kf1 = *(const LAS bf16x8*)(kp + (((2 + hi) ^ sw) << 4));
    const bf16x8 kf2 = *(const LAS bf16x8*)(kp + (((4 + hi) ^ sw) << 4)), kf3 = *(const LAS bf16x8*)(kp + (((6 + hi) ^ sw) << 4));
    const int c0 = (koff >> 3) + hi;
    const LAS unsigned char* vp0 = ck + 8192 + r32 * 128; const int sw0 = (r32 >> 1) & 7;
    const LAS unsigned char* vp1 = ck + 8192 + (32 + r32) * 128; const int sw1 = ((32 + r32) >> 1) & 7;
    const bf16x8 vf0 = *(const LAS bf16x8*)(vp0 + (((c0) ^ sw0) << 4)), vf1 = *(const LAS bf16x8*)(vp0 + (((c0 + 2) ^ sw0) << 4));
    const bf16x8 vf2 = *(const LAS bf16x8*)(vp1 + (((c0) ^ sw1) << 4)), vf3 = *(const LAS bf16x8*)(vp1 + (((c0 + 2) ^ sw1) << 4));
    __builtin_amdgcn_sched_barrier(0);
    f32x16 p;
#pragma unroll
    for (int r = 0; r < 16; ++r) p[r] = 0.f;
    p = MFMA32(kf0, qf[0], p); p = MFMA32(kf1, qf[1], p); p = MFMA32(kf2, qf[2], p); p = MFMA32(kf3, qf[3], p);
    if constexpr (MODE == 1) {
#pragma unroll
        for (int r = 0; r < 16; ++r) { const int d = T.a + kidx(r, hi); if (d > 128 || d < -128) p[r] = NEGBIG; }
    }
    if constexpr (MODE == 2) {
        const bool rowok = (T.kr >= T.rs_q) && (T.kr < T.rs_q + 8); const int drow = rowok ? T.kr - T.r_q + 7 : 15;
        const LAS float* bp = bias + 16 + drow * 31 + T.a;
#pragma unroll
        for (int r = 0; r < 16; ++r) p[r] = (p[r] + bp[(r & 3) + 4 * ((r >> 2) & 1) + 16 * (r >> 3)]) + cmm[r];
    }
    if constexpr (FIX == 0) {
        float tm = p[0];
#pragma unroll
        for (int r = 1; r < 16; ++r) tm = fmaxf(tm, p[r]);
        tm = xor32_max(tm);
        const float mn = fmaxf(m, tm), alpha = __builtin_amdgcn_exp2f(m - mn);
        float rs = 0.f;
#pragma unroll
        for (int r = 0; r < 16; ++r) { p[r] = __builtin_amdgcn_exp2f(p[r] - mn); rs += p[r]; }
        l = l * alpha + rs; m = mn;
#pragma unroll
        for (int r = 0; r < 16; ++r) { o0[r] *= alpha; o1[r] *= alpha; }
    } else {
        if constexpr (FIX == 1) {
            float tm = p[0];
#pragma unroll
            for (int r = 1; r < 16; ++r) tm = fmaxf(tm, p[r]);
            tm = xor32_max(tm);
            const float mn = fmaxf(m, tm); l *= __builtin_amdgcn_exp2f(m - mn); m = mn;
        }
        float rs = 0.f;
#pragma unroll
        for (int r = 0; r < 16; ++r) { p[r] = __builtin_amdgcn_exp2f(MODE == 2 ? p[r] : p[r] - m); rs += p[r]; }
        l += rs;
    }
    v4u w0, w1;
    w0.x = pk2c(p[0], p[1]); w0.y = pk2c(p[2], p[3]); w0.z = pk2c(p[4], p[5]); w0.w = pk2c(p[6], p[7]);
    w1.x = pk2c(p[8], p[9]); w1.y = pk2c(p[10], p[11]); w1.z = pk2c(p[12], p[13]); w1.w = pk2c(p[14], p[15]);
    const bf16x8 pb0 = __builtin_bit_cast(bf16x8, w0), pb1 = __builtin_bit_cast(bf16x8, w1);
    o0 = MFMA32(vf0, pb0, o0); o1 = MFMA32(vf2, pb0, o1);
    o0 = MFMA32(vf1, pb1, o0); o1 = MFMA32(vf3, pb1, o1);
}
__device__ __forceinline__ void attn_store(bf16* O, size_t rowq0, int hi16, int head, const f32x16& o0, const f32x16& o1, float l, int r32, int hi, LAS unsigned char* ost, int lane) {
    l = xor32_sum(l); const float inv = __builtin_amdgcn_rcpf(l);
    LAS unsigned char* wr_ = ost + r32 * 128;
#pragma unroll
    for (int g = 0; g < 4; ++g) { v2u w; w.x = pk2(o0[4 * g] * inv, o0[4 * g + 1] * inv); w.y = pk2(o0[4 * g + 2] * inv, o0[4 * g + 3] * inv);
        *(LAS v2u*)(wr_ + (((g) ^ (r32 & 7)) << 4) + 8 * hi) = w; }
#pragma unroll
    for (int g = 0; g < 4; ++g) { v2u w; w.x = pk2(o1[4 * g] * inv, o1[4 * g + 1] * inv); w.y = pk2(o1[4 * g + 2] * inv, o1[4 * g + 3] * inv);
        *(LAS v2u*)(wr_ + (((4 + g) ^ (r32 & 7)) << 4) + 8 * hi) = w; }
#pragma unroll
    for (int k = 0; k < 4; ++k) { const int row = 8 * k + (lane >> 3), pc = lane & 7;
        const v4u v = *(const LAS v4u*)(ost + row * 128 + ((pc ^ (row & 7)) << 4));
        gst16(O, ((rowq0 + (size_t)((row & 15) + (row >> 4) * hi16)) * D + head * 64 + 8 * pc) * 2, v); }
}
template <int KIND>
__device__ __forceinline__ size_t attn_rowq(int b, int part, int qi, int wave, int r32) {
    constexpr int NLATQ = KIND == 0 ? 8 : 4;
    if (KIND == 0) { if (qi < NLATQ) return (size_t)b * SEQ + 32 * (2 * (8 * part + qi) + (wave >> 2)) + r32; return (size_t)NLAT + b * CTXL + 64 * part + 32 * (wave >> 2) + r32; }
    if (qi < NLATQ) { const int r0 = 4 * (4 * part + qi) + 2 * (wave >> 2); return (size_t)b * SEQ + (r0 + (r32 >> 4)) * 64 + 16 * (wave & 3) + (r32 & 15); }
    return (size_t)NLAT + b * CTXL + 128 * part + 32 * (wave & 3) + r32;
}
constexpr int ATT_CTX_OFF = 0, ATT_BUF_OFF = 65536, ATT_OST_OFF = 100352, ATT_RPB_OFF = 133120;
template <int KIND>
__device__ __forceinline__ void phase_attn(KArgs ap, Ctx& C, int j, bool last) {
    const bf16* Q = P_R1; const bf16* Kb = P_R1 + (size_t)MTOT * D; const bf16* VTb = P_R1 + (size_t)2 * MTOT * D; bf16* O = P_R2;
    constexpr int NH = KIND == 0 ? 4 : 16, NLATQ = KIND == 0 ? 8 : 4, NUNITS = KIND == 0 ? 256 : 512;
    const int r32 = C.lane & 31, hi = C.lane >> 5, t = C.tid;
    const LAS unsigned char* ctxc = C.lds + ATT_CTX_OFF; LAS unsigned char* sbuf = C.lds + ATT_BUF_OFF; LAS float* rpb = (LAS float*)(C.lds + ATT_RPB_OFF);
    const int pr = t >> 3, pc = t & 7;
    const int kdst = pr * 128 + ((pc ^ ((pr >> 1) & 7)) << 4), vdst = 8192 + pr * 128 + ((pc ^ ((pr >> 1) & 7)) << 4);
    int par = 0;
    for (int unit = C.bid; unit < NUNITS; unit += C.G) {
        int b, h, part; if (KIND == 0) { b = unit >> 4; h = (unit >> 2) & 3; part = unit & 3; } else { b = unit >> 5; h = (unit >> 1) & 15; part = unit & 1; }
        const bf16* Kh = Kb + (size_t)(b * NH + h) * KVTOK * 64; const bf16* Vh = VTb + (size_t)(b * NH + h) * 64 * KVTOK;
        const bf16* kg = Kh + t * 8; const bf16* vg = Vh + (size_t)pr * KVTOK + pc * 8;
        __syncthreads();
#pragma unroll
        for (int cc = 0; cc < 4; ++cc) { const int tok0 = SEQ + 64 * cc; const v4u kv = *(const v4u*)(kg + (size_t)tok0 * 64), vv = *(const v4u*)(vg + tok0);
            *(LAS v4u*)(C.lds + ATT_CTX_OFF + cc * 16384 + kdst) = kv; *(LAS v4u*)(C.lds + ATT_CTX_OFF + cc * 16384 + vdst) = vv; }
        if (KIND == 2) {
            for (int e = t; e < 544; e += 512) rpb[e] = e < 16 ? 0.0f : (e < 16 + 465 ? P_nat_rpb[(size_t)(j * 16 + h) * 465 + (e - 16)] * LOG2E : NEGBIG); }
        __syncthreads();
        const int nqi = last ? NLATQ : NLATQ + 1;
        int qlo0, qhi0; if (KIND == 0) { const int qb = 8 * part; qlo0 = qb - 2 < 0 ? 0 : qb - 2; qhi0 = qb + 2 > 31 ? 31 : qb + 2; } else { const int quad = 4 * part; qlo0 = clampi(4 * quad - 4, 0, 24); qhi0 = clampi(4 * quad - 1, 0, 24) + 7; }
        v4u pk = *(const v4u*)(kg + (size_t)(64 * qlo0) * 64), pv = *(const v4u*)(vg + 64 * qlo0);
        const int headq = KIND == 0 ? 4 * h + (C.wave & 3) : h;
        bf16x8 qn[4];
        {   const size_t rq = attn_rowq<KIND>(b, part, 0, C.wave, r32);
#pragma unroll
            for (int s = 0; s < 4; ++s) qn[s] = *(const bf16x8*)(Q + rq * D + headq * 64 + 16 * s + 8 * hi); }
        for (int qi = 0; qi < nqi; ++qi) {
            const bool isctx = qi == NLATQ;
            int head, clo = 0, chi = -1; size_t rowq; bool active = true; TileArg T; T.a = 0; T.kr = 0; T.r_q = 0; T.c_q = 0; T.rs_q = 0; T.qs_q = 0;
            int qt = 0, wlo = 0, whi = -1, kc0 = 0;
            if (KIND == 0) {
                head = 4 * h + (C.wave & 3);
                if (!isctx) { const int qb = 8 * part + qi; clo = qb - 2 < 0 ? 0 : qb - 2; chi = qb + 2 > 31 ? 31 : qb + 2; qt = 2 * qb + (C.wave >> 2); rowq = (size_t)b * SEQ + 32 * qt + r32; }
                else rowq = (size_t)NLAT + b * CTXL + 64 * part + 32 * (C.wave >> 2) + r32;
            } else {
                head = h;
                if (!isctx) { const int quad = 4 * part + qi; clo = clampi(4 * quad - 4, 0, 24); chi = clampi(4 * quad - 1, 0, 24) + 7;
                    const int r0 = 4 * quad + 2 * (C.wave >> 2), cb = C.wave & 3; T.r_q = r0 + (r32 >> 4); T.c_q = 16 * cb + (r32 & 15); rowq = (size_t)b * SEQ + T.r_q * 64 + T.c_q;
                    T.rs_q = clampi(T.r_q - 4, 0, 24); T.qs_q = clampi(T.c_q - 8, 0, 48); wlo = clampi(r0 - 4, 0, 24); whi = clampi(r0 - 3, 0, 24) + 7; kc0 = clampi(16 * cb - 8, 0, 32); T.a = kc0 + 8 * hi - T.c_q + 15; }
                else { active = C.wave < 4; rowq = (size_t)NLAT + b * CTXL + 128 * part + 32 * (C.wave & 3) + r32; }
            }
            bf16x8 qf[4];
#pragma unroll
            for (int s = 0; s < 4; ++s) qf[s] = qn[s];
            if (qi + 1 < nqi) { const size_t rq = attn_rowq<KIND>(b, part, qi + 1, C.wave, r32);
#pragma unroll
                for (int s = 0; s < 4; ++s) qn[s] = *(const bf16x8*)(Q + rq * D + headq * 64 + 16 * s + 8 * hi); }
            f32x16 o0, o1; float cmm[16];
#pragma unroll
            for (int r = 0; r < 16; ++r) { o0[r] = 0.f; o1[r] = 0.f; cmm[r] = 0.f; }
            float m, l; if (KIND == 0) { m = P_attn_sink[j * 16 + head] * LOG2E; l = hi == 0 ? 1.0f : 0.0f; } else { m = NEGBIG; l = 0.0f; }
            if (active) {
                if (true) {
                    attn_tile<0, 1>(o0, o1, m, l, ctxc, 0, qf, r32, hi, T, rpb, cmm);
#pragma unroll 2
                    for (int jt = 1; jt < 8; ++jt) attn_tile<0, 2>(o0, o1, m, l, ctxc + (jt >> 1) * 16384, 32 * (jt & 1), qf, r32, hi, T, rpb, cmm);
                } else {
#pragma unroll 1
                    for (int jt = 0; jt < 8; ++jt) attn_tile<0>(o0, o1, m, l, ctxc + (jt >> 1) * 16384, 32 * (jt & 1), qf, r32, hi, T, rpb, cmm);
                }
            }
            if (KIND == 2 && !isctx) {
#pragma unroll
                for (int r = 0; r < 16; ++r) { const int kc = kc0 + kidx(r, hi); cmm[r] = ((kc >= T.qs_q && kc < T.qs_q + 16) ? 0.0f : NEGBIG) - m; }
            }
#pragma unroll 1
            for (int ch = clo; ch <= chi; ++ch) {
                LAS unsigned char* buf = sbuf + par * 16384;
                *(LAS v4u*)(buf + kdst) = pk; *(LAS v4u*)(buf + vdst) = pv;
                __syncthreads();
                {
                    int nch = ch + 1; bool ok = true;
                    if (nch > chi) { const int nq = qi + 1; if (nq < NLATQ) { if (KIND == 0) { const int qb = 8 * part + nq; nch = qb - 2 < 0 ? 0 : qb - 2; } else { const int quad = 4 * part + nq; nch = clampi(4 * quad - 4, 0, 24); } } else ok = false; }
                    if (ok) { pk = *(const v4u*)(kg + (size_t)(64 * nch) * 64); pv = *(const v4u*)(vg + 64 * nch); }
                }
                if (KIND == 0) {
#pragma unroll
                    for (int tau = 0; tau < 2; ++tau) { const int kt = 2 * ch + tau; if (kt >= qt - 4 && kt <= qt + 4) { T.a = 32 * kt - (32 * qt + r32); if (kt == qt - 4 || kt == qt + 4) attn_tile<1, 2>(o0, o1, m, l, buf, 32 * tau, qf, r32, hi, T, rpb, cmm); else attn_tile<0, 2>(o0, o1, m, l, buf, 32 * tau, qf, r32, hi, T, rpb, cmm); } }
                } else {
                    if (ch >= wlo && ch <= whi) { T.kr = ch; attn_tile<2, 2>(o0, o1, m, l, buf, kc0, qf, r32, hi, T, rpb, cmm); }
                }
                par ^= 1;
            }
            if (active) attn_store(O, rowq - (size_t)((r32 & 15) + (r32 >> 4) * ((KIND == 2 && !isctx) ? 64 : 16)), (KIND == 2 && !isctx) ? 64 : 16, head, o0, o1, l, r32, hi, C.lds + ATT_OST_OFF + C.wave * 4096, C.lane);
        }
    }
}
__device__ __forceinline__ void phase_conv(KArgs ap, Ctx& C, int j, bool last) {
    const bf16* Vc = P_R1; const bf16* GB = P_R1 + (size_t)MTOT * D; bf16* Z = P_R2; const float* cw = P_conv_w + (size_t)j * 3 * D;
    const int nrows = last ? NLAT : MTOT;
    const int rpw = nrows / C.ngw, r0 = C.gw * rpw;
    float w0[2][8], w1[2][8], w2[2][8];
#pragma unroll
    for (int i = 0; i < 2; ++i)
#pragma unroll
        for (int q = 0; q < 8; ++q) { const int c = 8 * C.lane + 512 * i + q; w0[i][q] = cw[c]; w1[i][q] = cw[D + c]; w2[i][q] = cw[2 * D + c]; }
    v4u va[2], vb[2], vc[2], g[2], vn[2], gn[2];
#pragma unroll
    for (int i = 0; i < 2; ++i) { const size_t o = (size_t)r0 * D + 8 * C.lane + 512 * i;
        va[i] = *(const v4u*)(Vc + (r0 > 0 ? o - D : o)); vb[i] = *(const v4u*)(Vc + o); vc[i] = *(const v4u*)(Vc + o + D); g[i] = *(const v4u*)(GB + o); }
#pragma unroll 1
    for (int k = 0; k < rpw; ++k) {
        const int row = r0 + k;
        if (k + 1 < rpw) {
#pragma unroll
            for (int i = 0; i < 2; ++i) { const size_t o = (size_t)(row + 1) * D + 8 * C.lane + 512 * i; vn[i] = *(const v4u*)(Vc + o + D); gn[i] = *(const v4u*)(GB + o); } }
        int pos, len; if (row < NLAT) { pos = row & 2047; len = SEQ; } else { pos = (row - NLAT) & 255; len = CTXL; }
        const bool hasm = pos > 0, hasp = pos < len - 1;
#pragma unroll
        for (int i = 0; i < 2; ++i) {
            v4u r;
#pragma unroll
            for (int q = 0; q < 4; ++q) {
                const unsigned am = hasm ? va[i][q] : 0u, cp = hasp ? vc[i][q] : 0u;
                const float lo = bflo(g[i][q]) * (w0[i][2 * q] * bflo(am) + w1[i][2 * q] * bflo(vb[i][q]) + w2[i][2 * q] * bflo(cp));
                const float hh = bfhi(g[i][q]) * (w0[i][2 * q + 1] * bfhi(am) + w1[i][2 * q + 1] * bfhi(vb[i][q]) + w2[i][2 * q + 1] * bfhi(cp));
                r[q] = pk2(lo, hh); }
            gst16(Z, ((size_t)row * D + 8 * C.lane + 512 * i) * 2, r);
            va[i] = vb[i]; vb[i] = vc[i]; vc[i] = vn[i]; g[i] = gn[i]; }
    }
}

__device__ __forceinline__ void wave_sum2(float& a, float& b) { a = wave_sum(a); b = wave_sum(b); }
__device__ __forceinline__ void phase_ln1(KArgs ap, Ctx& C, int layer, bool last, int dry = 0) {
    LAS float* WrT = (LAS float*)C.lds;
    LAS int* hist = (LAS int*)(C.lds + 147456);
    LAS int* gbase = hist + 32;
    LAS int* le = gbase + 32;
    LAS int* lr = le + 288;
    const float* wg = P_r_wg + (size_t)layer * 1024 * 4; const float* we = P_r_we + (size_t)layer * 1024 * 32;
    {
        f32x4 gq[2], eq[16];
#pragma unroll
        for (int j = 0; j < 2; ++j) gq[j] = *(const f32x4*)(wg + 4 * (j * 512 + C.tid));
#pragma unroll
        for (int j = 0; j < 16; ++j) eq[j] = *(const f32x4*)(we + 4 * (j * 512 + C.tid));
#pragma unroll
        for (int j = 0; j < 2; ++j) { const int k = j * 512 + C.tid;
#pragma unroll
            for (int q = 0; q < 4; ++q) WrT[q * 1024 + ((k + 4 * q) & 1023)] = gq[j][q]; }
#pragma unroll
        for (int j = 0; j < 16; ++j) { const int f = j * 512 + C.tid, k = f >> 3;
#pragma unroll
            for (int q = 0; q < 4; ++q) { const int o = 4 + 4 * (f & 7) + q; WrT[o * 1024 + ((k + 4 * o) & 1023)] = eq[j][q]; } }
    }
    if (C.tid < 32) hist[C.tid] = 0;
    __syncthreads();
    const int nrows = last ? NLAT : MTOT, rpb = nrows / C.G, rpw = rpb >> 3, row0 = C.bid * rpb;
    const bf16* Y = P_R3;
    f32x4 g1[4], b1[4];
#pragma unroll
    for (int i = 0; i < 4; ++i) { const int off = 4 * C.lane + 256 * i; g1[i] = *(const f32x4*)(P_ln1_g + layer * D + off); b1[i] = *(const f32x4*)(P_ln1_b + layer * D + off); }
    int curb = -1; f32x4 gt[4], sh[4], sc[4];
#pragma unroll
    for (int i = 0; i < 4; ++i) { gt[i] = (f32x4){0.f, 0.f, 0.f, 0.f}; sh[i] = gt[i]; sc[i] = gt[i]; }
    const int lbeg = C.wave * rpw, lend = lbeg + rpw;
    h16x4 pxh[2][4]; v2u pyv[2][4];
    {
#pragma unroll
        for (int rr = 0; rr < 2; ++rr) { const int row = row0 + lbeg + rr;
#pragma unroll
            for (int i = 0; i < 4; ++i) { const int off = 4 * C.lane + 256 * i; pxh[rr][i] = *(const h16x4*)(P_X + (size_t)row * D + off); pyv[rr][i] = *(const v2u*)(Y + (size_t)row * D + off); } }
    }
#pragma unroll 1
    for (int l0 = lbeg; l0 < lend; l0 += 2) {
        f32x4 xv[2][4]; v2u yv[2][4];
        {
#pragma unroll
            for (int rr = 0; rr < 2; ++rr)
#pragma unroll
                for (int i = 0; i < 4; ++i) { xv[rr][i] = __builtin_convertvector(pxh[rr][i], f32x4); yv[rr][i] = pyv[rr][i]; }
            if (l0 + 2 < lend) {
#pragma unroll
                for (int rr = 0; rr < 2; ++rr) { const int row = row0 + l0 + 2 + rr;
#pragma unroll
                    for (int i = 0; i < 4; ++i) { const int off = 4 * C.lane + 256 * i; pxh[rr][i] = *(const h16x4*)(P_X + (size_t)row * D + off); pyv[rr][i] = *(const v2u*)(Y + (size_t)row * D + off); } }
            }
        }
        float hv[2][16];
#pragma unroll
        for (int rr = 0; rr < 2; ++rr) {
            const int row = row0 + l0 + rr; const int bi = row_bidx(row);
            if (bi != curb) { curb = bi; const float* md = P_mod + (size_t)(layer * 17 + bi) * 6144;
#pragma unroll
                for (int i = 0; i < 4; ++i) { const int off = 4 * C.lane + 256 * i; gt[i] = *(const f32x4*)(md + 2 * 1024 + off); sh[i] = *(const f32x4*)(md + 3 * 1024 + off); sc[i] = *(const f32x4*)(md + 4 * 1024 + off); } }
            f32x4 v[4]; float s = 0.f;
#pragma unroll
            for (int i = 0; i < 4; ++i) { v[i] = xv[rr][i] * ALPHA + gt[i] * bf4(yv[rr][i]); s += (v[i][0] + v[i][1]) + (v[i][2] + v[i][3]); }
            const float mean = wave_sum(s) * (1.0f / D); float s2 = 0.f;
#pragma unroll
            for (int i = 0; i < 4; ++i) { v[i] = v[i] - mean; s2 += (v[i][0] * v[i][0] + v[i][1] * v[i][1]) + (v[i][2] * v[i][2] + v[i][3] * v[i][3]); }
            const float rstd = __builtin_amdgcn_rsqf(wave_sum(s2) * (1.0f / D) + LN_EPS);
#pragma unroll
            for (int i = 0; i < 4; ++i) { const int off = 4 * C.lane + 256 * i;
                const f32x4 xn = v[i] * rstd * g1[i] + b1[i]; stx4(ap, row, off, xn, dry);
                const f32x4 h = xn * (1.0f + sc[i]) + sh[i];
                hv[rr][4 * i] = h[0]; hv[rr][4 * i + 1] = h[1]; hv[rr][4 * i + 2] = h[2]; hv[rr][4 * i + 3] = h[3];
                v2u w; w.x = pk2(h[0], h[1]); w.y = pk2(h[2], h[3]); pst8(dry ? (bf16*)(ap->ws + WS_R1 + 80 * MiB) : P_H, ((size_t)row * D + off) * 2, w); }
        }
        float glg[2][4];
#pragma unroll
        for (int o = 0; o < 4; ++o) { float a0 = 0.f, a1 = 0.f;
#pragma unroll
            for (int i = 0; i < 4; ++i) { const f32x4 w = *(const LAS f32x4*)(WrT + o * 1024 + ((4 * C.lane + 256 * i + 4 * o) & 1023));
                a0 += w[0] * hv[0][4 * i] + w[1] * hv[0][4 * i + 1] + w[2] * hv[0][4 * i + 2] + w[3] * hv[0][4 * i + 3];
                a1 += w[0] * hv[1][4 * i] + w[1] * hv[1][4 * i + 1] + w[2] * hv[1][4 * i + 2] + w[3] * hv[1][4 * i + 3]; }
            wave_sum2(a0, a1); glg[0][o] = a0; glg[1][o] = a1; }
#pragma unroll
        for (int rr = 0; rr < 2; ++rr) {
            const int row = row0 + l0 + rr;
            float gl[4];
#pragma unroll
            for (int g = 0; g < 4; ++g) gl[g] = glg[rr][g] + P_r_bg[layer * 4 + g];
            int gi = 0; float gm = gl[0];
#pragma unroll
            for (int g = 1; g < 4; ++g) if (gl[g] > gm) { gm = gl[g]; gi = g; }
            gi = __builtin_amdgcn_readfirstlane(gi);
            float gsum = 0.f;
#pragma unroll
            for (int g = 0; g < 4; ++g) gsum += __builtin_amdgcn_exp2f((gl[g] - gm) * LOG2E);
            const float gprob = __builtin_amdgcn_rcpf(gsum);
            float el[8];
#pragma unroll
            for (int q = 0; q < 8; q += 2) { float a = 0.f, c = 0.f; const int o = 4 + gi * 8 + q;
#pragma unroll
                for (int i = 0; i < 4; ++i) { const f32x4 w = *(const LAS f32x4*)(WrT + o * 1024 + ((4 * C.lane + 256 * i + 4 * o) & 1023)), w2 = *(const LAS f32x4*)(WrT + (o + 1) * 1024 + ((4 * C.lane + 256 * i + 4 * (o + 1)) & 1023));
                    a += w[0] * hv[rr][4 * i] + w[1] * hv[rr][4 * i + 1] + w[2] * hv[rr][4 * i + 2] + w[3] * hv[rr][4 * i + 3];
                    c += w2[0] * hv[rr][4 * i] + w2[1] * hv[rr][4 * i + 1] + w2[2] * hv[rr][4 * i + 2] + w2[3] * hv[rr][4 * i + 3]; }
                wave_sum2(a, c); el[q] = a + P_r_be[layer * 32 + gi * 8 + q]; el[q + 1] = c + P_r_be[layer * 32 + gi * 8 + q + 1]; }
            int i0 = 0; float v0 = el[0];
#pragma unroll
            for (int q = 1; q < 8; ++q) if (el[q] > v0) { v0 = el[q]; i0 = q; }
            int i1 = -1; float v1 = -3.0e38f;
#pragma unroll
            for (int q = 0; q < 8; ++q) if (q != i0 && el[q] > v1) { v1 = el[q]; i1 = q; }
            const float e1 = __builtin_amdgcn_exp2f((v1 - v0) * LOG2E), p0 = __builtin_amdgcn_rcpf(1.0f + e1), p1 = e1 * p0;
            if (C.lane == 0 && !dry) { const int lrow = l0 + rr;
                P_r_eid[row * 2] = gi * 8 + i0; P_r_eid[row * 2 + 1] = gi * 8 + i1; P_r_gate[row * 2] = p0 * gprob; P_r_gate[row * 2 + 1] = p1 * gprob;
                le[lrow * 2] = gi * 8 + i0; le[lrow * 2 + 1] = gi * 8 + i1; }
        }
    }
    __syncthreads();
    if (dry) return;
    const int nas = 2 * rpb;
    if (C.tid < nas) lr[C.tid] = __hip_atomic_fetch_add(&hist[le[C.tid]], 1, __ATOMIC_RELAXED, __HIP_MEMORY_SCOPE_WORKGROUP);
    __syncthreads();
    if (C.tid < 32) gbase[C.tid] = (int)__hip_atomic_fetch_add(P_ctl + CW_CNT + 64 * layer + C.tid, (unsigned)hist[C.tid], __ATOMIC_RELAXED, __HIP_MEMORY_SCOPE_AGENT);
    __syncthreads();
    if (C.tid < nas) { const int e = le[C.tid], rk = gbase[e] + lr[C.tid]; P_r_rank[row0 * 2 + C.tid] = rk; P_tokrow[(size_t)e * TOKCAP + rk] = row0 + (C.tid >> 1); }
}
__device__ __noinline__ int moe_offsets_impl(const GAS unsigned* cnts, LAS int* poffs, LAS int* tile_e, int tid) {
    if (tid < 64) {
        const int e = tid & 31; const int cnt = (int)cnts[e]; const int nt = (cnt + 255) >> 8;
        int incl = nt;
#pragma unroll
        for (int o = 1; o < 32; o <<= 1) { const int v = __shfl_up(incl, o, 32); if (e >= o) incl += v; }
        const int first = incl - nt;
        if (tid < 32) { poffs[e] = first * 256; if (e == 31) poffs[32] = incl * 256; tile_e[400 + e] = cnt;
#pragma nounroll
            for (int k = 0; k < nt; ++k) tile_e[first + k] = e; }
    }
    __syncthreads();
    return __builtin_amdgcn_readfirstlane(poffs[32]) >> 8;
}
__device__ __forceinline__ int moe_offsets(KArgs ap, Ctx& C, int layer, LAS int* poffs, LAS int* tile_e) { return __builtin_amdgcn_readfirstlane(moe_offsets_impl((const GAS unsigned*)(P_ctl + CW_CNT + 64 * layer), poffs, tile_e, C.tid)); }
__device__ __forceinline__ void moe_rows(KArgs ap, Ctx& C, int layer, const LAS int* poffs, const LAS int* tile_e, LAS int* rows, int ntiles) {
    if (C.tid < 256) {
        int val[5];
#pragma unroll
        for (int ui = 0; ui < 5; ++ui) { const int tile = ui * 64 + (C.bid & 7) * 8 + (C.bid >> 5); val[ui] = 0;
            if (tile < ntiles) { const int e = tile_e[tile], r = tile * 256 - poffs[e] + C.tid, cnt = tile_e[400 + e];
                if (r < cnt) val[ui] = P_tokrow[(size_t)e * TOKCAP + r]; } }
#pragma unroll
        for (int ui = 0; ui < 5; ++ui) { const int tile = ui * 64 + (C.bid & 7) * 8 + (C.bid >> 5); if (tile < ntiles) rows[ui * 256 + C.tid] = val[ui]; }
    }
    __syncthreads();
}
__device__ __forceinline__ void phase_ln2(KArgs ap, Ctx& C, int layer, bool last, int dry = 0) {
    LAS int* poffs = (LAS int*)(C.lds + LDS_MOE); LAS int* tile_e = poffs + 64;
    moe_offsets(ap, C, layer, poffs, tile_e);
    const int nrows = last ? NLAT : MTOT, rpw = nrows / C.ngw, r0 = C.gw * rpw; const bf16* ys = P_R3;
    int ld0 = 0, ld1 = 0; float lg0 = 0.f, lg1 = 0.f;
    if (C.lane < rpw) { const int row = r0 + C.lane; ld0 = poffs[P_r_eid[row * 2]] + P_r_rank[row * 2]; ld1 = poffs[P_r_eid[row * 2 + 1]] + P_r_rank[row * 2 + 1]; lg0 = P_r_gate[row * 2]; lg1 = P_r_gate[row * 2 + 1]; }
#define LN2_OFF(j) (8 * C.lane + 512 * ((j) >> 1) + 4 * ((j) & 1))
    f32x4 g2[4], b2[4];
#pragma unroll
    for (int j = 0; j < 4; ++j) { g2[j] = *(const f32x4*)(P_ln2_g + layer * D + LN2_OFF(j)); b2[j] = *(const f32x4*)(P_ln2_b + layer * D + LN2_OFF(j)); }
    int curb = -1; f32x4 gt[4], sh[4], sc[4];
#pragma unroll
    for (int j = 0; j < 4; ++j) { gt[j] = (f32x4){0.f, 0.f, 0.f, 0.f}; sh[j] = gt[j]; sc[j] = gt[j]; }
    h16x8 px[2][2]; v4u pa[2][2], pb[2][2];
#pragma unroll
    for (int rr = 0; rr < 2; ++rr) { const int row = r0 + rr; const int d0 = __builtin_amdgcn_readlane(ld0, rr), d1 = __builtin_amdgcn_readlane(ld1, rr);
#pragma unroll
        for (int i = 0; i < 2; ++i) { const int off = 8 * C.lane + 512 * i; px[rr][i] = *(const h16x8*)(P_X + (size_t)row * D + off); pa[rr][i] = *(const v4u*)(ys + (size_t)d0 * D + off); pb[rr][i] = *(const v4u*)(ys + (size_t)d1 * D + off); } }
#pragma unroll 1
    for (int it = 0; it < rpw; it += 2) {
        f32x4 xv[2][4], ya[2][4], yb[2][4]; float gg[2][2];
#pragma unroll
        for (int rr = 0; rr < 2; ++rr) { gg[rr][0] = __builtin_bit_cast(float, __builtin_amdgcn_readlane(__builtin_bit_cast(int, lg0), it + rr)); gg[rr][1] = __builtin_bit_cast(float, __builtin_amdgcn_readlane(__builtin_bit_cast(int, lg1), it + rr));
#pragma unroll
            for (int i = 0; i < 2; ++i) {
                xv[rr][2 * i] = __builtin_convertvector(__builtin_shufflevector(px[rr][i], px[rr][i], 0, 1, 2, 3), f32x4); xv[rr][2 * i + 1] = __builtin_convertvector(__builtin_shufflevector(px[rr][i], px[rr][i], 4, 5, 6, 7), f32x4);
                ya[rr][2 * i] = bf4((v2u){pa[rr][i].x, pa[rr][i].y}); ya[rr][2 * i + 1] = bf4((v2u){pa[rr][i].z, pa[rr][i].w});
                yb[rr][2 * i] = bf4((v2u){pb[rr][i].x, pb[rr][i].y}); yb[rr][2 * i + 1] = bf4((v2u){pb[rr][i].z, pb[rr][i].w}); } }
        if (it + 2 < rpw) {
#pragma unroll
            for (int rr = 0; rr < 2; ++rr) { const int row = r0 + it + 2 + rr; const int d0 = __builtin_amdgcn_readlane(ld0, it + 2 + rr), d1 = __builtin_amdgcn_readlane(ld1, it + 2 + rr);
#pragma unroll
                for (int i = 0; i < 2; ++i) { const int off = 8 * C.lane + 512 * i; px[rr][i] = *(const h16x8*)(P_X + (size_t)row * D + off); pa[rr][i] = *(const v4u*)(ys + (size_t)d0 * D + off); pb[rr][i] = *(const v4u*)(ys + (size_t)d1 * D + off); } }
        }
#pragma unroll
        for (int rr = 0; rr < 2; ++rr) {
            const int row = r0 + it + rr; const int bi = row_bidx(row);
            if (bi != curb) { curb = bi; const float* md = P_mod + (size_t)(layer * 17 + bi) * 6144; const float* md2 = P_mod + (size_t)((layer + 1 < DEPTH ? layer + 1 : layer) * 17 + bi) * 6144;
#pragma unroll
                for (int j = 0; j < 4; ++j) { gt[j] = *(const f32x4*)(md + 5 * 1024 + LN2_OFF(j)); sh[j] = *(const f32x4*)(md2 + LN2_OFF(j)); sc[j] = *(const f32x4*)(md2 + 1024 + LN2_OFF(j)); } }
            f32x4 v[4]; float s = 0.f;
#pragma unroll
            for (int j = 0; j < 4; ++j) { v[j] = xv[rr][j] * ALPHA + gt[j] * (ya[rr][j] * gg[rr][0] + yb[rr][j] * gg[rr][1]); s += (v[j][0] + v[j][1]) + (v[j][2] + v[j][3]); }
            const float mean = wave_sum(s) * (1.0f / D); float s2 = 0.f;
#pragma unroll
            for (int j = 0; j < 4; ++j) { v[j] = v[j] - mean; s2 += (v[j][0] * v[j][0] + v[j][1] * v[j][1]) + (v[j][2] * v[j][2] + v[j][3] * v[j][3]); }
            const float rstd = __builtin_amdgcn_rsqf(wave_sum(s2) * (1.0f / D) + LN_EPS);
            f32x4 xn[4];
#pragma unroll
            for (int j = 0; j < 4; ++j) xn[j] = v[j] * rstd * g2[j] + b2[j];
            if (last) {
#pragma unroll
                for (int j = 0; j < 4; ++j) *(f32x4*)((dry ? (float*)(ap->ws + WS_R1) : P_out) + (size_t)row * D + LN2_OFF(j)) = xn[j];
            } else {
#pragma unroll
                for (int i = 0; i < 2; ++i) { const int off = 8 * C.lane + 512 * i;
                    const h16x4 xa = __builtin_convertvector(xn[2 * i], h16x4), xb = __builtin_convertvector(xn[2 * i + 1], h16x4);
                    pst16(dry ? (f16*)(ap->ws + WS_R1) : P_X, ((size_t)row * D + off) * 2, __builtin_bit_cast(v4u, __builtin_shufflevector(xa, xb, 0, 1, 2, 3, 4, 5, 6, 7)));
                    const f32x4 ha = xn[2 * i] * (1.0f + sc[2 * i]) + sh[2 * i], hb = xn[2 * i + 1] * (1.0f + sc[2 * i + 1]) + sh[2 * i + 1];
                    v4u w; w.x = pk2(ha[0], ha[1]); w.y = pk2(ha[2], ha[3]); w.z = pk2(hb[0], hb[1]); w.w = pk2(hb[2], hb[3]);
                    pst16(dry ? (bf16*)(ap->ws + WS_R1 + 80 * MiB) : P_H, ((size_t)row * D + off) * 2, w); }
            }
        }
    }
#undef LN2_OFF
}

__device__ __forceinline__ Ctx fresh(const Ctx& C) { Ctx R = C; const int ln = lane_id_fresh(); R.lane = ln; R.tid = C.wave * 64 + ln; return R; }
constexpr int NPH_LAYER = 8, NPHASES = 1 + DEPTH * NPH_LAYER;
__global__ void __launch_bounds__(512, 2) mk_fwd(Args args) {
    extern __shared__ __attribute__((aligned(16))) unsigned char lds_raw[];
    Ctx C;
    C.lds = (LAS unsigned char*)lds_raw; C.tid = threadIdx.x; C.lane = C.tid & 63; C.wave = __builtin_amdgcn_readfirstlane(C.tid >> 6); C.G = gridDim.x; C.bid = blockIdx.x;
    C.gw = C.bid * 8 + C.wave; C.ngw = C.G * 8;
    volatile LAS unsigned* MISC = (volatile LAS unsigned*)(C.lds + LDS_MISC);
    if (C.tid < 64) MISC[C.tid] = 0u;
    __syncthreads();
    const int lo = args.ph_lo, hi = args.ph_hi;
    XcdBarrier bar; { const KArgs ap = kargs(); bar.bar = P_ctl + CW_BAR; bar.x = 0; bar.st = nullptr; if (hi - lo > 1) bar = xcd_barrier_post(P_ctl + CW_BAR, MISC + 8); }
#ifndef PHMASK
#define PHMASK 0xFFFFFFFFu
#endif
#ifndef REP_GEMM
#define REP_GEMM 1
#endif
#ifndef REP_G3
#define REP_G3 REP_GEMM
#endif
#ifndef REP_G4
#define REP_G4 REP_GEMM
#endif
#ifndef REP_G8
#define REP_G8 REP_GEMM
#endif
#ifndef REP_G11
#define REP_G11 REP_GEMM
#endif
#ifndef REP_G12
#define REP_G12 REP_GEMM
#endif
#ifndef DRY_LN1
#define DRY_LN1 0
#endif
#ifndef DRY_LN2
#define DRY_LN2 0
#endif
#ifndef COLD_CONV
#define COLD_CONV 0
#endif
#ifndef NOSTORE_PROBE
#define NOSTORE_PROBE 0
#endif
#ifndef REP_ATTN
#define REP_ATTN 1
#endif
#ifndef REP_MEM
#define REP_MEM 1
#endif
#define REPEAT(n) _Pragma("nounroll") for (int rep_ = 0; rep_ < (n); ++rep_)
#define IN(k) (lo <= (k) && (k) < hi)
#define EN(b) ((PHMASK >> (b)) & 1u)
#define SEAM(k) do { if ((k) + 1 < hi) xcd_barrier(bar); } while (0)
    LAS unsigned char* ring = C.lds;

    if (IN(0)) { if (EN(0)) REPEAT(REP_MEM) { Ctx Cx = fresh(C); phase_mod(kargs(), Cx); __syncthreads(); } __syncthreads(); if (EN(1)) { Ctx Cx = fresh(C); convert_rest(kargs(), Cx, 0); } SEAM(0); }
#pragma nounroll
    for (int layer = 0; layer < DEPTH; ++layer) {
        const int base = 1 + NPH_LAYER * layer, kind = layer % 3, j = layer / 3; const bool last = layer == DEPTH - 1;
        const int nrows = last ? NLAT : MTOT;
        if (IN(base + 0)) { if (layer == 0) { Ctx Cx = fresh(C); if (EN(2)) REPEAT(REP_MEM) phase_hprep(kargs(), Cx); SEAM(base + 0); } }
        if (IN(base + 1)) {
            int fl_pre = -1, fl_post = -1; const int ftl = kind == 0 ? 160 : 64;
            { const int b_ = C.bid, odd = (b_ >> 3) & 1; int l1 = -1;
              if (kind == 0) { if (b_ >= 208) { fl_pre = 64 + 2 * (b_ - 208); fl_post = fl_pre + 1; } else if (b_ >= 144) l1 = b_ - 144; }
              else if (kind == 1) { if (b_ >= 192) l1 = b_ - 192; }
              else if (b_ >= 128 && b_ < 192) l1 = b_ - 128;
              if (l1 >= 0) { if (odd) fl_pre = l1; else fl_post = l1; } }
            if (EN(1) && fl_pre >= 0) { Ctx Cx = fresh(C); convert_fill(kargs(), Cx, layer, 0, fill_a(layer), fl_pre, 1, ftl); __syncthreads(); }
            if (kind != 1 && EN(3)) REPEAT(REP_G3) {
                const KArgs ap = kargs();
                const int nq = kind == 0 ? 1280 : 2048;
                pg8::Gemm g{P_H, P_WM_IN, MTOT, nq, D}; pg8::StaticOrder S; S.init(MTOT, nq, C.G, C.bid);
                pg8::EpiQK E{P_R1, P_R1 + (size_t)MTOT * D, kind == 0 ? P_rope : nullptr, kind == 0 ? 4 : 16, QSCALE};
                pg8::gemm_phase<pg8::EpiQK, pg8::StaticOrder, true, true>(ring, g, S, E, C.wave);
            }
            if (EN(4)) REPEAT(REP_G4) {
                const KArgs ap = kargs();
                pg8::Gemm g; pg8::StaticOrder S; pg8::EpiP<2> E;
                if (kind == 1) { g = pg8::Gemm{P_H, P_WM_IN, MTOT, 3072, D}; S.init(MTOT, 3072, C.G, C.bid); E = pg8::EpiP<2>{P_R1, P_R1 + (size_t)MTOT * D, D, -1, 1, 0}; }
                else { const int nq = kind == 0 ? 1280 : 2048, nv = kind == 0 ? 256 : 1024; g = pg8::Gemm{P_WM_IN + (size_t)nq * D, P_H, nv, MTOT, D}; S.init(nv, MTOT, C.G, kind == 2 ? C.G - 1 - C.bid : C.bid);     E = pg8::EpiP<2>{P_R1 + (size_t)2 * MTOT * D, nullptr, 0, -1, 0, kind == 0 ? 4 : 16}; }
                pg8::gemm_phase<pg8::EpiP<2>, pg8::StaticOrder, true, true>(ring, g, S, E, C.wave);
            }
            if (EN(1) && fl_post >= 0) { __syncthreads(); Ctx Cx = fresh(C); convert_fill(kargs(), Cx, layer, 0, fill_a(layer), fl_post, 1, ftl); }
            SEAM(base + 1);
        }
        if (IN(base + 2)) { Ctx Cx = fresh(C); if (kind == 0) { if (EN(5)) REPEAT(REP_ATTN) phase_attn<0>(kargs(), Cx, j, last); } else if (kind == 1) { if (EN(6)) REPEAT(REP_ATTN) phase_conv(kargs(), Cx, j, last); } else if (EN(7)) REPEAT(REP_ATTN) phase_attn<2>(kargs(), Cx, j, last); SEAM(base + 2); }
        if (IN(base + 3)) {
            if (!last && EN(1) && C.bid >= 64 && ((C.bid >> 3) & 1)) {
                Ctx Cx = fresh(C);
                convert_fill(kargs(), Cx, layer, fill_a(layer), fill_a(layer) + fill_b(layer), C.bid - 64, 1, 192);
                __syncthreads();
            }
            if (EN(8)) REPEAT(REP_G8) {
                const KArgs ap = kargs();
                pg8::Gemm g{P_R2, P_WM_O, nrows, D, D}; pg8::StaticOrder S; S.init(nrows, D, C.G, C.bid);
                pg8::EpiP<0> E{P_R3, nullptr, D, -1, 0, 0};
                if (NOSTORE_PROBE) { pg8::EpiP<9> E9{P_R3, nullptr, D, -1, 0, 0}; pg8::gemm_phase<pg8::EpiP<9>, pg8::StaticOrder, true, true>(ring, g, S, E9, C.wave); }
                pg8::gemm_phase<pg8::EpiP<0>, pg8::StaticOrder, true, true>(ring, g, S, E, C.wave);
            }
            if (!last && EN(1) && C.bid >= 64 && !((C.bid >> 3) & 1)) {
                __syncthreads(); Ctx Cx = fresh(C);
                convert_fill(kargs(), Cx, layer, fill_a(layer), fill_a(layer) + fill_b(layer), C.bid - 64, 1, 192);
            }
            SEAM(base + 3);
        }
        if (IN(base + 4)) { Ctx Cx = fresh(C); if (EN(9)) { if (DRY_LN1) { phase_ln1(kargs(), Cx, layer, last, 1); __syncthreads(); } phase_ln1(kargs(), Cx, layer, last); } SEAM(base + 4); }
        if (IN(base + 5)) {
            if (EN(11)) REPEAT(REP_G11) {
                const KArgs ap = kargs(); Ctx Cx = fresh(C);
                LAS int* poffs = (LAS int*)(C.lds + LDS_MOE); LAS int* tile_e = poffs + 64; LAS int* rows = poffs + 512;
                const int ntiles = moe_offsets(ap, Cx, layer, poffs, tile_e);
                moe_rows(ap, Cx, layer, poffs, tile_e, rows, ntiles);
                pg8::Gemm g{P_H, P_W1, MTOT, NEXP * 1024, D}; pg8::MoeOrder S{(const LAS int*)tile_e, (const LAS int*)rows, ntiles, C.bid};
                pg8::EpiP<1> E{P_R2, nullptr, EFF, 3, 0, 0};
                pg8::gemm_phase<pg8::EpiP<1>, pg8::MoeOrder, true, true, true>(ring, g, S, E, C.wave);
            }
            SEAM(base + 5);
        }
        if (IN(base + 6)) {
            if (EN(12)) REPEAT(REP_G12) {
                const KArgs ap = kargs(); Ctx Cx = fresh(C);
                LAS int* poffs = (LAS int*)(C.lds + LDS_MOE); LAS int* tile_e = poffs + 64;
                const int ntiles = moe_offsets(ap, Cx, layer, poffs, tile_e);
                pg8::Gemm g{P_R2, P_W2, ntiles * 256, NEXP * 1024, EFF}; pg8::MoeOrder S{(const LAS int*)tile_e, (const LAS int*)tile_e, ntiles, C.bid};
                pg8::EpiP<0> E{P_R3, nullptr, D, 3, 0, 0};
                pg8::gemm_phase<pg8::EpiP<0>, pg8::MoeOrder, true, true, false, true>(ring, g, S, E, C.wave);
            }
            SEAM(base + 6);
        }
        if (IN(base + 7)) { Ctx Cx = fresh(C); if (EN(13)) { if (DRY_LN2) { phase_ln2(kargs(), Cx, layer, last, 1); __syncthreads(); } phase_ln2(kargs(), Cx, layer, last); } if (!last && EN(1)) { __syncthreads(); convert_rest(kargs(), Cx, layer + 1); } SEAM(base + 7); }
    }
#undef IN
#undef SEAM
}

#ifndef MK_ONE_LAUNCH
#define MK_ONE_LAUNCH 1
#endif
extern "C" void kernel_launch(void* const* d_in, const int* in_sizes, int n_in, void* d_out, int out_size, void* d_ws, size_t ws_size, hipStream_t stream) {
    static int grid = 0;
    if (grid == 0) {
        if (n_in != 26 || in_sizes[0] != NLAT * D || out_size != NLAT * D || ws_size < WS_END) { fprintf(stderr, "kernel_launch: unexpected shapes (n_in %d, in0 %d, out %d, ws %zu < %zu); nothing launched\n", n_in, n_in > 0 ? in_sizes[0] : -1, out_size, ws_size, (size_t)WS_END); grid = -1; return; }
        int dev = 0, cus = 0, per_cu = 0;
        if (hipGetDevice(&dev) != hipSuccess || hipDeviceGetAttribute(&cus, hipDeviceAttributeMultiprocessorCount, dev) != hipSuccess) { fprintf(stderr, "kernel_launch: device query failed\n"); grid = -1; return; }
        if (hipFuncSetAttribute((const void*)mk_fwd, hipFuncAttributeMaxDynamicSharedMemorySize, LDS_BYTES) != hipSuccess) { fprintf(stderr, "kernel_launch: hipFuncSetAttribute failed\n"); grid = -1; return; }
        if (hipOccupancyMaxActiveBlocksPerMultiprocessor(&per_cu, (const void*)mk_fwd, 512, LDS_BYTES) != hipSuccess || per_cu < 1) { fprintf(stderr, "kernel_launch: occupancy query reports %d workgroups per CU\n", per_cu); }
        (void)hipGetLastError();
        grid = 256;
        if (cus < 256) { fprintf(stderr, "kernel_launch: %d CUs < 256: the grid would not be resident; nothing launched\n", cus); grid = -1; return; }
    }
    if (grid < 0) return;
    if (hipMemsetAsync((char*)d_ws + WS_CTL, 0, CTL_ZERO_BYTES, stream) != hipSuccess) { fprintf(stderr, "kernel_launch: hipMemsetAsync failed\n"); return; }
    Args a{};
    for (int i = 0; i < 26; ++i) a.in[i] = (const float*)d_in[i];
    a.out = (float*)d_out; a.ws = (unsigned char*)d_ws;
#if MK_ONE_LAUNCH
    a.ph_lo = 0; a.ph_hi = NPHASES;
    hipLaunchKernelGGL(mk_fwd, dim3(grid), dim3(512), LDS_BYTES, stream, a);
#else
    for (int p = 0; p < NPHASES; ++p) { a.ph_lo = p; a.ph_hi = p + 1; hipLaunchKernelGGL(mk_fwd, dim3(grid), dim3(512), LDS_BYTES, stream, a); }
#endif
    const hipError_t le = hipPeekAtLastError();
    if (le != hipSuccess) fprintf(stderr, "kernel_launch: launch failed: %s\n", hipGetErrorName(le));
}
```

```cpp
#include <hip/hip_runtime.h>
#include <cstdio>
#include <cstdint>

constexpr int D = 1024, NB = 16, SEQ = 2048, CTXL = 256, DEPTH = 4;
constexpr int NLAT = NB * SEQ;
constexpr int NCTX = NB * CTXL;
constexpr int MTOT = NLAT + NCTX;
constexpr int KVTOK = SEQ + CTXL;
constexpr int NEXP = 32, EFF = 512;
constexpr float LN_EPS = 1e-5f;
constexpr float ALPHA = 1.681792830507429f;
constexpr float LOG2E = 1.4426950408889634f;
constexpr float QSCALE = 0.125f * LOG2E;
constexpr float NEGBIG = -1e30f;
namespace pg8 {
#define PG8_LAS __attribute__((address_space(3)))
typedef unsigned short bf16_t;
typedef short bf16x8 __attribute__((ext_vector_type(8)));
typedef float f32x4 __attribute__((ext_vector_type(4)));
typedef unsigned u32x4 __attribute__((ext_vector_type(4)));
constexpr int BM = 256, BK = 64, HALF = 128, HTB = HALF * BK * 2  , STAGE_BYTES = 8 * HTB, NXCD = 8, WGM = 8;

__host__ __device__ __forceinline__ int lds_byte(int r, int c) { const int st = (r >> 4) * 2 + (c >> 5), rr = r & 15, cc = c & 31, ob = rr * 64 + cc * 2; return st * 1024 + (ob ^ (((ob >> 9) & 1) << 5)); }
__host__ __device__ __forceinline__ void stage_rc(int b, int& R, int& C) { const int st = b / 1024, sb = b % 1024, swz = sb ^ (((sb >> 9) & 1) << 5); R = (st >> 1) * 16 + swz / 64; C = (st & 1) * 32 + (swz % 64) / 2; }
__host__ __device__ __forceinline__ int perm32(int rho) { const int n = rho >> 4, i = rho & 15; return 8 * (i >> 2) + 4 * n + (i & 3); }

struct Unit { int pm, pn; };
struct Gemm { const bf16_t* A; const bf16_t* Bt; int M, N, K; };

struct StaticOrder {
    int nM, nN, nwg, G, c;
    __host__ __device__ void init(int M, int N, int G_, int c_) { nM = M / BM; nN = N / BM; nwg = nM * nN; G = G_; c = c_; }
    __host__ __device__ bool next(int i, Unit& u) const {
        const long L = (long)i * G + c; if (L >= nwg) return false;
        int wgid = (int)L; { const int q = nwg / NXCD, r = nwg % NXCD, xcd = wgid % NXCD, off = wgid / NXCD; wgid = (xcd < r ? xcd * (q + 1) : r * (q + 1) + (xcd - r) * q) + off; }
        const int nig = WGM * nN, gid = wgid / nig, fm = gid * WGM, gsz = (nM - fm) < WGM ? (nM - fm) : WGM;
        u.pm = fm + ((wgid % nig) % gsz); u.pn = (wgid % nig) / gsz; return true;
    }
    __device__ __forceinline__ void a_ready(const Unit&) const {}
    __device__ __forceinline__ void done(const Unit&) const {}
};


__device__ __forceinline__ unsigned cvt_pk_bf16(float lo, float hi) { unsigned r; asm volatile("v_cvt_pk_bf16_f32 %0, %1, %2" : "=v"(r) : "v"(lo), "v"(hi)); return r; }
typedef unsigned u32x2 __attribute__((ext_vector_type(2)));
__device__ __forceinline__ u32x2 pk4(const f32x4 v) { u32x2 w; w.x = cvt_pk_bf16(v[0], v[1]); w.y = cvt_pk_bf16(v[2], v[3]); return w; }
__device__ __forceinline__ u32x4 pk8(const f32x4 a, const f32x4 b) { u32x4 w; w.x = cvt_pk_bf16(a[0], a[1]); w.y = cvt_pk_bf16(a[2], a[3]); w.z = cvt_pk_bf16(b[0], b[1]); w.w = cvt_pk_bf16(b[2], b[3]); return w; }
#ifndef WT_STORES
#define WT_STORES 1
#endif
__device__ __forceinline__ void st16(bf16_t* p, const u32x4 v) {
#if WT_STORES
    asm volatile("global_store_dwordx4 %0, %1, off sc1\n\ts_nop 1" :: "v"(p), "v"(v) : "memory");
#else
    *(u32x4*)p = v;
#endif
}
__device__ __forceinline__ void st8(bf16_t* p, const u32x2 v) {
#if WT_STORES
    asm volatile("global_store_dwordx2 %0, %1, off sc1\n\ts_nop 1" :: "v"(p), "v"(v) : "memory");
#else
    *(u32x2*)p = v;
#endif
}
__device__ __forceinline__ void row_bt(int row, int& b, int& tok) { if (row < NLAT) { b = row >> 11; tok = row & 2047; } else { const int r = row - NLAT; b = r >> 8; tok = SEQ + (r & 255); } }

struct EpiQK {
    static constexpr bool PERM = false, AFTER_DRAIN = false;
    bf16_t* Q; bf16_t* Kb; const float* rope; int nkvh; float qscale;
    __device__ __forceinline__ void operator()(const f32x4 (&acc)[2][2][4][2], const Unit& u, int wr, int wc, int fr, int fq) const {
        const bool isQ = u.pn < 4, dorope = (rope != nullptr) && (u.pm < NLAT / BM);
        const int qi_ = fr & 3;
#pragma unroll
        for (int ai = 0; ai < 2; ++ai)
#pragma unroll
            for (int m = 0; m < 4; ++m) {
                const int row = u.pm * BM + ai * HALF + wr * 64 + m * 16 + fr;
                int b, tok; row_bt(row, b, tok);
                u32x2 pc[4];
#pragma unroll
                for (int bj = 0; bj < 2; ++bj) {
                    f32x4 cs = {1.f, 1.f, 1.f, 1.f}, sn = {0.f, 0.f, 0.f, 0.f};
                    if (dorope) { const int pos = bj ? (tok & 63) : (tok >> 6); const float* t = rope + (pos * 16 + 4 * fq) * 2;
                        const f32x4 t0 = *(const f32x4*)t, t1 = *(const f32x4*)(t + 4); cs = (f32x4){t0[0], t0[2], t1[0], t1[2]}; sn = (f32x4){t0[1], t0[3], t1[1], t1[3]}; }
                    const f32x4 x1 = acc[ai][bj][m][0], x2 = acc[ai][bj][m][1];
                    f32x4 o1 = x1 * cs - x2 * sn, o2 = x1 * sn + x2 * cs;
                    if (isQ) { o1 = o1 * qscale; o2 = o2 * qscale; }
                    pc[2 * bj] = pk4(o1); pc[2 * bj + 1] = pk4(o2);
                }
#pragma unroll
                for (int q = 0; q < 2; ++q) {
                    u32x2 snd = (qi_ & 1) ? pc[2 * q] : pc[2 * q + 1], rcv;
                    rcv.x = (unsigned)__builtin_amdgcn_mov_dpp((int)snd.x, 0xB1, 0xF, 0xF, true); rcv.y = (unsigned)__builtin_amdgcn_mov_dpp((int)snd.y, 0xB1, 0xF, 0xF, true);
                    if (qi_ & 1) pc[2 * q] = rcv; else pc[2 * q + 1] = rcv; }
#pragma unroll
                for (int q = 0; q < 2; ++q) {
                    u32x2 snd = (qi_ & 2) ? pc[q] : pc[q + 2], rcv;
                    rcv.x = (unsigned)__builtin_amdgcn_mov_dpp((int)snd.x, 0x4E, 0xF, 0xF, true); rcv.y = (unsigned)__builtin_amdgcn_mov_dpp((int)snd.y, 0x4E, 0xF, 0xF, true);
                    if (qi_ & 2) pc[q] = rcv; else pc[q + 2] = rcv; }
                if (isQ) { bf16_t* dst = Q + (size_t)(row - qi_) * D + u.pn * BM + wc * 64 + 16 * qi_ + 4 * fq;
#pragma unroll
                    for (int r = 0; r < 4; ++r) st8(dst + (size_t)r * D, pc[r]); }
                else { const int head = (u.pn - 4) * 4 + wc; bf16_t* dst = Kb + ((size_t)(b * nkvh + head) * KVTOK + (tok - qi_)) * 64 + 16 * qi_ + 4 * fq;
#pragma unroll
                    for (int r = 0; r < 4; ++r) st8(dst + r * 64, pc[r]); }
            }
    }
};

__device__ __forceinline__ void store_pair_rows(bf16_t* rowp_even, size_t ld, const u32x4 w0, const u32x4 w1, int odd) {
    u32x4 snd, rcv, s1, s2;
#pragma unroll
    for (int q = 0; q < 4; ++q) { snd[q] = odd ? w0[q] : w1[q]; rcv[q] = (unsigned)__builtin_amdgcn_mov_dpp((int)snd[q], 0xB1, 0xF, 0xF, true); }
#pragma unroll
    for (int q = 0; q < 4; ++q) { s1[q] = odd ? rcv[q] : w0[q]; s2[q] = odd ? w1[q] : rcv[q]; }
    st16(rowp_even, s1); st16(rowp_even + ld, s2);
}
template <int MODE> struct EpiP {
    static constexpr bool PERM = true, AFTER_DRAIN = false;
    bf16_t* O; bf16_t* O2; int ldc, pnmask, sub, nkvh;
    __device__ __forceinline__ void operator()(const f32x4 (&acc)[2][2][4][2], const Unit& u, int wr, int wc, int fr, int fq) const {
        if constexpr (MODE == 9) {
#pragma unroll
            for (int ai = 0; ai < 2; ++ai)
#pragma unroll
                for (int m = 0; m < 4; ++m)
#pragma unroll
                    for (int bj = 0; bj < 2; ++bj) asm volatile("" :: "v"(acc[ai][bj][m][0]), "v"(acc[ai][bj][m][1]));
        } else if constexpr (MODE == 0) {
            const int odd = fr & 1, col0 = (u.pn & pnmask) * BM + wc * 64 + 8 * fq + 32 * odd;
#pragma unroll
            for (int ai = 0; ai < 2; ++ai)
#pragma unroll
                for (int m = 0; m < 4; ++m) { bf16_t* rowp = O + (size_t)(u.pm * BM + ai * HALF + wr * 64 + m * 16 + fr - odd) * ldc + col0;
                    store_pair_rows(rowp, (size_t)ldc, pk8(acc[ai][0][m][0], acc[ai][0][m][1]), pk8(acc[ai][1][m][0], acc[ai][1][m][1]), odd); }
        } else if constexpr (MODE == 1) {
            bf16_t* blk = O + (size_t)u.pm * (BM * 512) + (size_t)((u.pn & 3) * 4 + wc) * (BM * 32) + (size_t)wr * (64 * 32);
            const unsigned lo = (unsigned)(fr * 32 + 8 * fq);
#pragma unroll
            for (int ai = 0; ai < 2; ++ai)
#pragma unroll
                for (int m = 0; m < 4; ++m) { bf16_t* rowp = blk + (ai * HALF + m * 16) * 32 + lo;
                    f32x4 h[2];
#pragma unroll
                    for (int n = 0; n < 2; ++n) { const f32x4 g = acc[ai][0][m][n], up = acc[ai][1][m][n];
#pragma unroll
                        for (int j = 0; j < 4; ++j) { const float e = __builtin_amdgcn_exp2f(-g[j] * LOG2E); h[n][j] = g[j] * __builtin_amdgcn_rcpf(1.0f + e) * up[j]; } }
                    st16(rowp, pk8(h[0], h[1])); }
        } else {
            if (sub == 0) {
                int b, tok0; row_bt(u.pn * BM, b, tok0);
                const int odd = fr & 1, tcol = tok0 + wc * 64 + 8 * fq + 32 * odd;
#pragma unroll
                for (int ai = 0; ai < 2; ++ai)
#pragma unroll
                    for (int m = 0; m < 4; ++m) { const int f = u.pm * BM + ai * HALF + wr * 64 + m * 16 + fr - odd; const int head = f >> 6, d = f & 63;
                        bf16_t* rowp = O + ((size_t)(b * nkvh + head) * 64 + d) * KVTOK + tcol;
                        store_pair_rows(rowp, (size_t)KVTOK, pk8(acc[ai][0][m][0], acc[ai][0][m][1]), pk8(acc[ai][1][m][0], acc[ai][1][m][1]), odd); }
            } else {
                if (u.pn < 8) {
                    const int col0 = u.pn * HALF + wc * 32 + 8 * fq;
#pragma unroll
                    for (int ai = 0; ai < 2; ++ai)
#pragma unroll
                        for (int m = 0; m < 4; ++m) { bf16_t* rowp = O + (size_t)(u.pm * BM + ai * HALF + wr * 64 + m * 16 + fr) * D + col0;
                            st16(rowp, pk8(acc[ai][0][m][0] * acc[ai][1][m][0], acc[ai][0][m][1] * acc[ai][1][m][1])); }
                } else {
                    const int odd = fr & 1, col0 = (u.pn - 8) * BM + wc * 64 + 8 * fq + 32 * odd;
#pragma unroll
                    for (int ai = 0; ai < 2; ++ai)
#pragma unroll
                        for (int m = 0; m < 4; ++m) { bf16_t* rowp = O2 + (size_t)(u.pm * BM + ai * HALF + wr * 64 + m * 16 + fr - odd) * D + col0;
                            store_pair_rows(rowp, (size_t)D, pk8(acc[ai][0][m][0], acc[ai][0][m][1]), pk8(acc[ai][1][m][0], acc[ai][1][m][1]), odd); }
                }
            }
        }
    }
};

struct MoeOrder {
    const PG8_LAS int* tile_e; const PG8_LAS int* rows; int ntiles, c;
    __device__ __forceinline__ bool next(int i, Unit& u) const {
        const int tile = i * 64 + (c & 7) * 8 + (c >> 5); if (tile >= ntiles) return false;
        u.pm = tile; u.pn = __builtin_amdgcn_readfirstlane(tile_e[tile]) * 4 + ((c >> 3) & 3); return true;
    }
    __device__ __forceinline__ int row(int ui, int r) const { return rows[ui * 256 + r]; }
    __device__ __forceinline__ void a_ready(const Unit&) const {}
    __device__ __forceinline__ void done(const Unit&) const {}
};
template <class Epi, class Sched, bool ALIGN_EPI = false, bool SP2 = true, bool GATHER = false, bool ABLK = false>
__device__ __forceinline__ void gemm_phase(PG8_LAS unsigned char* lds, const Gemm g, const Sched& S, const Epi& E, int wv  ) {
    int tid_; asm volatile("v_mbcnt_lo_u32_b32 %0, -1, 0\n\tv_mbcnt_hi_u32_b32 %0, -1, %0" : "=v"(tid_)); tid_ += wv * 64;
    static_assert(SP2, "the 64-column-per-wave B mapping reads both of a wave's B fragments from ONE half buffer in SP1: only the two-super-phase loop has them retired together");
    const int tid = tid_, wid = __builtin_amdgcn_readfirstlane(tid >> 6), lane = tid & 63, wr = wid >> 2, wc = wid & 3, fr = lane & 15, fq = lane >> 4;
    const int K = g.K, nt = K / BK;
    unsigned voffA[2][2], voffB[2];
#pragma unroll
    for (int i = 0; i < 2; ++i) { int R, C; stage_rc(tid * 16 + i * 8192, R, C); const int Rb = Epi::PERM ? ((R & ~31) + perm32(R & 31)) : R;
        voffA[0][i] = ABLK ? (unsigned)((C >> 5) * 16384 + R * 64 + (C & 31) * 2) : (unsigned)(R * K + C) * 2u; voffA[1][i] = voffA[0][i];     voffB[i] = (unsigned)(Rb * K + C) * 2u; }
#define PG8_GOFF(dst, uidx) do { _Pragma("unroll") for (int _i = 0; _i < 2; ++_i) { int R_, C_; stage_rc(tid * 16 + _i * 8192, R_, C_); \
        dst[0][_i] = (unsigned)(S.row(uidx, R_) * K + C_) * 2u; dst[1][_i] = (unsigned)(S.row(uidx, R_ + HALF) * K + C_) * 2u; } } while (0)
    const size_t kstep = (size_t)(BK * 2);
    const size_t kstepA = ABLK ? (size_t)32768 : kstep;
    const size_t hstep = (size_t)HALF * K * 2;
    const size_t hstepA = GATHER ? (size_t)0 : (ABLK ? (size_t)(HALF * 64) : hstep);
    const size_t tstep = 2 * hstep;
    const unsigned ldsw = (unsigned)wid * 1024u;
    const int aoff = lds_byte(wr * 64 + fr, fq * 8), boff = lds_byte((wc & 1) * 64 + fr, fq * 8) + (wc >> 1) * HTB;
#define PG8_SA(b, h) (((b) * 2 + (h)) * HTB)
#define PG8_SB(b, h) ((4 + (b) * 2 + (h)) * HTB)
#define PG8_STAGE(bufoff, gbase, voff) do { _Pragma("unroll") for (int _i = 0; _i < 2; ++_i) \
        __builtin_amdgcn_global_load_lds((const unsigned*)((const char*)(gbase) + (voff)[_i]), (PG8_LAS unsigned*)(lds + (bufoff) + ldsw + _i * 8192), 16, 0, 0); } while (0)
#define PG8_LDA(dst, b, h) do { _Pragma("unroll") for (int m = 0; m < 4; ++m) _Pragma("unroll") for (int k = 0; k < 2; ++k) dst[m][k] = *(const PG8_LAS bf16x8*)(lds + PG8_SA(b, h) + aoff + m * 2048 + k * 1024); } while (0)
#define PG8_LDB(dst, b, h) do { _Pragma("unroll") for (int n = 0; n < 2; ++n) _Pragma("unroll") for (int k = 0; k < 2; ++k) dst[n][k] = *(const PG8_LAS bf16x8*)(lds + PG8_SB(b, 0) + boff + (h) * 4096 + n * 2048 + k * 1024); } while (0)
#define PG8_MMA(ai, bj, At, Bt) do { __builtin_amdgcn_s_setprio(1); _Pragma("unroll") for (int m = 0; m < 4; ++m) _Pragma("unroll") for (int n = 0; n < 2; ++n) _Pragma("unroll") for (int k = 0; k < 2; ++k) \
        acc[ai][bj][m][n] = __builtin_amdgcn_mfma_f32_16x16x32_bf16(Bt[n][k], At[m][k], acc[ai][bj][m][n], 0, 0, 0); __builtin_amdgcn_s_setprio(0); } while (0)
#define PG8_WAIT_V(n) asm volatile("s_waitcnt vmcnt(" #n ")" ::: "memory")
#define PG8_WAIT_L(n) asm volatile("s_waitcnt lgkmcnt(" #n ")" ::: "memory")
#define PG8_BAR __builtin_amdgcn_s_barrier()
#define PG8_SCHED __builtin_amdgcn_sched_barrier(0)
    Unit cur, nxt; int ui = 0;
    if (!S.next(0, cur)) return;
    f32x4 acc[2][2][4][2];
#pragma unroll
    for (int a = 0; a < 2; ++a)
#pragma unroll
        for (int b = 0; b < 2; ++b)
#pragma unroll
            for (int m = 0; m < 4; ++m)
#pragma unroll
                for (int n = 0; n < 2; ++n) acc[a][b][m][n] = (f32x4){0.f, 0.f, 0.f, 0.f};
    bf16x8 At[4][2], B0[2][2], B1[2][2];
    const char* cA = (const char*)g.A + (GATHER ? (size_t)0 : (size_t)cur.pm * tstep); const char* cB = (const char*)g.Bt + (size_t)cur.pn * tstep;
    if constexpr (GATHER) PG8_GOFF(voffA, 0);
    S.a_ready(cur);
    if constexpr (SP2) {
        PG8_STAGE(PG8_SB(0, 0), cB, voffB); PG8_STAGE(PG8_SB(0, 1), cB + hstep, voffB); PG8_STAGE(PG8_SA(0, 0), cA, voffA[0]); PG8_STAGE(PG8_SA(0, 1), cA + hstepA, voffA[1]);
        if (wr == 1) PG8_BAR;
        PG8_WAIT_V(2); PG8_BAR;
        PG8_STAGE(PG8_SB(1, 0), cB + kstep, voffB); PG8_STAGE(PG8_SA(1, 0), cA + kstepA, voffA[0]); PG8_STAGE(PG8_SB(1, 1), cB + hstep + kstep, voffB);
        PG8_WAIT_V(6); PG8_BAR;
    } else {
        PG8_STAGE(PG8_SB(0, 0), cB, voffB); PG8_STAGE(PG8_SA(0, 0), cA, voffA[0]); PG8_STAGE(PG8_SB(0, 1), cB + hstep, voffB); PG8_STAGE(PG8_SA(0, 1), cA + hstepA, voffA[1]);
        if (wr == 1) PG8_BAR;
        PG8_WAIT_V(4); PG8_BAR;
        PG8_STAGE(PG8_SB(1, 0), cB + kstep, voffB); PG8_STAGE(PG8_SA(1, 0), cA + kstepA, voffA[0]); PG8_STAGE(PG8_SB(1, 1), cB + hstep + kstep, voffB);
        PG8_WAIT_V(6); PG8_BAR;
    }
    for (;;) {
        const bool has_next = S.next(ui + 1, nxt);
        const char* nA = (has_next && !GATHER) ? (const char*)g.A + (size_t)nxt.pm * tstep : cA; const char* nB = has_next ? (const char*)g.Bt + (size_t)nxt.pn * tstep : cB;
#pragma nounroll
        for (int t = 0; t < nt; t += 2) {
            const bool last = (t == nt - 2);
            const char* a1 = cA + (size_t)(t + 1) * kstepA;
            const char* a2 = last ? nA : cA + (size_t)(t + 2) * kstepA; const char* b2 = last ? nB : cB + (size_t)(t + 2) * kstep;
            const char* a3 = a2 + kstepA; const char* b3 = b2 + kstep;
            if (last && has_next) S.a_ready(nxt);
            if constexpr (SP2) {
            PG8_LDB(B0, 0, 0); PG8_LDB(B1, 0, 1); PG8_SCHED; PG8_LDA(At, 0, 0); PG8_STAGE(PG8_SA(1, 1), a1 + hstepA, voffA[1]);
            if constexpr (GATHER) { if (last && has_next) PG8_GOFF(voffA, ui + 1); }
            PG8_WAIT_V(8); PG8_WAIT_L(0); PG8_BAR; PG8_MMA(0, 0, At, B0); PG8_MMA(0, 1, At, B1); PG8_BAR; PG8_SCHED;
            PG8_LDA(At, 0, 1); PG8_STAGE(PG8_SB(0, 0), b2, voffB); PG8_STAGE(PG8_SB(0, 1), b2 + hstep, voffB); PG8_STAGE(PG8_SA(0, 0), a2, voffA[0]);
            PG8_WAIT_V(8); PG8_WAIT_L(0); PG8_BAR; PG8_MMA(1, 0, At, B0); PG8_MMA(1, 1, At, B1); PG8_BAR; PG8_SCHED;
            PG8_LDB(B0, 1, 0); PG8_LDB(B1, 1, 1); PG8_SCHED; PG8_LDA(At, 1, 0); PG8_STAGE(PG8_SA(0, 1), a2 + hstepA, voffA[1]);
            PG8_WAIT_V(8); PG8_WAIT_L(0); PG8_BAR; PG8_MMA(0, 0, At, B0); PG8_MMA(0, 1, At, B1); PG8_BAR; PG8_SCHED;
            PG8_LDA(At, 1, 1); PG8_STAGE(PG8_SB(1, 0), b3, voffB); PG8_STAGE(PG8_SB(1, 1), b3 + hstep, voffB); PG8_STAGE(PG8_SA(1, 0), a3, voffA[0]);
            PG8_WAIT_V(8); PG8_WAIT_L(0); PG8_BAR; PG8_MMA(1, 0, At, B0); PG8_MMA(1, 1, At, B1); PG8_BAR; PG8_SCHED;
            } else {
            PG8_LDB(B0, 0, 0); PG8_SCHED; PG8_LDA(At, 0, 0); PG8_STAGE(PG8_SA(1, 1), a1 + hstepA, voffA[1]);
            PG8_WAIT_L(8); PG8_BAR; PG8_WAIT_L(0); PG8_MMA(0, 0, At, B0); PG8_BAR; PG8_SCHED;
            PG8_LDB(B1, 0, 1); PG8_STAGE(PG8_SB(0, 0), b2, voffB);
            PG8_BAR; PG8_WAIT_L(0); PG8_MMA(0, 1, At, B1); PG8_BAR;
            PG8_LDA(At, 0, 1); PG8_STAGE(PG8_SA(0, 0), a2, voffA[0]);
            PG8_BAR; PG8_WAIT_L(0); PG8_MMA(1, 0, At, B0); PG8_BAR; PG8_SCHED;
            PG8_STAGE(PG8_SB(0, 1), b2 + hstep, voffB);
            PG8_WAIT_V(6); PG8_BAR; PG8_MMA(1, 1, At, B1); PG8_BAR;
            PG8_LDB(B0, 1, 0); PG8_SCHED; PG8_LDA(At, 1, 0); PG8_STAGE(PG8_SA(0, 1), a2 + hstepA, voffA[1]);
            PG8_WAIT_L(8); PG8_BAR; PG8_WAIT_L(0); PG8_MMA(0, 0, At, B0); PG8_BAR; PG8_SCHED;
            PG8_LDB(B1, 1, 1); PG8_STAGE(PG8_SB(1, 0), b3, voffB);
            PG8_BAR; PG8_WAIT_L(0); PG8_MMA(0, 1, At, B1); PG8_BAR;
            PG8_LDA(At, 1, 1); PG8_STAGE(PG8_SA(1, 0), a3, voffA[0]);
            PG8_BAR; PG8_WAIT_L(0); PG8_MMA(1, 0, At, B0); PG8_BAR; PG8_SCHED;
            PG8_STAGE(PG8_SB(1, 1), b3 + hstep, voffB);
            PG8_WAIT_V(6); PG8_BAR; PG8_MMA(1, 1, At, B1); PG8_BAR;
            }
        }
        if constexpr (ALIGN_EPI) { if (wr == 0) PG8_BAR; }
        if constexpr (!Epi::AFTER_DRAIN) { E(acc, cur, wr, wc, fr, fq); S.done(cur); }
        if (!has_next) break;
#pragma unroll
        for (int a = 0; a < 2; ++a)
#pragma unroll
            for (int b = 0; b < 2; ++b)
#pragma unroll
                for (int m = 0; m < 4; ++m)
#pragma unroll
                    for (int n = 0; n < 2; ++n) acc[a][b][m][n] = (f32x4){0.f, 0.f, 0.f, 0.f};
        cur = nxt; cA = nA; cB = nB; ++ui;
        if constexpr (ALIGN_EPI) { if (wr == 1) PG8_BAR; }
    }
    PG8_WAIT_V(0);
    if constexpr (!ALIGN_EPI) { if (wr == 0) PG8_BAR; }
    PG8_BAR;
    if constexpr (Epi::AFTER_DRAIN) { E.fused(acc, cur, wr, wc, fr, fq, lds, wid, lane); S.done(cur); }
#undef PG8_SA
#undef PG8_SB
#undef PG8_STAGE
#undef PG8_GOFF
#undef PG8_LDA
#undef PG8_LDB
#undef PG8_MMA
#undef PG8_WAIT_V
#undef PG8_WAIT_L
#undef PG8_BAR
#undef PG8_SCHED
}
}

constexpr size_t MiB = 1u << 20;
constexpr size_t WS_CTL = 0, CTL_ZERO_BYTES = 1 * MiB;
constexpr size_t WS_MOD = 1 * MiB;
constexpr size_t WS_ROPE = 3 * MiB;
constexpr size_t WS_ROUT = 4 * MiB;
constexpr size_t WS_X = 8 * MiB;
constexpr size_t WS_H = 152 * MiB;
constexpr size_t WS_R1 = 224 * MiB;
constexpr size_t WS_R2 = 440 * MiB;
constexpr size_t WS_R3 = 520 * MiB;
constexpr size_t WS_WM = 680 * MiB;
constexpr size_t WS_W1 = 688 * MiB;
constexpr size_t WS_W2 = 752 * MiB;
constexpr size_t WS_END = 784 * MiB;
constexpr int CW_BAR = 4096;
constexpr int CW_CNT = 16384;
constexpr int CW_Q = 20480;
constexpr int CW_DONE = 24576;
constexpr int LDS_BYTES = 155648;
constexpr int LDS_MOE = 131072;
constexpr int LDS_MISC = LDS_BYTES - 256;

#define GAS __attribute__((address_space(1)))
#define LAS __attribute__((address_space(3)))
typedef unsigned short bf16;
typedef unsigned v4u __attribute__((ext_vector_type(4)));
typedef unsigned v2u __attribute__((ext_vector_type(2)));
typedef float f32x4 __attribute__((ext_vector_type(4)));
typedef float f32x2 __attribute__((ext_vector_type(2)));
typedef float f32x16 __attribute__((ext_vector_type(16)));
typedef short bf16x8 __attribute__((ext_vector_type(8)));
typedef _Float16 f16;
typedef _Float16 h16x4 __attribute__((ext_vector_type(4)));
typedef _Float16 h16x8 __attribute__((ext_vector_type(8)));
#ifndef WT_PHASE
#define WT_PHASE 1
#endif
__device__ __forceinline__ __amdgpu_buffer_rsrc_t mkrs(const void* p) { return __builtin_amdgcn_make_buffer_rsrc((void*)p, 0, 0x7fffffff, 0x00020000); }
__device__ __forceinline__ void gst16(void* base, size_t boff, const v4u v) {
#if WT_PHASE
    __builtin_amdgcn_raw_buffer_store_b128(v, mkrs(base), (int)boff, 0, 16);
#else
    *(v4u*)((char*)base + boff) = v;
#endif
}
__device__ __forceinline__ void gst8(void* base, size_t boff, const v2u v) {
#if WT_PHASE
    __builtin_amdgcn_raw_buffer_store_b64(v, mkrs(base), (int)boff, 0, 16);
#else
    *(v2u*)((char*)base + boff) = v;
#endif
}
__device__ __forceinline__ void pst16(void* base, size_t boff, const v4u v) { *(v4u*)((char*)base + boff) = v; }
__device__ __forceinline__ void pst8(void* base, size_t boff, const v2u v) { *(v2u*)((char*)base + boff) = v; }
__device__ __forceinline__ void pst16_nt(void* base, size_t boff, const v4u v) { __builtin_nontemporal_store(v, (v4u*)((char*)base + boff)); }
__device__ __forceinline__ void gst16_nt(void* base, size_t boff, const v4u v) {
#if WT_PHASE
    __builtin_amdgcn_raw_buffer_store_b128(v, mkrs(base), (int)boff, 0, 18);
#else
    __builtin_nontemporal_store(v, (v4u*)((char*)base + boff));
#endif
}
#define LDS_WAIT() asm volatile("s_waitcnt lgkmcnt(0)" ::: "memory")
__device__ __forceinline__ unsigned f2bf(float f) { unsigned u = __builtin_bit_cast(unsigned, f); return (u + 0x7fffu + ((u >> 16) & 1u)) >> 16; }
__device__ __forceinline__ unsigned pk2(float lo, float hi) { return pg8::cvt_pk_bf16(lo, hi); }
typedef __bf16 bf16x2_t __attribute__((ext_vector_type(2)));
__device__ __forceinline__ unsigned pk2c(float lo, float hi) { const f32x2 v = {lo, hi}; return __builtin_bit_cast(unsigned, __builtin_convertvector(v, bf16x2_t)); }
__device__ __forceinline__ float bflo(unsigned w) { return __uint_as_float(w << 16); }
__device__ __forceinline__ float bfhi(unsigned w) { return __uint_as_float(w & 0xffff0000u); }
__device__ __forceinline__ f32x4 bf4(v2u w) { return (f32x4){bflo(w.x), bfhi(w.x), bflo(w.y), bfhi(w.y)}; }
__device__ __forceinline__ int lane_id_fresh() { int ln; asm volatile("v_mbcnt_lo_u32_b32 %0, -1, 0\n\tv_mbcnt_hi_u32_b32 %0, -1, %0" : "=v"(ln)); return ln; }
template <int CTRL, int RM> __device__ __forceinline__ float dpp0(float src) {
    return __builtin_bit_cast(float, __builtin_amdgcn_update_dpp(0, __builtin_bit_cast(int, src), CTRL, RM, 0xF, true)); }
__device__ __forceinline__ float wave_sum(float v) {
    v += dpp0<0xB1, 0xF>(v); v += dpp0<0x4E, 0xF>(v); v += dpp0<0x141, 0xF>(v); v += dpp0<0x140, 0xF>(v);
    v += dpp0<0x142, 0xA>(v); v += dpp0<0x143, 0xC>(v);
    return __builtin_bit_cast(float, __builtin_amdgcn_readlane(__builtin_bit_cast(int, v), 63));
}
__device__ __forceinline__ float xor32_max(float v) { const auto rr = __builtin_amdgcn_permlane32_swap(__float_as_uint(v), __float_as_uint(v), false, false); return fmaxf(__uint_as_float(rr[0]), __uint_as_float(rr[1])); }
__device__ __forceinline__ float xor32_sum(float v) { const auto rr = __builtin_amdgcn_permlane32_swap(__float_as_uint(v), __float_as_uint(v), false, false); return __uint_as_float(rr[0]) + __uint_as_float(rr[1]); }
#define XB_TMO      128
#define XB_XCNT(j)  (256  + 64 * (j))
#define XB_XSUB(j)  (1280 + 64 * (j))
#define XB_XGEN(j)  (2304 + 64 * (j))
#define XB_TOP      3328
#define XB_TOPGEN   3392
#define XCD_BAR_WORDS 3456
#define XB_SPIN_CAP (1u << 18)

__device__ __forceinline__ unsigned xb_ld(unsigned* p)              { return __hip_atomic_load(p, __ATOMIC_RELAXED, __HIP_MEMORY_SCOPE_AGENT); }
__device__ __forceinline__ unsigned xb_add(unsigned* p, unsigned v) { return __hip_atomic_fetch_add(p, v, __ATOMIC_RELAXED, __HIP_MEMORY_SCOPE_AGENT); }
__device__ __forceinline__ unsigned xb_xcc_id() { return (unsigned)__builtin_amdgcn_s_getreg((3 << 11) | 20) & 0xFu; }
#define XB_SPIN(cond, bar) do { unsigned _sp = 0; while (cond) { __builtin_amdgcn_s_sleep(1); \
    if ((++_sp & 255u) == 0u) { if (xb_ld(&(bar)[XB_TMO])) break; if (_sp > XB_SPIN_CAP) { atomicAdd(&(bar)[XB_TMO], 1u); break; } } } } while (0)

struct XcdBarrier {
    unsigned* bar; unsigned x;
    volatile LAS unsigned* st;
};

__device__ __forceinline__ XcdBarrier xcd_barrier_post(unsigned* bar, volatile LAS unsigned* st) {
    XcdBarrier b; b.bar = bar; b.x = xb_xcc_id(); b.st = st;
    if (threadIdx.x == 0) (void)xb_add(&bar[XB_XCNT(b.x)], 1u);
    return b;
}
__device__ __forceinline__ void xcd_barrier_complete(unsigned* bar, unsigned x, unsigned& nloc, unsigned& nx) {
    const unsigned G = gridDim.x * gridDim.y * gridDim.z;
    unsigned sum, cnt, mine, sp = 0u;
    for (;;) {
        sum = 0u; cnt = 0u; mine = 0u;
#pragma unroll
        for (unsigned j = 0; j < 16; ++j) { const unsigned c = xb_ld(&bar[XB_XCNT(j)]); sum += c; cnt += (c > 0u) ? 1u : 0u; mine = (j == x) ? c : mine; }
        if (sum == G) break;
        __builtin_amdgcn_s_sleep(1);
        if ((++sp & 255u) == 0u) { if (xb_ld(&bar[XB_TMO])) break; if (sp > XB_SPIN_CAP) { atomicAdd(&bar[XB_TMO], 1u); break; } }
    }
    nloc = mine > 0u ? mine : 1u; nx = cnt > 0u ? cnt : 1u;
}

__device__ __forceinline__ void xcd_barrier(const XcdBarrier& b) {
    asm volatile("s_waitcnt vmcnt(0)" ::: "memory");
    __syncthreads();
    if (threadIdx.x == 0) {
        unsigned* bar = b.bar;
        __builtin_amdgcn_s_waitcnt(0);
        unsigned nloc = b.st[0], nx = b.st[1];
        if (nloc == 0u) { xcd_barrier_complete(bar, b.x, nloc, nx); b.st[0] = nloc; b.st[1] = nx; }
        const unsigned old = xb_add(&bar[XB_XSUB(b.x)], 1u);
        const unsigned gen = old / nloc;
        if (old + 1u == (gen + 1u) * nloc) {
            __builtin_amdgcn_fence(__ATOMIC_RELEASE, "agent");
            asm volatile("s_waitcnt vmcnt(0)" ::: "memory");
            const unsigned og = xb_add(&bar[XB_TOP], 1u);
            const unsigned tg = og / nx;
            if (og + 1u == (tg + 1u) * nx) xb_add(&bar[XB_TOPGEN], 1u);
            else XB_SPIN(xb_ld(&bar[XB_TOPGEN]) == tg, bar);
            __builtin_amdgcn_fence(__ATOMIC_ACQUIRE, "agent");
            xb_add(&bar[XB_XGEN(b.x)], 1u);
            asm volatile("s_waitcnt vmcnt(0)" ::: "memory");
        } else {
            XB_SPIN(xb_ld(&bar[XB_XGEN(b.x)]) == gen, bar);
            __builtin_amdgcn_fence(__ATOMIC_ACQUIRE, "agent");
            asm volatile("s_waitcnt vmcnt(0)" ::: "memory");
        }
    }
    __syncthreads();
}
struct Args { const float* in[26]; float* out; unsigned char* ws; int ph_lo, ph_hi; };
typedef const Args __attribute__((address_space(4)))* KArgs;
__device__ __forceinline__ KArgs kargs() { KArgs p = (KArgs)__builtin_amdgcn_kernarg_segment_ptr(); asm volatile("" : "+s"(p)); return p; }
#define P_x (ap->in[0])
#define P_c (ap->in[1])
#define P_ctx (ap->in[2])
#define P_c_ctx (ap->in[3])
#define P_w_ada (ap->in[4])
#define P_b_ada (ap->in[5])
#define P_ln1_g (ap->in[6])
#define P_ln1_b (ap->in[7])
#define P_ln2_g (ap->in[8])
#define P_ln2_b (ap->in[9])
#define P_attn_w_qkv (ap->in[10])
#define P_attn_w_o (ap->in[11])
#define P_attn_sink (ap->in[12])
#define P_conv_w_in (ap->in[13])
#define P_conv_w (ap->in[14])
#define P_conv_w_out (ap->in[15])
#define P_nat_w_qkv (ap->in[16])
#define P_nat_w_o (ap->in[17])
#define P_nat_rpb (ap->in[18])
#define P_r_wg (ap->in[19])
#define P_r_bg (ap->in[20])
#define P_r_we (ap->in[21])
#define P_r_be (ap->in[22])
#define P_e_wg (ap->in[23])
#define P_e_wu (ap->in[24])
#define P_e_wd (ap->in[25])
#define P_out (ap->out)
#define P_ctl ((unsigned*)(ap->ws + WS_CTL))
#define P_mod ((float*)(ap->ws + WS_MOD))
#define P_rope ((float*)(ap->ws + WS_ROPE))
#define P_r_eid ((int*)(ap->ws + WS_ROUT))
#define P_r_gate ((float*)(ap->ws + WS_ROUT) + 2 * MTOT)
#define P_r_rank ((int*)(ap->ws + WS_ROUT) + 4 * MTOT)
#define P_r_dest ((int*)(ap->ws + WS_ROUT) + 6 * MTOT)
#define P_X ((f16*)(ap->ws + WS_X))
#define P_tokrow ((int*)(ap->ws + WS_R1))
constexpr int TOKCAP = 2 * MTOT;
#define P_H ((bf16*)(ap->ws + WS_H))
#define P_R1 ((bf16*)(ap->ws + WS_R1))
#define P_R2 ((bf16*)(ap->ws + WS_R2))
#define P_R3 ((bf16*)(ap->ws + WS_R3))
#define P_WM_IN ((bf16*)(ap->ws + WS_WM))
#define P_WM_O ((bf16*)(ap->ws + WS_WM + 6 * MiB))
#define P_W1 ((bf16*)(ap->ws + WS_W1))
#define P_W2 ((bf16*)(ap->ws + WS_W2))

struct Ctx {
    LAS unsigned char* lds; int tid, lane, wave, G, bid, gw, ngw;
};
__device__ __forceinline__ const float* xin_row(KArgs ap, const Ctx& C, int row) {
    return row < NLAT ? P_x + (size_t)row * D : P_ctx + (size_t)(row - NLAT) * D;
}
__device__ __forceinline__ f32x4 ldx4(KArgs ap, const Ctx& C, int layer, int row, int off) {
    if (layer == 0) return *(const f32x4*)(xin_row(ap, C, row) + off);
    return __builtin_convertvector(*(const h16x4*)(P_X + (size_t)row * D + off), f32x4);
}
__device__ __forceinline__ void stx4(KArgs ap, int row, int off, const f32x4 v, size_t dry = 0) { pst8(dry ? (f16*)(ap->ws + WS_R1) : P_X, ((size_t)row * D + off) * 2, __builtin_bit_cast(v2u, __builtin_convertvector(v, h16x4))); }
__device__ __forceinline__ int row_bidx(int row) { return row < NLAT ? (row >> 11) : 16; }

__device__ __forceinline__ void phase_mod(KArgs ap, Ctx& C) {
    LAS float* sl = (LAS float*)C.lds;
    LAS float* part = (LAS float*)(C.lds + 69632);
    {
        f32x4 cv[9];
#pragma unroll
        for (int j = 0; j < 9; ++j) { const int idx = (j * 512 + C.tid) * 4; const int r = idx >> 10, k = idx & 1023;
            cv[j] = idx < 17 * 1024 ? *(const f32x4*)(r < 16 ? P_c + r * 1024 + k : P_c_ctx + k) : (f32x4){0.f, 0.f, 0.f, 0.f}; }
#pragma unroll
        for (int j = 0; j < 9; ++j) { const int idx = (j * 512 + C.tid) * 4;
            if (idx < 17 * 1024) { f32x4 o;
#pragma unroll
                for (int q = 0; q < 4; ++q) o[q] = cv[j][q] * __builtin_amdgcn_rcpf(1.0f + __builtin_amdgcn_exp2f(-cv[j][q] * LOG2E));
                *(LAS f32x4*)(sl + idx) = o; } }
    }
    __syncthreads();
    for (int unit = C.bid; unit < DEPTH * 48; unit += C.G) {
        const int layer = unit / 48, nb = (unit % 48) * 128;
        const float* W = P_w_ada + (size_t)layer * 1024 * 6144 + nb + 2 * C.lane;
        float a0[17], a1[17];
#pragma unroll
        for (int r = 0; r < 17; ++r) { a0[r] = 0.f; a1[r] = 0.f; }
        const int k0 = C.wave * 128;
#pragma nounroll
        for (int kk = 0; kk < 128; kk += 16) {
            f32x2 w[16];
#pragma unroll
            for (int j = 0; j < 16; ++j) w[j] = *(const f32x2*)(W + (size_t)(k0 + kk + j) * 6144);
#pragma unroll
            for (int r = 0; r < 17; ++r) {
#pragma unroll
                for (int q = 0; q < 4; ++q) { const f32x4 s = *(const LAS f32x4*)(sl + r * 1024 + k0 + kk + 4 * q);
                    a0[r] += s[0] * w[4 * q].x + s[1] * w[4 * q + 1].x + s[2] * w[4 * q + 2].x + s[3] * w[4 * q + 3].x;
                    a1[r] += s[0] * w[4 * q].y + s[1] * w[4 * q + 1].y + s[2] * w[4 * q + 2].y + s[3] * w[4 * q + 3].y; } }
        }
#pragma unroll
        for (int r = 0; r < 17; ++r) *(LAS f32x2*)(part + (C.wave * 17 + r) * 128 + 2 * C.lane) = (f32x2){a0[r], a1[r]};
        __syncthreads();
        for (int idx = C.tid; idx < 17 * 128; idx += 512) { const int r = idx >> 7, cc = idx & 127; float s = P_b_ada[layer * 6144 + nb + cc];
#pragma unroll
            for (int w = 0; w < 8; ++w) s += part[(w * 17 + r) * 128 + cc];
            P_mod[(size_t)(layer * 17 + r) * 6144 + nb + cc] = s; }
        __syncthreads();
    }
    if (C.bid == C.G - 1) for (int idx = C.tid; idx < 1024; idx += 512) { const int pos = idx >> 4, i = idx & 15;
        const float inv = exp2f(-(float)i * (13.287712379549449f / 16.0f)); const float ang = (float)pos * inv;
        P_rope[idx * 2] = cosf(ang); P_rope[idx * 2 + 1] = sinf(ang); }
}

__device__ __forceinline__ void tr_item(const float* W, int N, int k0, int n0, bf16* WT, int Kd, int drow0, LAS float* scr, int lane) {
    float wv[32];
#pragma unroll
    for (int i = 0; i < 32; ++i) { const int kk = 2 * i + (lane >> 5); wv[i] = W[(size_t)(k0 + kk) * N + n0 + (lane & 31)]; }
#pragma unroll
    for (int i = 0; i < 32; ++i) { const int kk = 2 * i + (lane >> 5); scr[kk * 33 + (lane & 31)] = wv[i]; }
    LDS_WAIT(); asm volatile("" ::: "memory");
    const int c = lane & 7;
#pragma unroll
    for (int j = 0; j < 4; ++j) { const int n = (lane >> 3) + 8 * j; const LAS float* s = scr + (8 * c) * 33 + n;
        v4u o; o.x = pk2(s[0 * 33], s[1 * 33]); o.y = pk2(s[2 * 33], s[3 * 33]); o.z = pk2(s[4 * 33], s[5 * 33]); o.w = pk2(s[6 * 33], s[7 * 33]);
        *(v4u*)(WT + (size_t)(drow0 + n) * Kd + k0 + 8 * c) = o; }
    LDS_WAIT(); asm volatile("" ::: "memory");
}
__device__ __forceinline__ int convert_nitems(int layer) { return 3 * 32 * 256 + 16 * ((layer % 3) == 0 ? 48 : 96) + 512; }
__device__ __forceinline__ void convert_item(KArgs ap, Ctx& C, int layer, int it, LAS float* scr) {
    const int kind = layer % 3, j = layer / 3;
    if (it < 3 * 32 * 256) {
        const int which = it >> 13, r = it & 8191, e = r >> 8, q = r & 255;
        if (which < 2) { const float* W = (which ? P_e_wu : P_e_wg) + (size_t)(layer * 32 + e) * 1024 * 512; const int kb = q >> 4, n0 = 32 * (q & 15);
            tr_item(W, 512, 64 * kb, n0, P_W1, 1024, e * 1024 + 256 * (n0 >> 7) + 64 * ((n0 >> 5) & 3) + 32 * which, scr, C.lane); }
        else { const float* W = P_e_wd + (size_t)(layer * 32 + e) * 512 * 1024; const int kb = q >> 5, n0 = 32 * (q & 31);
            tr_item(W, 1024, 64 * kb, n0, P_W2, 512, e * 1024 + n0, scr, C.lane); }
        return;
    }
    it -= 3 * 32 * 256;
    const int nblk = kind == 0 ? 48 : 96;
    if (it < 16 * nblk) {
        const float* W; int N;
        if (kind == 0) { W = P_attn_w_qkv + (size_t)j * 1024 * 1536; N = 1536; }
        else if (kind == 1) { W = P_conv_w_in + (size_t)j * 1024 * 3072; N = 3072; }
        else { W = P_nat_w_qkv + (size_t)j * 1024 * 3072; N = 3072; }
        const int kb = it / nblk, n0 = 32 * (it % nblk); int drow0 = n0;
        if (kind == 1) { if (n0 < 1024) drow0 = 2048 + n0; else if (n0 < 2048) { const int jj = n0 - 1024; drow0 = 256 * (jj >> 7) + 64 * ((jj >> 5) & 3); } else { const int jj = n0 - 2048; drow0 = 256 * (jj >> 7) + 64 * ((jj >> 5) & 3) + 32; } }
        tr_item(W, N, 64 * kb, n0, P_WM_IN, 1024, drow0, scr, C.lane);
        return;
    }
    it -= 16 * nblk;
    const float* W = (kind == 0 ? P_attn_w_o : kind == 1 ? P_conv_w_out : P_nat_w_o) + (size_t)j * 1024 * 1024;
    const int kb = it >> 5, n0 = 32 * (it & 31); tr_item(W, 1024, 64 * kb, n0, P_WM_O, 1024, n0, scr, C.lane);
}
struct CvItem { const float* src; bf16* dst; int N, Kd; };
__device__ __forceinline__ CvItem convert_addr(KArgs ap, int layer, int it) {
    const int kind = layer % 3, j = layer / 3; CvItem r;
    if (it < 3 * 32 * 256) {
        const int which = it >> 13, rr = it & 8191, e = rr >> 8, q = rr & 255;
        if (which < 2) { const float* W = (which ? P_e_wu : P_e_wg) + (size_t)(layer * 32 + e) * 1024 * 512; const int kb = q >> 4, n0 = 32 * (q & 15);
            r.src = W + (size_t)(64 * kb) * 512 + n0; r.N = 512; r.dst = P_W1 + (size_t)(e * 1024 + 256 * (n0 >> 7) + 64 * ((n0 >> 5) & 3) + 32 * which) * 1024 + 64 * kb; r.Kd = 1024; }
        else { const float* W = P_e_wd + (size_t)(layer * 32 + e) * 512 * 1024; const int kb = q >> 5, n0 = 32 * (q & 31);
            r.src = W + (size_t)(64 * kb) * 1024 + n0; r.N = 1024; r.dst = P_W2 + (size_t)(e * 1024 + n0) * 512 + 64 * kb; r.Kd = 512; }
        return r;
    }
    it -= 3 * 32 * 256;
    const int nblk = kind == 0 ? 48 : 96;
    if (it < 16 * nblk) {
        const float* W; int N;
        if (kind == 0) { W = P_attn_w_qkv + (size_t)j * 1024 * 1536; N = 1536; }
        else if (kind == 1) { W = P_conv_w_in + (size_t)j * 1024 * 3072; N = 3072; }
        else { W = P_nat_w_qkv + (size_t)j * 1024 * 3072; N = 3072; }
        const int kb = it / nblk, n0 = 32 * (it % nblk); int drow0 = n0;
        if (kind == 1) { if (n0 < 1024) drow0 = 2048 + n0; else if (n0 < 2048) { const int jj = n0 - 1024; drow0 = 256 * (jj >> 7) + 64 * ((jj >> 5) & 3); } else { const int jj = n0 - 2048; drow0 = 256 * (jj >> 7) + 64 * ((jj >> 5) & 3) + 32; } }
        r.src = W + (size_t)(64 * kb) * N + n0; r.N = N; r.dst = P_WM_IN + (size_t)drow0 * 1024 + 64 * kb; r.Kd = 1024;
        return r;
    }
    it -= 16 * nblk;
    const float* W = (kind == 0 ? P_attn_w_o : kind == 1 ? P_conv_w_out : P_nat_w_o) + (size_t)j * 1024 * 1024;
    const int kb = it >> 5, n0 = 32 * (it & 31);
    r.src = W + (size_t)(64 * kb) * 1024 + n0; r.N = 1024; r.dst = P_WM_O + (size_t)n0 * 1024 + 64 * kb; r.Kd = 1024;
    return r;
}
__device__ __forceinline__ void tr_load(const CvItem& I, f32x4 (&wv)[8], int lane) {
    const float* p = I.src + (size_t)(lane >> 3) * I.N + 4 * (lane & 7);
#pragma unroll
    for (int i = 0; i < 8; ++i) wv[i] = __builtin_nontemporal_load((const f32x4*)(p + (size_t)(8 * i) * I.N));
}
__device__ __forceinline__ void tr_store(const CvItem& I, const f32x4 (&wv)[8], LAS float* scr, int lane) {
    LAS float* wp = scr + (lane >> 3) * 33 + 4 * (lane & 7);
#pragma unroll
    for (int i = 0; i < 8; ++i) { wp[(8 * i) * 33] = wv[i][0]; wp[(8 * i) * 33 + 1] = wv[i][1]; wp[(8 * i) * 33 + 2] = wv[i][2]; wp[(8 * i) * 33 + 3] = wv[i][3]; }
    LDS_WAIT(); asm volatile("" ::: "memory");
    const int c = lane & 7;
#pragma unroll
    for (int j = 0; j < 4; ++j) { const int n = (lane >> 3) + 8 * j; const LAS float* s = scr + (8 * c) * 33 + n;
        v4u o; o.x = pk2(s[0 * 33], s[1 * 33]); o.y = pk2(s[2 * 33], s[3 * 33]); o.z = pk2(s[4 * 33], s[5 * 33]); o.w = pk2(s[6 * 33], s[7 * 33]);
        pst16_nt(I.dst, ((size_t)n * I.Kd + 8 * c) * 2, o); }
    LDS_WAIT(); asm volatile("" ::: "memory");
}
__device__ __forceinline__ void convert_seq(KArgs ap, Ctx& C, int layer, int first, int stride, int hi) {
    LAS float* scr = (LAS float*)(C.lds + C.wave * 16384);
    if (first >= hi) return;
    f32x4 w0[8], w1[8], w2[8], w3[8]; CvItem i0, i1, i2, i3;
    int it = first;
    i0 = convert_addr(ap, layer, it); tr_load(i0, w0, C.lane);
    if (it + stride < hi) { i1 = convert_addr(ap, layer, it + stride); tr_load(i1, w1, C.lane); }
    if (it + 2 * stride < hi) { i2 = convert_addr(ap, layer, it + 2 * stride); tr_load(i2, w2, C.lane); }
#pragma unroll 1
    for (;;) {
        if (it + 3 * stride < hi) { i3 = convert_addr(ap, layer, it + 3 * stride); tr_load(i3, w3, C.lane); }
        tr_store(i0, w0, scr, C.lane);
        if (it + 4 * stride < hi) { i0 = convert_addr(ap, layer, it + 4 * stride); tr_load(i0, w0, C.lane); }
        if (it + stride >= hi) break;
        tr_store(i1, w1, scr, C.lane);
        if (it + 5 * stride < hi) { i1 = convert_addr(ap, layer, it + 5 * stride); tr_load(i1, w1, C.lane); }
        if (it + 2 * stride >= hi) break;
        tr_store(i2, w2, scr, C.lane);
        if (it + 6 * stride < hi) { i2 = convert_addr(ap, layer, it + 6 * stride); tr_load(i2, w2, C.lane); }
        if (it + 3 * stride >= hi) break;
        tr_store(i3, w3, scr, C.lane);
        it += 4 * stride;
        if (it >= hi) break;
    }
}
__device__ __forceinline__ void convert_pull(KArgs ap, Ctx& C, int layer, const unsigned* done) {
    LAS float* scr = (LAS float*)(C.lds + C.wave * 16384); volatile LAS int* slot = (volatile LAS int*)(C.lds + LDS_MISC + 64);
    const int nit = convert_nitems(layer); unsigned* qh = P_ctl + CW_Q + 64 * layer;
    for (;;) {
        if (C.tid == 0) { int base = -1;
            if (!(done && __hip_atomic_load(done, __ATOMIC_RELAXED, __HIP_MEMORY_SCOPE_AGENT) >= (unsigned)C.G)) { const unsigned b = __hip_atomic_fetch_add(qh, 16u, __ATOMIC_RELAXED, __HIP_MEMORY_SCOPE_AGENT); if (b < (unsigned)nit) base = (int)b; }
            slot[0] = base; }
        __syncthreads();
        const int base = __builtin_amdgcn_readfirstlane(slot[0]);
        if (base < 0) break;
#pragma unroll 1
        for (int k = 0; k < 2; ++k) { const int it = base + 8 * k + C.wave; if (it < nit) convert_item(ap, C, layer, it, scr); }
        __syncthreads();
    }
}
#ifndef FA0
#define FA0 10240
#endif
#ifndef FA12
#define FA12 0
#endif
#ifndef FA3
#define FA3 20480
#endif
#ifndef FB0
#define FB0 14336
#endif
#ifndef FB12
#define FB12 24576
#endif
__device__ __forceinline__ int fill_a(int layer) { return layer == 0 ? FA0 : layer == 3 ? FA3 : FA12; }
__device__ __forceinline__ int fill_b(int layer) { return layer == 0 ? FB0 : layer == DEPTH - 1 ? 0 : FB12; }
__device__ __forceinline__ void convert_rest(KArgs ap, Ctx& C, int layer) {
    convert_seq(ap, C, layer, fill_a(layer) + fill_b(layer) + C.gw, C.ngw, convert_nitems(layer));
}
__device__ __forceinline__ void convert_fill(KArgs ap, Ctx& C, int layer, int lo, int hi, int l0, int nl, int tl) {
    convert_seq(ap, C, layer, lo + l0 * 8 + C.wave, tl * 8, hi);
}
__device__ __forceinline__ void tail_convert(KArgs ap, Ctx& C, int layer_next, int phase) {
    unsigned* done = P_ctl + CW_DONE + 64 * phase;
    __syncthreads();
    if (C.tid == 0) __hip_atomic_fetch_add(done, 1u, __ATOMIC_RELAXED, __HIP_MEMORY_SCOPE_AGENT);
    convert_pull(ap, C, layer_next, done);
}
__device__ __forceinline__ void phase_hprep(KArgs ap, Ctx& C) {
    for (int row = C.gw; row < MTOT; row += C.ngw) {
        const float* xr = xin_row(ap, C, row); const float* md = P_mod + (size_t)row_bidx(row) * 6144;
#pragma unroll
        for (int i = 0; i < 4; ++i) { const int off = 4 * C.lane + 256 * i; const f32x4 x = *(const f32x4*)(xr + off), sh = *(const f32x4*)(md + off), sc = *(const f32x4*)(md + 1024 + off);
            const f32x4 h = x * (1.0f + sc) + sh; v2u w; w.x = pk2(h[0], h[1]); w.y = pk2(h[2], h[3]); pst8(P_H, ((size_t)row * D + off) * 2, w); }
    }
}

__device__ __forceinline__ int crow(int r, int hi) { return (r & 3) + 8 * (r >> 2) + 4 * hi; }
__device__ __forceinline__ int clampi(int v, int lo, int hi) { return v < lo ? lo : (v > hi ? hi : v); }
#define MFMA32(a, b, c) __builtin_amdgcn_mfma_f32_32x32x16_bf16(a, b, c, 0, 0, 0)
struct TileArg { int a, kr, r_q, c_q, rs_q, qs_q; };
__device__ __forceinline__ int kidx(int reg, int hi) { return (reg & 3) + 4 * ((reg >> 2) & 1) + 8 * hi + 16 * (reg >> 3); }
template <int MODE, int FIX = 0>
__device__ __forceinline__ void attn_tile(f32x16& o0, f32x16& o1, float& m, float& l, const LAS unsigned char* ck, int koff, const bf16x8 (&qf)[4], int r32, int hi, const TileArg& T, const LAS float* bias, const float (&cmm)[16]) {
    const int row = koff + ((r32 & 3) | ((r32 & 4) << 1) | ((r32 & 8) >> 1) | (r32 & 16)); const LAS unsigned char* kp = ck + row * 128; const int sw = (row >> 1) & 7;
    const bf16x8 kf0 = *(const LAS bf16x8*)(kp + (((0 + hi) ^ sw) << 4)), kf1 = *(const LAS bf16x8*)(kp + (((2 + hi) ^ sw) << 4));
    const bf16x8 kf2 = *(const LAS bf16x8*)(kp + (((4 + hi) ^ sw) << 4)), kf3 = *(const LAS bf16x8*)(kp + (((6 + hi) ^ sw) << 4));
    const int c0 = (koff >> 3) + hi;
    const LAS unsigned char* vp0 = ck + 8192 + r32 * 128; const int sw0 = (r32 >> 1) & 7;
    const LAS unsigned char* vp1 = ck + 8192 + (32 + r32) * 128; const int sw1 = ((32 + r32) >> 1) & 7;
    const bf16x8 vf0 = *(const LAS bf16x8*)(vp0 + (((c0) ^ sw0) << 4)), vf1 = *(const LAS bf16x8*)(vp0 + (((c0 + 2) ^ sw0) << 4));
    const bf16x8 vf2 = *(const LAS bf16x8*)(vp1 + (((c0) ^ sw1) << 4)), vf3 = *(const LAS bf16x8*)(vp1 + (((c0 + 2) ^ sw1) << 4));
    __builtin_amdgcn_sched_barrier(0);
    f32x16 p;
#pragma unroll
    for (int r = 0; r < 16; ++r) p[r] = 0.f;
    p = MFMA32(kf0, qf[0], p); p = MFMA32(kf1, qf[1], p); p = MFMA32(kf2, qf[2], p); p = MFMA32(kf3, qf[3], p);
    if constexpr (MODE == 1) {
#pragma unroll
        for (int r = 0; r < 16; ++r) { const int d = T.a + kidx(r, hi); if (d > 128 || d < -128) p[r] = NEGBIG; }
    }
    if constexpr (MODE == 2) {
        const bool rowok = (T.kr >= T.rs_q) && (T.kr < T.rs_q + 8); const int drow = rowok ? T.kr - T.r_q + 7 : 15;
        const LAS float* bp = bias + 16 + drow * 31 + T.a;
#pragma unroll
        for (int r = 0; r < 16; ++r) p[r] = (p[r] + bp[(r & 3) + 4 * ((r >> 2) & 1) + 16 * (r >> 3)]) + cmm[r];
    }
    if constexpr (FIX == 0) {
        float tm = p[0];
#pragma unroll
        for (int r = 1; r < 16; ++r) tm = fmaxf(tm, p[r]);
        tm = xor32_max(tm);
        const float mn = fmaxf(m, tm), alpha = __builtin_amdgcn_exp2f(m - mn);
        float rs = 0.f;
#pragma unroll
        for (int r = 0; r < 16; ++r) { p[r] = __builtin_amdgcn_exp2f(p[r] - mn); rs += p[r]; }
        l = l * alpha + rs; m = mn;
#pragma unroll
        for (int r = 0; r < 16; ++r) { o0[r] *= alpha; o1[r] *= alpha; }
    } else {
        if constexpr (FIX == 1) {
            float tm = p[0];
#pragma unroll
            for (int r = 1; r < 16; ++r) tm = fmaxf(tm, p[r]);
            tm = xor32_max(tm);
            const float mn = fmaxf(m, tm); l *= __builtin_amdgcn_exp2f(m - mn); m = mn;
        }
        float rs = 0.f;
#pragma unroll
        for (int r = 0; r < 16; ++r) { p[r] = __builtin_amdgcn_exp2f(MODE == 2 ? p[r] : p[r] - m); rs += p[r]; }
        l += rs;
    }
    v4u w0, w1;
    w0.x = pk2c(p[0], p[1]); w0.y = pk2c(p[2], p[3]); w0.z = pk2c(p[4], p[5]); w0.w = pk2c(p[6], p[7]);
    w1.x = pk2c(p[8], p[9]); w1.y = pk2c(p[10], p[11]); w1.z = pk2c(p[12], p[13]); w1.w = pk2c(p[14], p[15]);
    const bf16x8 pb0 = __builtin_bit_cast(bf16x8, w0), pb1 = __builtin_bit_cast(bf16x8, w1);
    o0 = MFMA32(vf0, pb0, o0); o1 = MFMA32(vf2, pb0, o1);
    o0 = MFMA32(vf1, pb1, o0); o1 = MFMA32(vf3, pb1, o1);
}
__device__ __forceinline__ void attn_store(bf16* O, size_t rowq0, int hi16, int head, const f32x16& o0, const f32x16& o1, float l, int r32, int hi, LAS unsigned char* ost, int lane) {
    l = xor32_sum(l); const float inv = __builtin_amdgcn_rcpf(l);
    LAS unsigned char* wr_ = ost + r32 * 128;
#pragma unroll
    for (int g = 0; g < 4; ++g) { v2u w; w.x = pk2(o0[4 * g] * inv, o0[4 * g + 1] * inv); w.y = pk2(o0[4 * g + 2] * inv, o0[4 * g + 3] * inv);
        *(LAS v2u*)(wr_ + (((g) ^ (r32 & 7)) << 4) + 8 * hi) = w; }
#pragma unroll
    for (int g = 0; g < 4; ++g) { v2u w; w.x = pk2(o1[4 * g] * inv, o1[4 * g + 1] * inv); w.y = pk2(o1[4 * g + 2] * inv, o1[4 * g + 3] * inv);
        *(LAS v2u*)(wr_ + (((4 + g) ^ (r32 & 7)) << 4) + 8 * hi) = w; }
#pragma unroll
    for (int k = 0; k < 4; ++k) { const int row = 8 * k + (lane >> 3), pc = lane & 7;
        const v4u v = *(const LAS v4u*)(ost + row * 128 + ((pc ^ (row & 7)) << 4));
        gst16(O, ((rowq0 + (size_t)((row & 15) + (row >> 4) * hi16)) * D + head * 64 + 8 * pc) * 2, v); }
}
template <int KIND>
__device__ __forceinline__ size_t attn_rowq(int b, int part, int qi, int wave, int r32) {
    constexpr int NLATQ = KIND == 0 ? 8 : 4;
    if (KIND == 0) { if (qi < NLATQ) return (size_t)b * SEQ + 32 * (2 * (8 * part + qi) + (wave >> 2)) + r32; return (size_t)NLAT + b * CTXL + 64 * part + 32 * (wave >> 2) + r32; }
    if (qi < NLATQ) { const int r0 = 4 * (4 * part + qi) + 2 * (wave >> 2); return (size_t)b * SEQ + (r0 + (r32 >> 4)) * 64 + 16 * (wave & 3) + (r32 & 15); }
    return (size_t)NLAT + b * CTXL + 128 * part + 32 * (wave & 3) + r32;
}
constexpr int ATT_CTX_OFF = 0, ATT_BUF_OFF = 65536, ATT_OST_OFF = 100352, ATT_RPB_OFF = 133120;
template <int KIND>
__device__ __forceinline__ void phase_attn(KArgs ap, Ctx& C, int j, bool last) {
    const bf16* Q = P_R1; const bf16* Kb = P_R1 + (size_t)MTOT * D; const bf16* VTb = P_R1 + (size_t)2 * MTOT * D; bf16* O = P_R2;
    constexpr int NH = KIND == 0 ? 4 : 16, NLATQ = KIND == 0 ? 8 : 4, NUNITS = KIND == 0 ? 256 : 512;
    const int r32 = C.lane & 31, hi = C.lane >> 5, t = C.tid;
    const LAS unsigned char* ctxc = C.lds + ATT_CTX_OFF; LAS unsigned char* sbuf = C.lds + ATT_BUF_OFF; LAS float* rpb = (LAS float*)(C.lds + ATT_RPB_OFF);
    const int pr = t >> 3, pc = t & 7;
    const int kdst = pr * 128 + ((pc ^ ((pr >> 1) & 7)) << 4), vdst = 8192 + pr * 128 + ((pc ^ ((pr >> 1) & 7)) << 4);
    int par = 0;
    for (int unit = C.bid; unit < NUNITS; unit += C.G) {
        int b, h, part; if (KIND == 0) { b = unit >> 4; h = (unit >> 2) & 3; part = unit & 3; } else { b = unit >> 5; h = (unit >> 1) & 15; part = unit & 1; }
        const bf16* Kh = Kb + (size_t)(b * NH + h) * KVTOK * 64; const bf16* Vh = VTb + (size_t)(b * NH + h) * 64 * KVTOK;
        const bf16* kg = Kh + t * 8; const bf16* vg = Vh + (size_t)pr * KVTOK + pc * 8;
        __syncthreads();
#pragma unroll
        for (int cc = 0; cc < 4; ++cc) { const int tok0 = SEQ + 64 * cc; const v4u kv = *(const v4u*)(kg + (size_t)tok0 * 64), vv = *(const v4u*)(vg + tok0);
            *(LAS v4u*)(C.lds + ATT_CTX_OFF + cc * 16384 + kdst) = kv; *(LAS v4u*)(C.lds + ATT_CTX_OFF + cc * 16384 + vdst) = vv; }
        if (KIND == 2) {
            for (int e = t; e < 544; e += 512) rpb[e] = e < 16 ? 0.0f : (e < 16 + 465 ? P_nat_rpb[(size_t)(j * 16 + h) * 465 + (e - 16)] * LOG2E : NEGBIG); }
        __syncthreads();
        const int nqi = last ? NLATQ : NLATQ + 1;
        int qlo0, qhi0; if (KIND == 0) { const int qb = 8 * part; qlo0 = qb - 2 < 0 ? 0 : qb - 2; qhi0 = qb + 2 > 31 ? 31 : qb + 2; } else { const int quad = 4 * part; qlo0 = clampi(4 * quad - 4, 0, 24); qhi0 = clampi(4 * quad - 1, 0, 24) + 7; }
        v4u pk = *(const v4u*)(kg + (size_t)(64 * qlo0) * 64), pv = *(const v4u*)(vg + 64 * qlo0);
        const int headq = KIND == 0 ? 4 * h + (C.wave & 3) : h;
        bf16x8 qn[4];
        {   const size_t rq = attn_rowq<KIND>(b, part, 0, C.wave, r32);
#pragma unroll
            for (int s = 0; s < 4; ++s) qn[s] = *(const bf16x8*)(Q + rq * D + headq * 64 + 16 * s + 8 * hi); }
        for (int qi = 0; qi < nqi; ++qi) {
            const bool isctx = qi == NLATQ;
            int head, clo = 0, chi = -1; size_t rowq; bool active = true; TileArg T; T.a = 0; T.kr = 0; T.r_q = 0; T.c_q = 0; T.rs_q = 0; T.qs_q = 0;
            int qt = 0, wlo = 0, whi = -1, kc0 = 0;
            if (KIND == 0) {
                head = 4 * h + (C.wave & 3);
                if (!isctx) { const int qb = 8 * part + qi; clo = qb - 2 < 0 ? 0 : qb - 2; chi = qb + 2 > 31 ? 31 : qb + 2; qt = 2 * qb + (C.wave >> 2); rowq = (size_t)b * SEQ + 32 * qt + r32; }
                else rowq = (size_t)NLAT + b * CTXL + 64 * part + 32 * (C.wave >> 2) + r32;
            } else {
                head = h;
                if (!isctx) { const int quad = 4 * part + qi; clo = clampi(4 * quad - 4, 0, 24); chi = clampi(4 * quad - 1, 0, 24) + 7;
                    const int r0 = 4 * quad + 2 * (C.wave >> 2), cb = C.wave & 3; T.r_q = r0 + (r32 >> 4); T.c_q = 16 * cb + (r32 & 15); rowq = (size_t)b * SEQ + T.r_q * 64 + T.c_q;
                    T.rs_q = clampi(T.r_q - 4, 0, 24); T.qs_q = clampi(T.c_q - 8, 0, 48); wlo = clampi(r0 - 4, 0, 24); whi = clampi(r0 - 3, 0, 24) + 7; kc0 = clampi(16 * cb - 8, 0, 32); T.a = kc0 + 8 * hi - T.c_q + 15; }
                else { active = C.wave < 4; rowq = (size_t)NLAT + b * CTXL + 128 * part + 32 * (C.wave & 3) + r32; }
            }
            bf16x8 qf[4];
#pragma unroll
            for (int s = 0; s < 4; ++s) qf[s] = qn[s];
            if (qi + 1 < nqi) { const size_t rq = attn_rowq<KIND>(b, part, qi + 1, C.wave, r32);
#pragma unroll
                for (int s = 0; s < 4; ++s) qn[s] = *(const bf16x8*)(Q + rq * D + headq * 64 + 16 * s + 8 * hi); }
            f32x16 o0, o1; float cmm[16];
#pragma unroll
            for (int r = 0; r < 16; ++r) { o0[r] = 0.f; o1[r] = 0.f; cmm[r] = 0.f; }
            float m, l; if (KIND == 0) { m = P_attn_sink[j * 16 + head] * LOG2E; l = hi == 0 ? 1.0f : 0.0f; } else { m = NEGBIG; l = 0.0f; }
            if (active) {
                if (true) {
                    attn_tile<0, 1>(o0, o1, m, l, ctxc, 0, qf, r32, hi, T, rpb, cmm);
#pragma unroll 2
                    for (int jt = 1; jt < 8; ++jt) attn_tile<0, 2>(o0, o1, m, l, ctxc + (jt >> 1) * 16384, 32 * (jt & 1), qf, r32, hi, T, rpb, cmm);
                } else {
#pragma unroll 1
                    for (int jt = 0; jt < 8; ++jt) attn_tile<0>(o0, o1, m, l, ctxc + (jt >> 1) * 16384, 32 * (jt & 1), qf, r32, hi, T, rpb, cmm);
                }
            }
            if (KIND == 2 && !isctx) {
#pragma unroll
                for (int r = 0; r < 16; ++r) { const int kc = kc0 + kidx(r, hi); cmm[r] = ((kc >= T.qs_q && kc < T.qs_q + 16) ? 0.0f : NEGBIG) - m; }
            }
#pragma unroll 1
            for (int ch = clo; ch <= chi; ++ch) {
                LAS unsigned char* buf = sbuf + par * 16384;
                *(LAS v4u*)(buf + kdst) = pk; *(LAS v4u*)(buf + vdst) = pv;
                __syncthreads();
                {
                    int nch = ch + 1; bool ok = true;
                    if (nch > chi) { const int nq = qi + 1; if (nq < NLATQ) { if (KIND == 0) { const int qb = 8 * part + nq; nch = qb - 2 < 0 ? 0 : qb - 2; } else { const int quad = 4 * part + nq; nch = clampi(4 * quad - 4, 0, 24); } } else ok = false; }
                    if (ok) { pk = *(const v4u*)(kg + (size_t)(64 * nch) * 64); pv = *(const v4u*)(vg + 64 * nch); }
                }
                if (KIND == 0) {
#pragma unroll
                    for (int tau = 0; tau < 2; ++tau) { const int kt = 2 * ch + tau; if (kt >= qt - 4 && kt <= qt + 4) { T.a = 32 * kt - (32 * qt + r32); if (kt == qt - 4 || kt == qt + 4) attn_tile<1, 2>(o0, o1, m, l, buf, 32 * tau, qf, r32, hi, T, rpb, cmm); else attn_tile<0, 2>(o0, o1, m, l, buf, 32 * tau, qf, r32, hi, T, rpb, cmm); } }
                } else {
                    if (ch >= wlo && ch <= whi) { T.kr = ch; attn_tile<2, 2>(o0, o1, m, l, buf, kc0, qf, r32, hi, T, rpb, cmm); }
                }
                par ^= 1;
            }
            if (active) attn_store(O, rowq - (size_t)((r32 & 15) + (r32 >> 4) * ((KIND == 2 && !isctx) ? 64 : 16)), (KIND == 2 && !isctx) ? 64 : 16, head, o0, o1, l, r32, hi, C.lds + ATT_OST_OFF + C.wave * 4096, C.lane);
        }
    }
}
__device__ __forceinline__ void phase_conv(KArgs ap, Ctx& C, int j, bool last) {
    const bf16* Vc = P_R1; const bf16* GB = P_R1 + (size_t)MTOT * D; bf16* Z = P_R2; const float* cw = P_conv_w + (size_t)j * 3 * D;
    const int nrows = last ? NLAT : MTOT;
    const int rpw = nrows / C.ngw, r0 = C.gw * rpw;
    float w0[2][8], w1[2][8], w2[2][8];
#pragma unroll
    for (int i = 0; i < 2; ++i)
#pragma unroll
        for (int q = 0; q < 8; ++q) { const int c = 8 * C.lane + 512 * i + q; w0[i][q] = cw[c]; w1[i][q] = cw[D + c]; w2[i][q] = cw[2 * D + c]; }
    v4u va[2], vb[2], vc[2], g[2], vn[2], gn[2];
#pragma unroll
    for (int i = 0; i < 2; ++i) { const size_t o = (size_t)r0 * D + 8 * C.lane + 512 * i;
        va[i] = *(const v4u*)(Vc + (r0 > 0 ? o - D : o)); vb[i] = *(const v4u*)(Vc + o); vc[i] = *(const v4u*)(Vc + o + D); g[i] = *(const v4u*)(GB + o); }
#pragma unroll 1
    for (int k = 0; k < rpw; ++k) {
        const int row = r0 + k;
        if (k + 1 < rpw) {
#pragma unroll
            for (int i = 0; i < 2; ++i) { const size_t o = (size_t)(row + 1) * D + 8 * C.lane + 512 * i; vn[i] = *(const v4u*)(Vc + o + D); gn[i] = *(const v4u*)(GB + o); } }
        int pos, len; if (row < NLAT) { pos = row & 2047; len = SEQ; } else { pos = (row - NLAT) & 255; len = CTXL; }
        const bool hasm = pos > 0, hasp = pos < len - 1;
#pragma unroll
        for (int i = 0; i < 2; ++i) {
            v4u r;
#pragma unroll
            for (int q = 0; q < 4; ++q) {
                const unsigned am = hasm ? va[i][q] : 0u, cp = hasp ? vc[i][q] : 0u;
                const float lo = bflo(g[i][q]) * (w0[i][2 * q] * bflo(am) + w1[i][2 * q] * bflo(vb[i][q]) + w2[i][2 * q] * bflo(cp));
                const float hh = bfhi(g[i][q]) * (w0[i][2 * q + 1] * bfhi(am) + w1[i][2 * q + 1] * bfhi(vb[i][q]) + w2[i][2 * q + 1] * bfhi(cp));
                r[q] = pk2(lo, hh); }
            gst16(Z, ((size_t)row * D + 8 * C.lane + 512 * i) * 2, r);
            va[i] = vb[i]; vb[i] = vc[i]; vc[i] = vn[i]; g[i] = gn[i]; }
    }
}

__device__ __forceinline__ void wave_sum2(float& a, float& b) { a = wave_sum(a); b = wave_sum(b); }
__device__ __forceinline__ void phase_ln1(KArgs ap, Ctx& C, int layer, bool last, int dry = 0) {
    LAS float* WrT = (LAS float*)C.lds;
    LAS int* hist = (LAS int*)(C.lds + 147456);
    LAS int* gbase = hist + 32;
    LAS int* le = gbase + 32;
    LAS int* lr = le + 288;
    const float* wg = P_r_wg + (size_t)layer * 1024 * 4; const float* we = P_r_we + (size_t)layer * 1024 * 32;
    {
        f32x4 gq[2], eq[16];
#pragma unroll
        for (int j = 0; j < 2; ++j) gq[j] = *(const f32x4*)(wg + 4 * (j * 512 + C.tid));
#pragma unroll
        for (int j = 0; j < 16; ++j) eq[j] = *(const f32x4*)(we + 4 * (j * 512 + C.tid));
#pragma unroll
        for (int j = 0; j < 2; ++j) { const int k = j * 512 + C.tid;
#pragma unroll
            for (int q = 0; q < 4; ++q) WrT[q * 1024 + ((k + 4 * q) & 1023)] = gq[j][q]; }
#pragma unroll
        for (int j = 0; j < 16; ++j) { const int f = j * 512 + C.tid, k = f >> 3;
#pragma unroll
            for (int q = 0; q < 4; ++q) { const int o = 4 + 4 * (f & 7) + q; WrT[o * 1024 + ((k + 4 * o) & 1023)] = eq[j][q]; } }
    }
    if (C.tid < 32) hist[C.tid] = 0;
    __syncthreads();
    const int nrows = last ? NLAT : MTOT, rpb = nrows / C.G, rpw = rpb >> 3, row0 = C.bid * rpb;
    const bf16* Y = P_R3;
    f32x4 g1[4], b1[4];
#pragma unroll
    for (int i = 0; i < 4; ++i) { const int off = 4 * C.lane + 256 * i; g1[i] = *(const f32x4*)(P_ln1_g + layer * D + off); b1[i] = *(const f32x4*)(P_ln1_b + layer * D + off); }
    int curb = -1; f32x4 gt[4], sh[4], sc[4];
#pragma unroll
    for (int i = 0; i < 4; ++i) { gt[i] = (f32x4){0.f, 0.f, 0.f, 0.f}; sh[i] = gt[i]; sc[i] = gt[i]; }
    const int lbeg = C.wave * rpw, lend = lbeg + rpw;
    h16x4 pxh[2][4]; v2u pyv[2][4];
    if (layer != 0) {
#pragma unroll
        for (int rr = 0; rr < 2; ++rr) { const int row = row0 + lbeg + rr;
#pragma unroll
            for (int i = 0; i < 4; ++i) { const int off = 4 * C.lane + 256 * i; pxh[rr][i] = *(const h16x4*)(P_X + (size_t)row * D + off); pyv[rr][i] = *(const v2u*)(Y + (size_t)row * D + off); } }
    }
#pragma unroll 1
    for (int l0 = lbeg; l0 < lend; l0 += 2) {
        f32x4 xv[2][4]; v2u yv[2][4];
        if (layer == 0) {
#pragma unroll
            for (int rr = 0; rr < 2; ++rr) { const int row = row0 + l0 + rr; const float* xr = xin_row(ap, C, row); const bf16* yr = Y + (size_t)row * D;
#pragma unroll
                for (int i = 0; i < 4; ++i) { const int off = 4 * C.lane + 256 * i; xv[rr][i] = *(const f32x4*)(xr + off); yv[rr][i] = *(const v2u*)(yr + off); } }
        } else {
#pragma unroll
            for (int rr = 0; rr < 2; ++rr)
#pragma unroll
                for (int i = 0; i < 4; ++i) { xv[rr][i] = __builtin_convertvector(pxh[rr][i], f32x4); yv[rr][i] = pyv[rr][i]; }
            if (l0 + 2 < lend) {
#pragma unroll
                for (int rr = 0; rr < 2; ++rr) { const int row = row0 + l0 + 2 + rr;
#pragma unroll
                    for (int i = 0; i < 4; ++i) { const int off = 4 * C.lane + 256 * i; pxh[rr][i] = *(const h16x4*)(P_X + (size_t)row * D + off); pyv[rr][i] = *(const v2u*)(Y + (size_t)row * D + off); } }
            }
        }
        float hv[2][16];
#pragma unroll
        for (int rr = 0; rr < 2; ++rr) {
            const int row = row0 + l0 + rr; const int bi = row_bidx(row);
            if (bi != curb) { curb = bi; const float* md = P_mod + (size_t)(layer * 17 + bi) * 6144;
#pragma unroll
                for (int i = 0; i < 4; ++i) { const int off = 4 * C.lane + 256 * i; gt[i] = *(const f32x4*)(md + 2 * 1024 + off); sh[i] = *(const f32x4*)(md + 3 * 1024 + off); sc[i] = *(const f32x4*)(md + 4 * 1024 + off); } }
            f32x4 v[4]; float s = 0.f;
#pragma unroll
            for (int i = 0; i < 4; ++i) { v[i] = xv[rr][i] * ALPHA + gt[i] * bf4(yv[rr][i]); s += (v[i][0] + v[i][1]) + (v[i][2] + v[i][3]); }
            const float mean = wave_sum(s) * (1.0f / D); float s2 = 0.f;
#pragma unroll
            for (int i = 0; i < 4; ++i) { v[i] = v[i] - mean; s2 += (v[i][0] * v[i][0] + v[i][1] * v[i][1]) + (v[i][2] * v[i][2] + v[i][3] * v[i][3]); }
            const float rstd = __builtin_amdgcn_rsqf(wave_sum(s2) * (1.0f / D) + LN_EPS);
#pragma unroll
            for (int i = 0; i < 4; ++i) { const int off = 4 * C.lane + 256 * i;
                const f32x4 xn = v[i] * rstd * g1[i] + b1[i]; stx4(ap, row, off, xn, dry);
                const f32x4 h = xn * (1.0f + sc[i]) + sh[i];
                hv[rr][4 * i] = h[0]; hv[rr][4 * i + 1] = h[1]; hv[rr][4 * i + 2] = h[2]; hv[rr][4 * i + 3] = h[3];
                v2u w; w.x = pk2(h[0], h[1]); w.y = pk2(h[2], h[3]); pst8(dry ? (bf16*)(ap->ws + WS_R1 + 80 * MiB) : P_H, ((size_t)row * D + off) * 2, w); }
        }
        float glg[2][4];
#pragma unroll
        for (int o = 0; o < 4; ++o) { float a0 = 0.f, a1 = 0.f;
#pragma unroll
            for (int i = 0; i < 4; ++i) { const f32x4 w = *(const LAS f32x4*)(WrT + o * 1024 + ((4 * C.lane + 256 * i + 4 * o) & 1023));
                a0 += w[0] * hv[0][4 * i] + w[1] * hv[0][4 * i + 1] + w[2] * hv[0][4 * i + 2] + w[3] * hv[0][4 * i + 3];
                a1 += w[0] * hv[1][4 * i] + w[1] * hv[1][4 * i + 1] + w[2] * hv[1][4 * i + 2] + w[3] * hv[1][4 * i + 3]; }
            wave_sum2(a0, a1); glg[0][o] = a0; glg[1][o] = a1; }
#pragma unroll
        for (int rr = 0; rr < 2; ++rr) {
            const int row = row0 + l0 + rr;
            float gl[4];
#pragma unroll
            for (int g = 0; g < 4; ++g) gl[g] = glg[rr][g] + P_r_bg[layer * 4 + g];
            int gi = 0; float gm = gl[0];
#pragma unroll
            for (int g = 1; g < 4; ++g) if (gl[g] > gm) { gm = gl[g]; gi = g; }
            gi = __builtin_amdgcn_readfirstlane(gi);
            float gsum = 0.f;
#pragma unroll
            for (int g = 0; g < 4; ++g) gsum += __builtin_amdgcn_exp2f((gl[g] - gm) * LOG2E);
            const float gprob = __builtin_amdgcn_rcpf(gsum);
            float el[8];
#pragma unroll
            for (int q = 0; q < 8; q += 2) { float a = 0.f, c = 0.f; const int o = 4 + gi * 8 + q;
#pragma unroll
                for (int i = 0; i < 4; ++i) { const f32x4 w = *(const LAS f32x4*)(WrT + o * 1024 + ((4 * C.lane + 256 * i + 4 * o) & 1023)), w2 = *(const LAS f32x4*)(WrT + (o + 1) * 1024 + ((4 * C.lane + 256 * i + 4 * (o + 1)) & 1023));
                    a += w[0] * hv[rr][4 * i] + w[1] * hv[rr][4 * i + 1] + w[2] * hv[rr][4 * i + 2] + w[3] * hv[rr][4 * i + 3];
                    c += w2[0] * hv[rr][4 * i] + w2[1] * hv[rr][4 * i + 1] + w2[2] * hv[rr][4 * i + 2] + w2[3] * hv[rr][4 * i + 3]; }
                wave_sum2(a, c); el[q] = a + P_r_be[layer * 32 + gi * 8 + q]; el[q + 1] = c + P_r_be[layer * 32 + gi * 8 + q + 1]; }
            int i0 = 0; float v0 = el[0];
#pragma unroll
            for (int q = 1; q < 8; ++q) if (el[q] > v0) { v0 = el[q]; i0 = q; }
            int i1 = -1; float v1 = -3.0e38f;
#pragma unroll
            for (int q = 0; q < 8; ++q) if (q != i0 && el[q] > v1) { v1 = el[q]; i1 = q; }
            const float e1 = __builtin_amdgcn_exp2f((v1 - v0) * LOG2E), p0 = __builtin_amdgcn_rcpf(1.0f + e1), p1 = e1 * p0;
            if (C.lane == 0 && !dry) { const int lrow = l0 + rr;
                P_r_eid[row * 2] = gi * 8 + i0; P_r_eid[row * 2 + 1] = gi * 8 + i1; P_r_gate[row * 2] = p0 * gprob; P_r_gate[row * 2 + 1] = p1 * gprob;
                le[lrow * 2] = gi * 8 + i0; le[lrow * 2 + 1] = gi * 8 + i1; }
        }
    }
    __syncthreads();
    if (dry) return;
    const int nas = 2 * rpb;
    if (C.tid < nas) lr[C.tid] = __hip_atomic_fetch_add(&hist[le[C.tid]], 1, __ATOMIC_RELAXED, __HIP_MEMORY_SCOPE_WORKGROUP);
    __syncthreads();
    if (C.tid < 32) gbase[C.tid] = (int)__hip_atomic_fetch_add(P_ctl + CW_CNT + 64 * layer + C.tid, (unsigned)hist[C.tid], __ATOMIC_RELAXED, __HIP_MEMORY_SCOPE_AGENT);
    __syncthreads();
    if (C.tid < nas) { const int e = le[C.tid], rk = gbase[e] + lr[C.tid]; P_r_rank[row0 * 2 + C.tid] = rk; P_tokrow[(size_t)e * TOKCAP + rk] = row0 + (C.tid >> 1); }
}
__device__ __noinline__ int moe_offsets_impl(const GAS unsigned* cnts, LAS int* poffs, LAS int* tile_e, int tid) {
    if (tid < 64) {
        const int e = tid & 31; const int cnt = (int)cnts[e]; const int nt = (cnt + 255) >> 8;
        int incl = nt;
#pragma unroll
        for (int o = 1; o < 32; o <<= 1) { const int v = __shfl_up(incl, o, 32); if (e >= o) incl += v; }
        const int first = incl - nt;
        if (tid < 32) { poffs[e] = first * 256; if (e == 31) poffs[32] = incl * 256; tile_e[400 + e] = cnt;
#pragma nounroll
            for (int k = 0; k < nt; ++k) tile_e[first + k] = e; }
    }
    __syncthreads();
    return __builtin_amdgcn_readfirstlane(poffs[32]) >> 8;
}
__device__ __forceinline__ int moe_offsets(KArgs ap, Ctx& C, int layer, LAS int* poffs, LAS int* tile_e) { return __builtin_amdgcn_readfirstlane(moe_offsets_impl((const GAS unsigned*)(P_ctl + CW_CNT + 64 * layer), poffs, tile_e, C.tid)); }
__device__ __forceinline__ void moe_rows(KArgs ap, Ctx& C, int layer, const LAS int* poffs, const LAS int* tile_e, LAS int* rows, int ntiles) {
    if (C.tid < 256) {
        int val[5];
#pragma unroll
        for (int ui = 0; ui < 5; ++ui) { const int tile = ui * 64 + (C.bid & 7) * 8 + (C.bid >> 5); val[ui] = 0;
            if (tile < ntiles) { const int e = tile_e[tile], r = tile * 256 - poffs[e] + C.tid, cnt = tile_e[400 + e];
                if (r < cnt) val[ui] = P_tokrow[(size_t)e * TOKCAP + r]; } }
#pragma unroll
        for (int ui = 0; ui < 5; ++ui) { const int tile = ui * 64 + (C.bid & 7) * 8 + (C.bid >> 5); if (tile < ntiles) rows[ui * 256 + C.tid] = val[ui]; }
    }
    __syncthreads();
}
__device__ __forceinline__ void phase_ln2(KArgs ap, Ctx& C, int layer, bool last, int dry = 0) {
    LAS int* poffs = (LAS int*)(C.lds + LDS_MOE); LAS int* tile_e = poffs + 64;
    moe_offsets(ap, C, layer, poffs, tile_e);
    const int nrows = last ? NLAT : MTOT, rpw = nrows / C.ngw, r0 = C.gw * rpw; const bf16* ys = P_R3;
    int ld0 = 0, ld1 = 0; float lg0 = 0.f, lg1 = 0.f;
    if (C.lane < rpw) { const int row = r0 + C.lane; ld0 = poffs[P_r_eid[row * 2]] + P_r_rank[row * 2]; ld1 = poffs[P_r_eid[row * 2 + 1]] + P_r_rank[row * 2 + 1]; lg0 = P_r_gate[row * 2]; lg1 = P_r_gate[row * 2 + 1]; }
#define LN2_OFF(j) (8 * C.lane + 512 * ((j) >> 1) + 4 * ((j) & 1))
    f32x4 g2[4], b2[4];
#pragma unroll
    for (int j = 0; j < 4; ++j) { g2[j] = *(const f32x4*)(P_ln2_g + layer * D + LN2_OFF(j)); b2[j] = *(const f32x4*)(P_ln2_b + layer * D + LN2_OFF(j)); }
    int curb = -1; f32x4 gt[4], sh[4], sc[4];
#pragma unroll
    for (int j = 0; j < 4; ++j) { gt[j] = (f32x4){0.f, 0.f, 0.f, 0.f}; sh[j] = gt[j]; sc[j] = gt[j]; }
    h16x8 px[2][2]; v4u pa[2][2], pb[2][2];
#pragma unroll
    for (int rr = 0; rr < 2; ++rr) { const int row = r0 + rr; const int d0 = __builtin_amdgcn_readlane(ld0, rr), d1 = __builtin_amdgcn_readlane(ld1, rr);
#pragma unroll
        for (int i = 0; i < 2; ++i) { const int off = 8 * C.lane + 512 * i; px[rr][i] = *(const h16x8*)(P_X + (size_t)row * D + off); pa[rr][i] = *(const v4u*)(ys + (size_t)d0 * D + off); pb[rr][i] = *(const v4u*)(ys + (size_t)d1 * D + off); } }
#pragma unroll 1
    for (int it = 0; it < rpw; it += 2) {
        f32x4 xv[2][4], ya[2][4], yb[2][4]; float gg[2][2];
#pragma unroll
        for (int rr = 0; rr < 2; ++rr) { gg[rr][0] = __builtin_bit_cast(float, __builtin_amdgcn_readlane(__builtin_bit_cast(int, lg0), it + rr)); gg[rr][1] = __builtin_bit_cast(float, __builtin_amdgcn_readlane(__builtin_bit_cast(int, lg1), it + rr));
#pragma unroll
            for (int i = 0; i < 2; ++i) {
                xv[rr][2 * i] = __builtin_convertvector(__builtin_shufflevector(px[rr][i], px[rr][i], 0, 1, 2, 3), f32x4); xv[rr][2 * i + 1] = __builtin_convertvector(__builtin_shufflevector(px[rr][i], px[rr][i], 4, 5, 6, 7), f32x4);
                ya[rr][2 * i] = bf4((v2u){pa[rr][i].x, pa[rr][i].y}); ya[rr][2 * i + 1] = bf4((v2u){pa[rr][i].z, pa[rr][i].w});
                yb[rr][2 * i] = bf4((v2u){pb[rr][i].x, pb[rr][i].y}); yb[rr][2 * i + 1] = bf4((v2u){pb[rr][i].z, pb[rr][i].w}); } }
        if (it + 2 < rpw) {
#pragma unroll
            for (int rr = 0; rr < 2; ++rr) { const int row = r0 + it + 2 + rr; const int d0 = __builtin_amdgcn_readlane(ld0, it + 2 + rr), d1 = __builtin_amdgcn_readlane(ld1, it + 2 + rr);
#pragma unroll
                for (int i = 0; i < 2; ++i) { const int off = 8 * C.lane + 512 * i; px[rr][i] = *(const h16x8*)(P_X + (size_t)row * D + off); pa[rr][i] = *(const v4u*)(ys + (size_t)d0 * D + off); pb[rr][i] = *(const v4u*)(ys + (size_t)d1 * D + off); } }
        }
#pragma unroll
        for (int rr = 0; rr < 2; ++rr) {
            const int row = r0 + it + rr; const int bi = row_bidx(row);
            if (bi != curb) { curb = bi; const float* md = P_mod + (size_t)(layer * 17 + bi) * 6144; const float* md2 = P_mod + (size_t)((layer + 1 < DEPTH ? layer + 1 : layer) * 17 + bi) * 6144;
#pragma unroll
                for (int j = 0; j < 4; ++j) { gt[j] = *(const f32x4*)(md + 5 * 1024 + LN2_OFF(j)); sh[j] = *(const f32x4*)(md2 + LN2_OFF(j)); sc[j] = *(const f32x4*)(md2 + 1024 + LN2_OFF(j)); } }
            f32x4 v[4]; float s = 0.f;
#pragma unroll
            for (int j = 0; j < 4; ++j) { v[j] = xv[rr][j] * ALPHA + gt[j] * (ya[rr][j] * gg[rr][0] + yb[rr][j] * gg[rr][1]); s += (v[j][0] + v[j][1]) + (v[j][2] + v[j][3]); }
            const float mean = wave_sum(s) * (1.0f / D); float s2 = 0.f;
#pragma unroll
            for (int j = 0; j < 4; ++j) { v[j] = v[j] - mean; s2 += (v[j][0] * v[j][0] + v[j][1] * v[j][1]) + (v[j][2] * v[j][2] + v[j][3] * v[j][3]); }
            const float rstd = __builtin_amdgcn_rsqf(wave_sum(s2) * (1.0f / D) + LN_EPS);
            f32x4 xn[4];
#pragma unroll
            for (int j = 0; j < 4; ++j) xn[j] = v[j] * rstd * g2[j] + b2[j];
            if (last) {
                LAS float* ob = (LAS float*)(C.lds + C.wave * 4096);
#pragma unroll
                for (int j = 0; j < 4; ++j) *(LAS f32x4*)(ob + LN2_OFF(j)) = xn[j];
                LDS_WAIT(); asm volatile("" ::: "memory");
                float* orow = (dry ? (float*)(ap->ws + WS_R1) : P_out) + (size_t)row * D;
#pragma unroll
                for (int j = 0; j < 4; ++j) { const f32x4 o = *(const LAS f32x4*)(ob + 4 * C.lane + 256 * j); *(f32x4*)(orow + 4 * C.lane + 256 * j) = o; }
                LDS_WAIT(); asm volatile("" ::: "memory");
            } else {
#pragma unroll
                for (int i = 0; i < 2; ++i) { const int off = 8 * C.lane + 512 * i;
                    const h16x4 xa = __builtin_convertvector(xn[2 * i], h16x4), xb = __builtin_convertvector(xn[2 * i + 1], h16x4);
                    pst16(dry ? (f16*)(ap->ws + WS_R1) : P_X, ((size_t)row * D + off) * 2, __builtin_bit_cast(v4u, __builtin_shufflevector(xa, xb, 0, 1, 2, 3, 4, 5, 6, 7)));
                    const f32x4 ha = xn[2 * i] * (1.0f + sc[2 * i]) + sh[2 * i], hb = xn[2 * i + 1] * (1.0f + sc[2 * i + 1]) + sh[2 * i + 1];
                    v4u w; w.x = pk2(ha[0], ha[1]); w.y = pk2(ha[2], ha[3]); w.z = pk2(hb[0], hb[1]); w.w = pk2(hb[2], hb[3]);
                    pst16(dry ? (bf16*)(ap->ws + WS_R1 + 80 * MiB) : P_H, ((size_t)row * D + off) * 2, w); }
            }
        }
    }
#undef LN2_OFF
}

__device__ __forceinline__ Ctx fresh(const Ctx& C) { Ctx R = C; const int ln = lane_id_fresh(); R.lane = ln; R.tid = C.wave * 64 + ln; return R; }
constexpr int NPH_LAYER = 8, NPHASES = 1 + DEPTH * NPH_LAYER;
__global__ void __launch_bounds__(512, 2) mk_fwd(Args args) {
    extern __shared__ __attribute__((aligned(16))) unsigned char lds_raw[];
    Ctx C;
    C.lds = (LAS unsigned char*)lds_raw; C.tid = threadIdx.x; C.lane = C.tid & 63; C.wave = __builtin_amdgcn_readfirstlane(C.tid >> 6); C.G = gridDim.x; C.bid = blockIdx.x;
    C.gw = C.bid * 8 + C.wave; C.ngw = C.G * 8;
    volatile LAS unsigned* MISC = (volatile LAS unsigned*)(C.lds + LDS_MISC);
    if (C.tid < 64) MISC[C.tid] = 0u;
    __syncthreads();
    const int lo = args.ph_lo, hi = args.ph_hi;
    XcdBarrier bar; { const KArgs ap = kargs(); bar.bar = P_ctl + CW_BAR; bar.x = 0; bar.st = nullptr; if (hi - lo > 1) bar = xcd_barrier_post(P_ctl + CW_BAR, MISC + 8); }
#ifndef PHMASK
#define PHMASK 0xFFFFFFFFu
#endif
#ifndef REP_GEMM
#define REP_GEMM 1
#endif
#ifndef REP_G3
#define REP_G3 REP_GEMM
#endif
#ifndef REP_G4
#define REP_G4 REP_GEMM
#endif
#ifndef REP_G8
#define REP_G8 REP_GEMM
#endif
#ifndef REP_G11
#define REP_G11 REP_GEMM
#endif
#ifndef REP_G12
#define REP_G12 REP_GEMM
#endif
#ifndef DRY_LN1
#define DRY_LN1 0
#endif
#ifndef DRY_LN2
#define DRY_LN2 0
#endif
#ifndef COLD_CONV
#define COLD_CONV 0
#endif
#ifndef NOSTORE_PROBE
#define NOSTORE_PROBE 0
#endif
#ifndef REP_ATTN
#define REP_ATTN 1
#endif
#ifndef REP_MEM
#define REP_MEM 1
#endif
#define REPEAT(n) _Pragma("nounroll") for (int rep_ = 0; rep_ < (n); ++rep_)
#define IN(k) (lo <= (k) && (k) < hi)
#define EN(b) ((PHMASK >> (b)) & 1u)
#define SEAM(k) do { if ((k) + 1 < hi) xcd_barrier(bar); } while (0)
    LAS unsigned char* ring = C.lds;

    if (IN(0)) { if (EN(0)) REPEAT(REP_MEM) { Ctx Cx = fresh(C); phase_mod(kargs(), Cx); __syncthreads(); } __syncthreads(); if (EN(1)) { Ctx Cx = fresh(C); convert_rest(kargs(), Cx, 0); } SEAM(0); }
#pragma nounroll
    for (int layer = 0; layer < DEPTH; ++layer) {
        const int base = 1 + NPH_LAYER * layer, kind = layer % 3, j = layer / 3; const bool last = layer == DEPTH - 1;
        const int nrows = last ? NLAT : MTOT;
        if (IN(base + 0)) { if (layer == 0) { Ctx Cx = fresh(C); if (EN(2)) REPEAT(REP_MEM) phase_hprep(kargs(), Cx); SEAM(base + 0); } }
        if (IN(base + 1)) {
            int fl_pre = -1, fl_post = -1; const int ftl = kind == 0 ? 160 : 64;
            { const int b_ = C.bid, odd = (b_ >> 3) & 1; int l1 = -1;
              if (kind == 0) { if (b_ >= 208) { fl_pre = 64 + 2 * (b_ - 208); fl_post = fl_pre + 1; } else if (b_ >= 144) l1 = b_ - 144; }
              else if (kind == 1) { if (b_ >= 192) l1 = b_ - 192; }
              else if (b_ >= 128 && b_ < 192) l1 = b_ - 128;
              if (l1 >= 0) { if (odd) fl_pre = l1; else fl_post = l1; } }
            if (EN(1) && fl_pre >= 0) { Ctx Cx = fresh(C); convert_fill(kargs(), Cx, layer, 0, fill_a(layer), fl_pre, 1, ftl); __syncthreads(); }
            if (kind != 1 && EN(3)) REPEAT(REP_G3) {
                const KArgs ap = kargs();
                const int nq = kind == 0 ? 1280 : 2048;
                pg8::Gemm g{P_H, P_WM_IN, MTOT, nq, D}; pg8::StaticOrder S; S.init(MTOT, nq, C.G, C.bid);
                pg8::EpiQK E{P_R1, P_R1 + (size_t)MTOT * D, kind == 0 ? P_rope : nullptr, kind == 0 ? 4 : 16, QSCALE};
                pg8::gemm_phase<pg8::EpiQK, pg8::StaticOrder, true, true>(ring, g, S, E, C.wave);
            }
            if (EN(4)) REPEAT(REP_G4) {
                const KArgs ap = kargs();
                pg8::Gemm g; pg8::StaticOrder S; pg8::EpiP<2> E;
                if (kind == 1) { g = pg8::Gemm{P_H, P_WM_IN, MTOT, 3072, D}; S.init(MTOT, 3072, C.G, C.bid); E = pg8::EpiP<2>{P_R1, P_R1 + (size_t)MTOT * D, D, -1, 1, 0}; }
                else { const int nq = kind == 0 ? 1280 : 2048, nv = kind == 0 ? 256 : 1024; g = pg8::Gemm{P_WM_IN + (size_t)nq * D, P_H, nv, MTOT, D}; S.init(nv, MTOT, C.G, kind == 2 ? C.G - 1 - C.bid : C.bid);     E = pg8::EpiP<2>{P_R1 + (size_t)2 * MTOT * D, nullptr, 0, -1, 0, kind == 0 ? 4 : 16}; }
                pg8::gemm_phase<pg8::EpiP<2>, pg8::StaticOrder, true, true>(ring, g, S, E, C.wave);
            }
            if (EN(1) && fl_post >= 0) { __syncthreads(); Ctx Cx = fresh(C); convert_fill(kargs(), Cx, layer, 0, fill_a(layer), fl_post, 1, ftl); }
            SEAM(base + 1);
        }
        if (IN(base + 2)) { Ctx Cx = fresh(C); if (kind == 0) { if (EN(5)) REPEAT(REP_ATTN) phase_attn<0>(kargs(), Cx, j, last); } else if (kind == 1) { if (EN(6)) REPEAT(REP_ATTN) phase_conv(kargs(), Cx, j, last); } else if (EN(7)) REPEAT(REP_ATTN) phase_attn<2>(kargs(), Cx, j, last); SEAM(base + 2); }
        if (IN(base + 3)) {
            if (!last && EN(1) && C.bid >= 64 && ((C.bid >> 3) & 1)) {
                Ctx Cx = fresh(C);
                convert_fill(kargs(), Cx, layer, fill_a(layer), fill_a(layer) + fill_b(layer), C.bid - 64, 1, 192);
                __syncthreads();
            }
            if (EN(8)) REPEAT(REP_G8) {
                const KArgs ap = kargs();
                pg8::Gemm g{P_R2, P_WM_O, nrows, D, D}; pg8::StaticOrder S; S.init(nrows, D, C.G, C.bid);
                pg8::EpiP<0> E{P_R3, nullptr, D, -1, 0, 0};
                if (NOSTORE_PROBE) { pg8::EpiP<9> E9{P_R3, nullptr, D, -1, 0, 0}; pg8::gemm_phase<pg8::EpiP<9>, pg8::StaticOrder, true, true>(ring, g, S, E9, C.wave); }
                pg8::gemm_phase<pg8::EpiP<0>, pg8::StaticOrder, true, true>(ring, g, S, E, C.wave);
            }
            if (!last && EN(1) && C.bid >= 64 && !((C.bid >> 3) & 1)) {
                __syncthreads(); Ctx Cx = fresh(C);
                convert_fill(kargs(), Cx, layer, fill_a(layer), fill_a(layer) + fill_b(layer), C.bid - 64, 1, 192);
            }
            SEAM(base + 3);
        }
        if (IN(base + 4)) { Ctx Cx = fresh(C); if (EN(9)) { if (DRY_LN1) { phase_ln1(kargs(), Cx, layer, last, 1); __syncthreads(); } phase_ln1(kargs(), Cx, layer, last); } SEAM(base + 4); }
        if (IN(base + 5)) {
            if (EN(11)) REPEAT(REP_G11) {
                const KArgs ap = kargs(); Ctx Cx = fresh(C);
                LAS int* poffs = (LAS int*)(C.lds + LDS_MOE); LAS int* tile_e = poffs + 64; LAS int* rows = poffs + 512;
                const int ntiles = moe_offsets(ap, Cx, layer, poffs, tile_e);
                moe_rows(ap, Cx, layer, poffs, tile_e, rows, ntiles);
                pg8::Gemm g{P_H, P_W1, MTOT, NEXP * 1024, D}; pg8::MoeOrder S{(const LAS int*)tile_e, (const LAS int*)rows, ntiles, C.bid};
                pg8::EpiP<1> E{P_R2, nullptr, EFF, 3, 0, 0};
                pg8::gemm_phase<pg8::EpiP<1>, pg8::MoeOrder, true, true, true>(ring, g, S, E, C.wave);
            }
            SEAM(base + 5);
        }
        if (IN(base + 6)) {
            if (EN(12)) REPEAT(REP_G12) {
                const KArgs ap = kargs(); Ctx Cx = fresh(C);
                LAS int* poffs = (LAS int*)(C.lds + LDS_MOE); LAS int* tile_e = poffs + 64;
                const int ntiles = moe_offsets(ap, Cx, layer, poffs, tile_e);
                pg8::Gemm g{P_R2, P_W2, ntiles * 256, NEXP * 1024, EFF}; pg8::MoeOrder S{(const LAS int*)tile_e, (const LAS int*)tile_e, ntiles, C.bid};
                pg8::EpiP<0> E{P_R3, nullptr, D, 3, 0, 0};
                pg8::gemm_phase<pg8::EpiP<0>, pg8::MoeOrder, true, true, false, true>(ring, g, S, E, C.wave);
            }
            SEAM(base + 6);
        }
        if (IN(base + 7)) { Ctx Cx = fresh(C); if (EN(13)) { if (DRY_LN2) { phase_ln2(kargs(), Cx, layer, last, 1); __syncthreads(); } phase_ln2(kargs(), Cx, layer, last); } if (!last && EN(1)) { __syncthreads(); convert_rest(kargs(), Cx, layer + 1); } SEAM(base + 7); }
    }
#undef IN
#undef SEAM
}

#ifndef MK_ONE_LAUNCH
#define MK_ONE_LAUNCH 1
#endif
extern "C" void kernel_launch(void* const* d_in, const int* in_sizes, int n_in, void* d_out, int out_size, void* d_ws, size_t ws_size, hipStream_t stream) {
    static int grid = 0;
    if (grid == 0) {
        if (n_in != 26 || in_sizes[0] != NLAT * D || out_size != NLAT * D || ws_size < WS_END) { fprintf(stderr, "kernel_launch: unexpected shapes (n_in %d, in0 %d, out %d, ws %zu < %zu); nothing launched\n", n_in, n_in > 0 ? in_sizes[0] : -1, out_size, ws_size, (size_t)WS_END); grid = -1; return; }
        int dev = 0, cus = 0, per_cu = 0;
        if (hipGetDevice(&dev) != hipSuccess || hipDeviceGetAttribute(&cus, hipDeviceAttributeMultiprocessorCount, dev) != hipSuccess) { fprintf(stderr, "kernel_launch: device query failed\n"); grid = -1; return; }
        if (hipFuncSetAttribute((const void*)mk_fwd, hipFuncAttributeMaxDynamicSharedMemorySize, LDS_BYTES) != hipSuccess) { fprintf(stderr, "kernel_launch: hipFuncSetAttribute failed\n"); grid = -1; return; }
        if (hipOccupancyMaxActiveBlocksPerMultiprocessor(&per_cu, (const void*)mk_fwd, 512, LDS_BYTES) != hipSuccess || per_cu < 1) { fprintf(stderr, "kernel_launch: occupancy query reports %d workgroups per CU\n", per_cu); }
        (void)hipGetLastError();
        grid = 256;
        if (cus < 256) { fprintf(stderr, "kernel_launch: %d CUs < 256: the grid would not be resident; nothing launched\n", cus); grid = -1; return; }
    }
    if (grid < 0) return;
    if (hipMemsetAsync((char*)d_ws + WS_CTL, 0, CTL_ZERO_BYTES, stream) != hipSuccess) { fprintf(stderr, "kernel_launch: hipMemsetAsync failed\n"); return; }
    Args a{};
    for (int i = 0; i < 26; ++i) a.in[i] = (const float*)d_in[i];
    a.out = (float*)d_out; a.ws = (unsigned char*)d_ws;
#if MK_ONE_LAUNCH
    a.ph_lo = 0; a.ph_hi = NPHASES;
    hipLaunchKernelGGL(mk_fwd, dim3(grid), dim3(512), LDS_BYTES, stream, a);
#else
    for (int p = 0; p < NPHASES; ++p) { a.ph_lo = p; a.ph_hi = p + 1; hipLaunchKernelGGL(mk_fwd, dim3(grid), dim3(512), LDS_BYTES, stream, a); }
#endif
    const hipError_t le = hipPeekAtLastError();
    if (le != hipSuccess) fprintf(stderr, "kernel_launch: launch failed: %s\n", hipGetErrorName(le));
}
```

```cpp
#include <hip/hip_runtime.h>
#include <cstdio>
#include <cstdint>

constexpr int D = 1024, NB = 16, SEQ = 2048, CTXL = 256, DEPTH = 4;
constexpr int NLAT = NB * SEQ;
constexpr int NCTX = NB * CTXL;
constexpr int MTOT = NLAT + NCTX;
constexpr int KVTOK = SEQ + CTXL;
constexpr int NEXP = 32, EFF = 512;
constexpr float LN_EPS = 1e-5f;
constexpr float ALPHA = 1.681792830507429f;
constexpr float LOG2E = 1.4426950408889634f;
constexpr float QSCALE = 0.125f * LOG2E;
constexpr float NEGBIG = -1e30f;
namespace pg8 {
#define PG8_LAS __attribute__((address_space(3)))
typedef unsigned short bf16_t;
typedef short bf16x8 __attribute__((ext_vector_type(8)));
typedef float f32x4 __attribute__((ext_vector_type(4)));
typedef unsigned u32x4 __attribute__((ext_vector_type(4)));
constexpr int BM = 256, BK = 64, HALF = 128, HTB = HALF * BK * 2  , STAGE_BYTES = 8 * HTB, NXCD = 8, WGM = 8;

__host__ __device__ __forceinline__ int lds_byte(int r, int c) { const int st = (r >> 4) * 2 + (c >> 5), rr = r & 15, cc = c & 31, ob = rr * 64 + cc * 2; return st * 1024 + (ob ^ (((ob >> 9) & 1) << 5)); }
__host__ __device__ __forceinline__ void stage_rc(int b, int& R, int& C) { const int st = b / 1024, sb = b % 1024, swz = sb ^ (((sb >> 9) & 1) << 5); R = (st >> 1) * 16 + swz / 64; C = (st & 1) * 32 + (swz % 64) / 2; }
__host__ __device__ __forceinline__ int perm32(int rho) { const int n = rho >> 4, i = rho & 15; return 8 * (i >> 2) + 4 * n + (i & 3); }

struct Unit { int pm, pn; };
struct Gemm { const bf16_t* A; const bf16_t* Bt; int M, N, K; };

struct StaticOrder {
    int nM, nN, nwg, G, c;
    __host__ __device__ void init(int M, int N, int G_, int c_) { nM = M / BM; nN = N / BM; nwg = nM * nN; G = G_; c = c_; }
    __host__ __device__ bool next(int i, Unit& u) const {
        const long L = (long)i * G + c; if (L >= nwg) return false;
        int wgid = (int)L; { const int q = nwg / NXCD, r = nwg % NXCD, xcd = wgid % NXCD, off = wgid / NXCD; wgid = (xcd < r ? xcd * (q + 1) : r * (q + 1) + (xcd - r) * q) + off; }
        const int nig = WGM * nN, gid = wgid / nig, fm = gid * WGM, gsz = (nM - fm) < WGM ? (nM - fm) : WGM;
        u.pm = fm + ((wgid % nig) % gsz); u.pn = (wgid % nig) / gsz; return true;
    }
    __device__ __forceinline__ void a_ready(const Unit&) const {}
    __device__ __forceinline__ void done(const Unit&) const {}
};


__device__ __forceinline__ unsigned cvt_pk_bf16(float lo, float hi) { unsigned r; asm volatile("v_cvt_pk_bf16_f32 %0, %1, %2" : "=v"(r) : "v"(lo), "v"(hi)); return r; }
typedef unsigned u32x2 __attribute__((ext_vector_type(2)));
__device__ __forceinline__ u32x2 pk4(const f32x4 v) { u32x2 w; w.x = cvt_pk_bf16(v[0], v[1]); w.y = cvt_pk_bf16(v[2], v[3]); return w; }
__device__ __forceinline__ u32x4 pk8(const f32x4 a, const f32x4 b) { u32x4 w; w.x = cvt_pk_bf16(a[0], a[1]); w.y = cvt_pk_bf16(a[2], a[3]); w.z = cvt_pk_bf16(b[0], b[1]); w.w = cvt_pk_bf16(b[2], b[3]); return w; }
#ifndef WT_STORES
#define WT_STORES 1
#endif
__device__ __forceinline__ void st16(bf16_t* p, const u32x4 v) {
#if WT_STORES
    asm volatile("global_store_dwordx4 %0, %1, off sc1\n\ts_nop 1" :: "v"(p), "v"(v) : "memory");
#else
    *(u32x4*)p = v;
#endif
}
__device__ __forceinline__ void st8(bf16_t* p, const u32x2 v) {
#if WT_STORES
    asm volatile("global_store_dwordx2 %0, %1, off sc1\n\ts_nop 1" :: "v"(p), "v"(v) : "memory");
#else
    *(u32x2*)p = v;
#endif
}
__device__ __forceinline__ void row_bt(int row, int& b, int& tok) { if (row < NLAT) { b = row >> 11; tok = row & 2047; } else { const int r = row - NLAT; b = r >> 8; tok = SEQ + (r & 255); } }

struct EpiQK {
    static constexpr bool PERM = false, AFTER_DRAIN = false;
    bf16_t* Q; bf16_t* Kb; const float* rope; int nkvh; float qscale;
    __device__ __forceinline__ void operator()(const f32x4 (&acc)[2][2][4][2], const Unit& u, int wr, int wc, int fr, int fq) const {
        const bool isQ = u.pn < 4, dorope = (rope != nullptr) && (u.pm < NLAT / BM);
        const int qi_ = fr & 3;
#pragma unroll
        for (int ai = 0; ai < 2; ++ai)
#pragma unroll
            for (int m = 0; m < 4; ++m) {
                const int row = u.pm * BM + ai * HALF + wr * 64 + m * 16 + fr;
                int b, tok; row_bt(row, b, tok);
                u32x2 pc[4];
#pragma unroll
                for (int bj = 0; bj < 2; ++bj) {
                    f32x4 cs = {1.f, 1.f, 1.f, 1.f}, sn = {0.f, 0.f, 0.f, 0.f};
                    if (dorope) { const int pos = bj ? (tok & 63) : (tok >> 6); const float* t = rope + (pos * 16 + 4 * fq) * 2;
                        const f32x4 t0 = *(const f32x4*)t, t1 = *(const f32x4*)(t + 4); cs = (f32x4){t0[0], t0[2], t1[0], t1[2]}; sn = (f32x4){t0[1], t0[3], t1[1], t1[3]}; }
                    const f32x4 x1 = acc[ai][bj][m][0], x2 = acc[ai][bj][m][1];
                    f32x4 o1 = x1 * cs - x2 * sn, o2 = x1 * sn + x2 * cs;
                    if (isQ) { o1 = o1 * qscale; o2 = o2 * qscale; }
                    pc[2 * bj] = pk4(o1); pc[2 * bj + 1] = pk4(o2);
                }
#pragma unroll
                for (int q = 0; q < 2; ++q) {
                    u32x2 snd = (qi_ & 1) ? pc[2 * q] : pc[2 * q + 1], rcv;
                    rcv.x = (unsigned)__builtin_amdgcn_mov_dpp((int)snd.x, 0xB1, 0xF, 0xF, true); rcv.y = (unsigned)__builtin_amdgcn_mov_dpp((int)snd.y, 0xB1, 0xF, 0xF, true);
                    if (qi_ & 1) pc[2 * q] = rcv; else pc[2 * q + 1] = rcv; }
#pragma unroll
                for (int q = 0; q < 2; ++q) {
                    u32x2 snd = (qi_ & 2) ? pc[q] : pc[q + 2], rcv;
                    rcv.x = (unsigned)__builtin_amdgcn_mov_dpp((int)snd.x, 0x4E, 0xF, 0xF, true); rcv.y = (unsigned)__builtin_amdgcn_mov_dpp((int)snd.y, 0x4E, 0xF, 0xF, true);
                    if (qi_ & 2) pc[q] = rcv; else pc[q + 2] = rcv; }
                if (isQ) { bf16_t* dst = Q + (size_t)(row - qi_) * D + u.pn * BM + wc * 64 + 16 * qi_ + 4 * fq;
#pragma unroll
                    for (int r = 0; r < 4; ++r) st8(dst + (size_t)r * D, pc[r]); }
                else { const int head = (u.pn - 4) * 4 + wc; bf16_t* dst = Kb + ((size_t)(b * nkvh + head) * KVTOK + (tok - qi_)) * 64 + 16 * qi_ + 4 * fq;
#pragma unroll
                    for (int r = 0; r < 4; ++r) st8(dst + r * 64, pc[r]); }
            }
    }
};

__device__ __forceinline__ void store_pair_rows(bf16_t* rowp_even, size_t ld, const u32x4 w0, const u32x4 w1, int odd) {
    u32x4 snd, rcv, s1, s2;
#pragma unroll
    for (int q = 0; q < 4; ++q) { snd[q] = odd ? w0[q] : w1[q]; rcv[q] = (unsigned)__builtin_amdgcn_mov_dpp((int)snd[q], 0xB1, 0xF, 0xF, true); }
#pragma unroll
    for (int q = 0; q < 4; ++q) { s1[q] = odd ? rcv[q] : w0[q]; s2[q] = odd ? w1[q] : rcv[q]; }
    st16(rowp_even, s1); st16(rowp_even + ld, s2);
}
template <int MODE> struct EpiP {
    static constexpr bool PERM = true, AFTER_DRAIN = false;
    bf16_t* O; bf16_t* O2; int ldc, pnmask, sub, nkvh;
    __device__ __forceinline__ void operator()(const f32x4 (&acc)[2][2][4][2], const Unit& u, int wr, int wc, int fr, int fq) const {
        if constexpr (MODE == 9) {
#pragma unroll
            for (int ai = 0; ai < 2; ++ai)
#pragma unroll
                for (int m = 0; m < 4; ++m)
#pragma unroll
                    for (int bj = 0; bj < 2; ++bj) asm volatile("" :: "v"(acc[ai][bj][m][0]), "v"(acc[ai][bj][m][1]));
        } else if constexpr (MODE == 0) {
            const int odd = fr & 1, col0 = (u.pn & pnmask) * BM + wc * 64 + 8 * fq + 32 * odd;
#pragma unroll
            for (int ai = 0; ai < 2; ++ai)
#pragma unroll
                for (int m = 0; m < 4; ++m) { bf16_t* rowp = O + (size_t)(u.pm * BM + ai * HALF + wr * 64 + m * 16 + fr - odd) * ldc + col0;
                    store_pair_rows(rowp, (size_t)ldc, pk8(acc[ai][0][m][0], acc[ai][0][m][1]), pk8(acc[ai][1][m][0], acc[ai][1][m][1]), odd); }
        } else if constexpr (MODE == 1) {
            bf16_t* blk = O + (size_t)u.pm * (BM * 512) + (size_t)((u.pn & 3) * 4 + wc) * (BM * 32) + (size_t)wr * (64 * 32);
            const unsigned lo = (unsigned)(fr * 32 + 8 * fq);
#pragma unroll
            for (int ai = 0; ai < 2; ++ai)
#pragma unroll
                for (int m = 0; m < 4; ++m) { bf16_t* rowp = blk + (ai * HALF + m * 16) * 32 + lo;
                    f32x4 h[2];
#pragma unroll
                    for (int n = 0; n < 2; ++n) { const f32x4 g = acc[ai][0][m][n], up = acc[ai][1][m][n];
#pragma unroll
                        for (int j = 0; j < 4; ++j) { const float e = __builtin_amdgcn_exp2f(-g[j] * LOG2E); h[n][j] = g[j] * __builtin_amdgcn_rcpf(1.0f + e) * up[j]; } }
                    st16(rowp, pk8(h[0], h[1])); }
        } else {
            if (sub == 0) {
                int b, tok0; row_bt(u.pn * BM, b, tok0);
                const int odd = fr & 1, tcol = tok0 + wc * 64 + 8 * fq + 32 * odd;
#pragma unroll
                for (int ai = 0; ai < 2; ++ai)
#pragma unroll
                    for (int m = 0; m < 4; ++m) { const int f = u.pm * BM + ai * HALF + wr * 64 + m * 16 + fr - odd; const int head = f >> 6, d = f & 63;
                        bf16_t* rowp = O + ((size_t)(b * nkvh + head) * 64 + d) * KVTOK + tcol;
                        store_pair_rows(rowp, (size_t)KVTOK, pk8(acc[ai][0][m][0], acc[ai][0][m][1]), pk8(acc[ai][1][m][0], acc[ai][1][m][1]), odd); }
            } else {
                if (u.pn < 8) {
                    const int col0 = u.pn * HALF + wc * 32 + 8 * fq;
#pragma unroll
                    for (int ai = 0; ai < 2; ++ai)
#pragma unroll
                        for (int m = 0; m < 4; ++m) { bf16_t* rowp = O + (size_t)(u.pm * BM + ai * HALF + wr * 64 + m * 16 + fr) * D + col0;
                            st16(rowp, pk8(acc[ai][0][m][0] * acc[ai][1][m][0], acc[ai][0][m][1] * acc[ai][1][m][1])); }
                } else {
                    const int odd = fr & 1, col0 = (u.pn - 8) * BM + wc * 64 + 8 * fq + 32 * odd;
#pragma unroll
                    for (int ai = 0; ai < 2; ++ai)
#pragma unroll
                        for (int m = 0; m < 4; ++m) { bf16_t* rowp = O2 + (size_t)(u.pm * BM + ai * HALF + wr * 64 + m * 16 + fr - odd) * D + col0;
                            store_pair_rows(rowp, (size_t)D, pk8(acc[ai][0][m][0], acc[ai][0][m][1]), pk8(acc[ai][1][m][0], acc[ai][1][m][1]), odd); }
                }
            }
        }
    }
};

struct MoeOrder {
    const PG8_LAS int* tile_e; const PG8_LAS int* rows; int ntiles, c;
    __device__ __forceinline__ bool next(int i, Unit& u) const {
        const int tile = i * 64 + (c & 7) * 8 + (c >> 5); if (tile >= ntiles) return false;
        u.pm = tile; u.pn = __builtin_amdgcn_readfirstlane(tile_e[tile]) * 4 + ((c >> 3) & 3); return true;
    }
    __device__ __forceinline__ int row(int ui, int r) const { return rows[ui * 256 + r]; }
    __device__ __forceinline__ void a_ready(const Unit&) const {}
    __device__ __forceinline__ void done(const Unit&) const {}
};
template <class Epi, class Sched, bool ALIGN_EPI = false, bool SP2 = true, bool GATHER = false, bool ABLK = false>
__device__ __forceinline__ void gemm_phase(PG8_LAS unsigned char* lds, const Gemm g, const Sched& S, const Epi& E, int wv  ) {
    int tid_; asm volatile("v_mbcnt_lo_u32_b32 %0, -1, 0\n\tv_mbcnt_hi_u32_b32 %0, -1, %0" : "=v"(tid_)); tid_ += wv * 64;
    static_assert(SP2, "the 64-column-per-wave B mapping reads both of a wave's B fragments from ONE half buffer in SP1: only the two-super-phase loop has them retired together");
    const int tid = tid_, wid = __builtin_amdgcn_readfirstlane(tid >> 6), lane = tid & 63, wr = wid >> 2, wc = wid & 3, fr = lane & 15, fq = lane >> 4;
    const int K = g.K, nt = K / BK;
    unsigned voffA[2][2], voffB[2];
#pragma unroll
    for (int i = 0; i < 2; ++i) { int R, C; stage_rc(tid * 16 + i * 8192, R, C); const int Rb = Epi::PERM ? ((R & ~31) + perm32(R & 31)) : R;
        voffA[0][i] = ABLK ? (unsigned)((C >> 5) * 16384 + R * 64 + (C & 31) * 2) : (unsigned)(R * K + C) * 2u; voffA[1][i] = voffA[0][i];     voffB[i] = (unsigned)(Rb * K + C) * 2u; }
#define PG8_GOFF(dst, uidx) do { _Pragma("unroll") for (int _i = 0; _i < 2; ++_i) { int R_, C_; stage_rc(tid * 16 + _i * 8192, R_, C_); \
        dst[0][_i] = (unsigned)(S.row(uidx, R_) * K + C_) * 2u; dst[1][_i] = (unsigned)(S.row(uidx, R_ + HALF) * K + C_) * 2u; } } while (0)
    const size_t kstep = (size_t)(BK * 2);
    const size_t kstepA = ABLK ? (size_t)32768 : kstep;
    const size_t hstep = (size_t)HALF * K * 2;
    const size_t hstepA = GATHER ? (size_t)0 : (ABLK ? (size_t)(HALF * 64) : hstep);
    const size_t tstep = 2 * hstep;
    const unsigned ldsw = (unsigned)wid * 1024u;
    const int aoff = lds_byte(wr * 64 + fr, fq * 8), boff = lds_byte((wc & 1) * 64 + fr, fq * 8) + (wc >> 1) * HTB;
#define PG8_SA(b, h) (((b) * 2 + (h)) * HTB)
#define PG8_SB(b, h) ((4 + (b) * 2 + (h)) * HTB)
#define PG8_STAGE(bufoff, gbase, voff) do { _Pragma("unroll") for (int _i = 0; _i < 2; ++_i) \
        __builtin_amdgcn_global_load_lds((const unsigned*)((const char*)(gbase) + (voff)[_i]), (PG8_LAS unsigned*)(lds + (bufoff) + ldsw + _i * 8192), 16, 0, 0); } while (0)
#define PG8_LDA(dst, b, h) do { _Pragma("unroll") for (int m = 0; m < 4; ++m) _Pragma("unroll") for (int k = 0; k < 2; ++k) dst[m][k] = *(const PG8_LAS bf16x8*)(lds + PG8_SA(b, h) + aoff + m * 2048 + k * 1024); } while (0)
#define PG8_LDB(dst, b, h) do { _Pragma("unroll") for (int n = 0; n < 2; ++n) _Pragma("unroll") for (int k = 0; k < 2; ++k) dst[n][k] = *(const PG8_LAS bf16x8*)(lds + PG8_SB(b, 0) + boff + (h) * 4096 + n * 2048 + k * 1024); } while (0)
#define PG8_MMA(ai, bj, At, Bt) do { __builtin_amdgcn_s_setprio(1); _Pragma("unroll") for (int m = 0; m < 4; ++m) _Pragma("unroll") for (int n = 0; n < 2; ++n) _Pragma("unroll") for (int k = 0; k < 2; ++k) \
        acc[ai][bj][m][n] = __builtin_amdgcn_mfma_f32_16x16x32_bf16(Bt[n][k], At[m][k], acc[ai][bj][m][n], 0, 0, 0); __builtin_amdgcn_s_setprio(0); } while (0)
#define PG8_WAIT_V(n) asm volatile("s_waitcnt vmcnt(" #n ")" ::: "memory")
#define PG8_WAIT_L(n) asm volatile("s_waitcnt lgkmcnt(" #n ")" ::: "memory")
#define PG8_BAR __builtin_amdgcn_s_barrier()
#define PG8_SCHED __builtin_amdgcn_sched_barrier(0)
    Unit cur, nxt; int ui = 0;
    if (!S.next(0, cur)) return;
    f32x4 acc[2][2][4][2];
#pragma unroll
    for (int a = 0; a < 2; ++a)
#pragma unroll
        for (int b = 0; b < 2; ++b)
#pragma unroll
            for (int m = 0; m < 4; ++m)
#pragma unroll
                for (int n = 0; n < 2; ++n) acc[a][b][m][n] = (f32x4){0.f, 0.f, 0.f, 0.f};
    bf16x8 At[4][2], B0[2][2], B1[2][2];
    const char* cA = (const char*)g.A + (GATHER ? (size_t)0 : (size_t)cur.pm * tstep); const char* cB = (const char*)g.Bt + (size_t)cur.pn * tstep;
    if constexpr (GATHER) PG8_GOFF(voffA, 0);
    S.a_ready(cur);
    if constexpr (SP2) {
        PG8_STAGE(PG8_SB(0, 0), cB, voffB); PG8_STAGE(PG8_SB(0, 1), cB + hstep, voffB); PG8_STAGE(PG8_SA(0, 0), cA, voffA[0]); PG8_STAGE(PG8_SA(0, 1), cA + hstepA, voffA[1]);
        if (wr == 1) PG8_BAR;
        PG8_WAIT_V(2); PG8_BAR;
        PG8_STAGE(PG8_SB(1, 0), cB + kstep, voffB); PG8_STAGE(PG8_SA(1, 0), cA + kstepA, voffA[0]); PG8_STAGE(PG8_SB(1, 1), cB + hstep + kstep, voffB);
        PG8_WAIT_V(6); PG8_BAR;
    } else {
        PG8_STAGE(PG8_SB(0, 0), cB, voffB); PG8_STAGE(PG8_SA(0, 0), cA, voffA[0]); PG8_STAGE(PG8_SB(0, 1), cB + hstep, voffB); PG8_STAGE(PG8_SA(0, 1), cA + hstepA, voffA[1]);
        if (wr == 1) PG8_BAR;
        PG8_WAIT_V(4); PG8_BAR;
        PG8_STAGE(PG8_SB(1, 0), cB + kstep, voffB); PG8_STAGE(PG8_SA(1, 0), cA + kstepA, voffA[0]); PG8_STAGE(PG8_SB(1, 1), cB + hstep + kstep, voffB);
        PG8_WAIT_V(6); PG8_BAR;
    }
    for (;;) {
        const bool has_next = S.next(ui + 1, nxt);
        const char* nA = (has_next && !GATHER) ? (const char*)g.A + (size_t)nxt.pm * tstep : cA; const char* nB = has_next ? (const char*)g.Bt + (size_t)nxt.pn * tstep : cB;
#pragma nounroll
        for (int t = 0; t < nt; t += 2) {
            const bool last = (t == nt - 2);
            const char* a1 = cA + (size_t)(t + 1) * kstepA;
            const char* a2 = last ? nA : cA + (size_t)(t + 2) * kstepA; const char* b2 = last ? nB : cB + (size_t)(t + 2) * kstep;
            const char* a3 = a2 + kstepA; const char* b3 = b2 + kstep;
            if (last && has_next) S.a_ready(nxt);
            if constexpr (SP2) {
            PG8_LDB(B0, 0, 0); PG8_LDB(B1, 0, 1); PG8_SCHED; PG8_LDA(At, 0, 0); PG8_STAGE(PG8_SA(1, 1), a1 + hstepA, voffA[1]);
            if constexpr (GATHER) { if (last && has_next) PG8_GOFF(voffA, ui + 1); }
            PG8_WAIT_V(8); PG8_WAIT_L(0); PG8_BAR; PG8_MMA(0, 0, At, B0); PG8_MMA(0, 1, At, B1); PG8_BAR; PG8_SCHED;
            PG8_LDA(At, 0, 1); PG8_STAGE(PG8_SB(0, 0), b2, voffB); PG8_STAGE(PG8_SB(0, 1), b2 + hstep, voffB); PG8_STAGE(PG8_SA(0, 0), a2, voffA[0]);
            PG8_WAIT_V(8); PG8_WAIT_L(0); PG8_BAR; PG8_MMA(1, 0, At, B0); PG8_MMA(1, 1, At, B1); PG8_BAR; PG8_SCHED;
            PG8_LDB(B0, 1, 0); PG8_LDB(B1, 1, 1); PG8_SCHED; PG8_LDA(At, 1, 0); PG8_STAGE(PG8_SA(0, 1), a2 + hstepA, voffA[1]);
            PG8_WAIT_V(8); PG8_WAIT_L(0); PG8_BAR; PG8_MMA(0, 0, At, B0); PG8_MMA(0, 1, At, B1); PG8_BAR; PG8_SCHED;
            PG8_LDA(At, 1, 1); PG8_STAGE(PG8_SB(1, 0), b3, voffB); PG8_STAGE(PG8_SB(1, 1), b3 + hstep, voffB); PG8_STAGE(PG8_SA(1, 0), a3, voffA[0]);
            PG8_WAIT_V(8); PG8_WAIT_L(0); PG8_BAR; PG8_MMA(1, 0, At, B0); PG8_MMA(1, 1, At, B1); PG8_BAR; PG8_SCHED;
            } else {
            PG8_LDB(B0, 0, 0); PG8_SCHED; PG8_LDA(At, 0, 0); PG8_STAGE(PG8_SA(1, 1), a1 + hstepA, voffA[1]);
            PG8_WAIT_L(8); PG8_BAR; PG8_WAIT_L(0); PG8_MMA(0, 0, At, B0); PG8_BAR; PG8_SCHED;
            PG8_LDB(B1, 0, 1); PG8_STAGE(PG8_SB(0, 0), b2, voffB);
            PG8_BAR; PG8_WAIT_L(0); PG8_MMA(0, 1, At, B1); PG8_BAR;
            PG8_LDA(At, 0, 1); PG8_STAGE(PG8_SA(0, 0), a2, voffA[0]);
            PG8_BAR; PG8_WAIT_L(0); PG8_MMA(1, 0, At, B0); PG8_BAR; PG8_SCHED;
            PG8_STAGE(PG8_SB(0, 1), b2 + hstep, voffB);
            PG8_WAIT_V(6); PG8_BAR; PG8_MMA(1, 1, At, B1); PG8_BAR;
            PG8_LDB(B0, 1, 0); PG8_SCHED; PG8_LDA(At, 1, 0); PG8_STAGE(PG8_SA(0, 1), a2 + hstepA, voffA[1]);
            PG8_WAIT_L(8); PG8_BAR; PG8_WAIT_L(0); PG8_MMA(0, 0, At, B0); PG8_BAR; PG8_SCHED;
            PG8_LDB(B1, 1, 1); PG8_STAGE(PG8_SB(1, 0), b3, voffB);
            PG8_BAR; PG8_WAIT_L(0); PG8_MMA(0, 1, At, B1); PG8_BAR;
            PG8_LDA(At, 1, 1); PG8_STAGE(PG8_SA(1, 0), a3, voffA[0]);
            PG8_BAR; PG8_WAIT_L(0); PG8_MMA(1, 0, At, B0); PG8_BAR; PG8_SCHED;
            PG8_STAGE(PG8_SB(1, 1), b3 + hstep, voffB);
            PG8_WAIT_V(6); PG8_BAR; PG8_MMA(1, 1, At, B1); PG8_BAR;
            }
        }
        if constexpr (ALIGN_EPI) { if (wr == 0) PG8_BAR; }
        if constexpr (!Epi::AFTER_DRAIN) { E(acc, cur, wr, wc, fr, fq); S.done(cur); }
        if (!has_next) break;
#pragma unroll
        for (int a = 0; a < 2; ++a)
#pragma unroll
            for (int b = 0; b < 2; ++b)
#pragma unroll
                for (int m = 0; m < 4; ++m)
#pragma unroll
                    for (int n = 0; n < 2; ++n) acc[a][b][m][n] = (f32x4){0.f, 0.f, 0.f, 0.f};
        cur = nxt; cA = nA; cB = nB; ++ui;
        if constexpr (ALIGN_EPI) { if (wr == 1) PG8_BAR; }
    }
    PG8_WAIT_V(0);
    if constexpr (!ALIGN_EPI) { if (wr == 0) PG8_BAR; }
    PG8_BAR;
    if constexpr (Epi::AFTER_DRAIN) { E.fused(acc, cur, wr, wc, fr, fq, lds, wid, lane); S.done(cur); }
#undef PG8_SA
#undef PG8_SB
#undef PG8_STAGE
#undef PG8_GOFF
#undef PG8_LDA
#undef PG8_LDB
#undef PG8_MMA
#undef PG8_WAIT_V
#undef PG8_WAIT_L
#undef PG8_BAR
#undef PG8_SCHED
}
}

constexpr size_t MiB = 1u << 20;
constexpr size_t WS_CTL = 0, CTL_ZERO_BYTES = 1 * MiB;
constexpr size_t WS_MOD = 1 * MiB;
constexpr size_t WS_ROPE = 3 * MiB;
constexpr size_t WS_ROUT = 4 * MiB;
constexpr size_t WS_X = 8 * MiB;
constexpr size_t WS_H = 152 * MiB;
constexpr size_t WS_R1 = 224 * MiB;
constexpr size_t WS_R2 = 440 * MiB;
constexpr size_t WS_R3 = 520 * MiB;
constexpr size_t WS_WM = 680 * MiB;
constexpr size_t WS_W1 = 688 * MiB;
constexpr size_t WS_W2 = 752 * MiB;
constexpr size_t WS_END = 784 * MiB;
constexpr int CW_BAR = 4096;
constexpr int CW_CNT = 16384;
constexpr int CW_Q = 20480;
constexpr int CW_DONE = 24576;
constexpr int LDS_BYTES = 155648;
constexpr int LDS_MOE = 131072;
constexpr int LDS_MISC = LDS_BYTES - 256;

#define GAS __attribute__((address_space(1)))
#define LAS __attribute__((address_space(3)))
typedef unsigned short bf16;
typedef unsigned v4u __attribute__((ext_vector_type(4)));
typedef unsigned v2u __attribute__((ext_vector_type(2)));
typedef float f32x4 __attribute__((ext_vector_type(4)));
typedef float f32x2 __attribute__((ext_vector_type(2)));
typedef float f32x16 __attribute__((ext_vector_type(16)));
typedef short bf16x8 __attribute__((ext_vector_type(8)));
typedef _Float16 f16;
typedef _Float16 h16x4 __attribute__((ext_vector_type(4)));
typedef _Float16 h16x8 __attribute__((ext_vector_type(8)));
#ifndef WT_PHASE
#define WT_PHASE 1
#endif
__device__ __forceinline__ __amdgpu_buffer_rsrc_t mkrs(const void* p) { return __builtin_amdgcn_make_buffer_rsrc((void*)p, 0, 0x7fffffff, 0x00020000); }
__device__ __forceinline__ void gst16(void* base, size_t boff, const v4u v) {
#if WT_PHASE
    __builtin_amdgcn_raw_buffer_store_b128(v, mkrs(base), (int)boff, 0, 16);
#else
    *(v4u*)((char*)base + boff) = v;
#endif
}
__device__ __forceinline__ void gst8(void* base, size_t boff, const v2u v) {
#if WT_PHASE
    __builtin_amdgcn_raw_buffer_store_b64(v, mkrs(base), (int)boff, 0, 16);
#else
    *(v2u*)((char*)base + boff) = v;
#endif
}
__device__ __forceinline__ void pst16(void* base, size_t boff, const v4u v) { *(v4u*)((char*)base + boff) = v; }
__device__ __forceinline__ void pst8(void* base, size_t boff, const v2u v) { *(v2u*)((char*)base + boff) = v; }
__device__ __forceinline__ void pst16_nt(void* base, size_t boff, const v4u v) { __builtin_nontemporal_store(v, (v4u*)((char*)base + boff)); }
__device__ __forceinline__ void gst16_nt(void* base, size_t boff, const v4u v) {
#if WT_PHASE
    __builtin_amdgcn_raw_buffer_store_b128(v, mkrs(base), (int)boff, 0, 18);
#else
    __builtin_nontemporal_store(v, (v4u*)((char*)base + boff));
#endif
}
#define LDS_WAIT() asm volatile("s_waitcnt lgkmcnt(0)" ::: "memory")
__device__ __forceinline__ unsigned f2bf(float f) { unsigned u = __builtin_bit_cast(unsigned, f); return (u + 0x7fffu + ((u >> 16) & 1u)) >> 16; }
__device__ __forceinline__ unsigned pk2(float lo, float hi) { return pg8::cvt_pk_bf16(lo, hi); }
typedef __bf16 bf16x2_t __attribute__((ext_vector_type(2)));
__device__ __forceinline__ unsigned pk2c(float lo, float hi) { const f32x2 v = {lo, hi}; return __builtin_bit_cast(unsigned, __builtin_convertvector(v, bf16x2_t)); }
__device__ __forceinline__ float bflo(unsigned w) { return __uint_as_float(w << 16); }
__device__ __forceinline__ float bfhi(unsigned w) { return __uint_as_float(w & 0xffff0000u); }
__device__ __forceinline__ f32x4 bf4(v2u w) { return (f32x4){bflo(w.x), bfhi(w.x), bflo(w.y), bfhi(w.y)}; }
__device__ __forceinline__ int lane_id_fresh() { int ln; asm volatile("v_mbcnt_lo_u32_b32 %0, -1, 0\n\tv_mbcnt_hi_u32_b32 %0, -1, %0" : "=v"(ln)); return ln; }
template <int CTRL, int RM> __device__ __forceinline__ float dpp0(float src) {
    return __builtin_bit_cast(float, __builtin_amdgcn_update_dpp(0, __builtin_bit_cast(int, src), CTRL, RM, 0xF, true)); }
__device__ __forceinline__ float wave_sum(float v) {
    v += dpp0<0xB1, 0xF>(v); v += dpp0<0x4E, 0xF>(v); v += dpp0<0x141, 0xF>(v); v += dpp0<0x140, 0xF>(v);
    v += dpp0<0x142, 0xA>(v); v += dpp0<0x143, 0xC>(v);
    return __builtin_bit_cast(float, __builtin_amdgcn_readlane(__builtin_bit_cast(int, v), 63));
}
__device__ __forceinline__ float xor32_max(float v) { const auto rr = __builtin_amdgcn_permlane32_swap(__float_as_uint(v), __float_as_uint(v), false, false); return fmaxf(__uint_as_float(rr[0]), __uint_as_float(rr[1])); }
__device__ __forceinline__ float xor32_sum(float v) { const auto rr = __builtin_amdgcn_permlane32_swap(__float_as_uint(v), __float_as_uint(v), false, false); return __uint_as_float(rr[0]) + __uint_as_float(rr[1]); }
#define XB_TMO      128
#define XB_XCNT(j)  (256  + 64 * (j))
#define XB_XSUB(j)  (1280 + 64 * (j))
#define XB_XGEN(j)  (2304 + 64 * (j))
#define XB_TOP      3328
#define XB_TOPGEN   3392
#define XCD_BAR_WORDS 3456
#define XB_SPIN_CAP (1u << 18)

__device__ __forceinline__ unsigned xb_ld(unsigned* p)              { return __hip_atomic_load(p, __ATOMIC_RELAXED, __HIP_MEMORY_SCOPE_AGENT); }
__device__ __forceinline__ unsigned xb_add(unsigned* p, unsigned v) { return __hip_atomic_fetch_add(p, v, __ATOMIC_RELAXED, __HIP_MEMORY_SCOPE_AGENT); }
__device__ __forceinline__ unsigned xb_xcc_id() { return (unsigned)__builtin_amdgcn_s_getreg((3 << 11) | 20) & 0xFu; }
#define XB_SPIN(cond, bar) do { unsigned _sp = 0; while (cond) { __builtin_amdgcn_s_sleep(1); \
    if ((++_sp & 255u) == 0u) { if (xb_ld(&(bar)[XB_TMO])) break; if (_sp > XB_SPIN_CAP) { atomicAdd(&(bar)[XB_TMO], 1u); break; } } } } while (0)

struct XcdBarrier {
    unsigned* bar; unsigned x;
    volatile LAS unsigned* st;
};

__device__ __forceinline__ XcdBarrier xcd_barrier_post(unsigned* bar, volatile LAS unsigned* st) {
    XcdBarrier b; b.bar = bar; b.x = xb_xcc_id(); b.st = st;
    if (threadIdx.x == 0) (void)xb_add(&bar[XB_XCNT(b.x)], 1u);
    return b;
}
__device__ __forceinline__ void xcd_barrier_complete(unsigned* bar, unsigned x, unsigned& nloc, unsigned& nx) {
    const unsigned G = gridDim.x * gridDim.y * gridDim.z;
    unsigned sum, cnt, mine, sp = 0u;
    for (;;) {
        sum = 0u; cnt = 0u; mine = 0u;
#pragma unroll
        for (unsigned j = 0; j < 16; ++j) { const unsigned c = xb_ld(&bar[XB_XCNT(j)]); sum += c; cnt += (c > 0u) ? 1u : 0u; mine = (j == x) ? c : mine; }
        if (sum == G) break;
        __builtin_amdgcn_s_sleep(1);
        if ((++sp & 255u) == 0u) { if (xb_ld(&bar[XB_TMO])) break; if (sp > XB_SPIN_CAP) { atomicAdd(&bar[XB_TMO], 1u); break; } }
    }
    nloc = mine > 0u ? mine : 1u; nx = cnt > 0u ? cnt : 1u;
}

__device__ __forceinline__ void xcd_barrier(const XcdBarrier& b) {
    asm volatile("s_waitcnt vmcnt(0)" ::: "memory");
    __syncthreads();
    if (threadIdx.x == 0) {
        unsigned* bar = b.bar;
        __builtin_amdgcn_s_waitcnt(0);
        unsigned nloc = b.st[0], nx = b.st[1];
        if (nloc == 0u) { xcd_barrier_complete(bar, b.x, nloc, nx); b.st[0] = nloc; b.st[1] = nx; }
        const unsigned old = xb_add(&bar[XB_XSUB(b.x)], 1u);
        const unsigned gen = old / nloc;
        if (old + 1u == (gen + 1u) * nloc) {
            __builtin_amdgcn_fence(__ATOMIC_RELEASE, "agent");
            asm volatile("s_waitcnt vmcnt(0)" ::: "memory");
            const unsigned og = xb_add(&bar[XB_TOP], 1u);
            const unsigned tg = og / nx;
            if (og + 1u == (tg + 1u) * nx) xb_add(&bar[XB_TOPGEN], 1u);
            else XB_SPIN(xb_ld(&bar[XB_TOPGEN]) == tg, bar);
            __builtin_amdgcn_fence(__ATOMIC_ACQUIRE, "agent");
            xb_add(&bar[XB_XGEN(b.x)], 1u);
            asm volatile("s_waitcnt vmcnt(0)" ::: "memory");
        } else {
            XB_SPIN(xb_ld(&bar[XB_XGEN(b.x)]) == gen, bar);
            __builtin_amdgcn_fence(__ATOMIC_ACQUIRE, "agent");
            asm volatile("s_waitcnt vmcnt(0)" ::: "memory");
        }
    }
    __syncthreads();
}
struct Args { const float* in[26]; float* out; unsigned char* ws; int ph_lo, ph_hi; };
typedef const Args __attribute__((address_space(4)))* KArgs;
__device__ __forceinline__ KArgs kargs() { KArgs p = (KArgs)__builtin_amdgcn_kernarg_segment_ptr(); asm volatile("" : "+s"(p)); return p; }
#define P_x (ap->in[0])
#define P_c (ap->in[1])
#define P_ctx (ap->in[2])
#define P_c_ctx (ap->in[3])
#define P_w_ada (ap->in[4])
#define P_b_ada (ap->in[5])
#define P_ln1_g (ap->in[6])
#define P_ln1_b (ap->in[7])
#define P_ln2_g (ap->in[8])
#define P_ln2_b (ap->in[9])
#define P_attn_w_qkv (ap->in[10])
#define P_attn_w_o (ap->in[11])
#define P_attn_sink (ap->in[12])
#define P_conv_w_in (ap->in[13])
#define P_conv_w (ap->in[14])
#define P_conv_w_out (ap->in[15])
#define P_nat_w_qkv (ap->in[16])
#define P_nat_w_o (ap->in[17])
#define P_nat_rpb (ap->in[18])
#define P_r_wg (ap->in[19])
#define P_r_bg (ap->in[20])
#define P_r_we (ap->in[21])
#define P_r_be (ap->in[22])
#define P_e_wg (ap->in[23])
#define P_e_wu (ap->in[24])
#define P_e_wd (ap->in[25])
#define P_out (ap->out)
#define P_ctl ((unsigned*)(ap->ws + WS_CTL))
#define P_mod ((float*)(ap->ws + WS_MOD))
#define P_rope ((float*)(ap->ws + WS_ROPE))
#define P_r_eid ((int*)(ap->ws + WS_ROUT))
#define P_r_gate ((float*)(ap->ws + WS_ROUT) + 2 * MTOT)
#define P_r_rank ((int*)(ap->ws + WS_ROUT) + 4 * MTOT)
#define P_r_dest ((int*)(ap->ws + WS_ROUT) + 6 * MTOT)
#define P_X ((f16*)(ap->ws + WS_X))
#define P_tokrow ((int*)(ap->ws + WS_R1))
constexpr int TOKCAP = 2 * MTOT;
#define P_H ((bf16*)(ap->ws + WS_H))
#define P_R1 ((bf16*)(ap->ws + WS_R1))
#define P_R2 ((bf16*)(ap->ws + WS_R2))
#define P_R3 ((bf16*)(ap->ws + WS_R3))
#define P_WM_IN ((bf16*)(ap->ws + WS_WM))
#define P_WM_O ((bf16*)(ap->ws + WS_WM + 6 * MiB))
#define P_W1 ((bf16*)(ap->ws + WS_W1))
#define P_W2 ((bf16*)(ap->ws + WS_W2))

struct Ctx {
    LAS unsigned char* lds; int tid, lane, wave, G, bid, gw, ngw;
};
__device__ __forceinline__ const float* xin_row(KArgs ap, const Ctx& C, int row) {
    return row < NLAT ? P_x + (size_t)row * D : P_ctx + (size_t)(row - NLAT) * D;
}
__device__ __forceinline__ f32x4 ldx4(KArgs ap, const Ctx& C, int layer, int row, int off) {
    if (layer == 0) return *(const f32x4*)(xin_row(ap, C, row) + off);
    return __builtin_convertvector(*(const h16x4*)(P_X + (size_t)row * D + off), f32x4);
}
__device__ __forceinline__ void stx4(KArgs ap, int row, int off, const f32x4 v, size_t dry = 0) { pst8(dry ? (f16*)(ap->ws + WS_R1) : P_X, ((size_t)row * D + off) * 2, __builtin_bit_cast(v2u, __builtin_convertvector(v, h16x4))); }
__device__ __forceinline__ int row_bidx(int row) { return row < NLAT ? (row >> 11) : 16; }

__device__ __forceinline__ void phase_mod(KArgs ap, Ctx& C) {
    LAS float* sl = (LAS float*)C.lds;
    LAS float* part = (LAS float*)(C.lds + 69632);
    {
        f32x4 cv[9];
#pragma unroll
        for (int j = 0; j < 9; ++j) { const int idx = (j * 512 + C.tid) * 4; const int r = idx >> 10, k = idx & 1023;
            cv[j] = idx < 17 * 1024 ? *(const f32x4*)(r < 16 ? P_c + r * 1024 + k : P_c_ctx + k) : (f32x4){0.f, 0.f, 0.f, 0.f}; }
#pragma unroll
        for (int j = 0; j < 9; ++j) { const int idx = (j * 512 + C.tid) * 4;
            if (idx < 17 * 1024) { f32x4 o;
#pragma unroll
                for (int q = 0; q < 4; ++q) o[q] = cv[j][q] * __builtin_amdgcn_rcpf(1.0f + __builtin_amdgcn_exp2f(-cv[j][q] * LOG2E));
                *(LAS f32x4*)(sl + idx) = o; } }
    }
    __syncthreads();
    for (int unit = C.bid; unit < DEPTH * 48; unit += C.G) {
        const int layer = unit / 48, nb = (unit % 48) * 128;
        const float* W = P_w_ada + (size_t)layer * 1024 * 6144 + nb + 2 * C.lane;
        float a0[17], a1[17];
#pragma unroll
        for (int r = 0; r < 17; ++r) { a0[r] = 0.f; a1[r] = 0.f; }
        const int k0 = C.wave * 128;
#pragma nounroll
        for (int kk = 0; kk < 128; kk += 16) {
            f32x2 w[16];
#pragma unroll
            for (int j = 0; j < 16; ++j) w[j] = *(const f32x2*)(W + (size_t)(k0 + kk + j) * 6144);
#pragma unroll
            for (int r = 0; r < 17; ++r) {
#pragma unroll
                for (int q = 0; q < 4; ++q) { const f32x4 s = *(const LAS f32x4*)(sl + r * 1024 + k0 + kk + 4 * q);
                    a0[r] += s[0] * w[4 * q].x + s[1] * w[4 * q + 1].x + s[2] * w[4 * q + 2].x + s[3] * w[4 * q + 3].x;
                    a1[r] += s[0] * w[4 * q].y + s[1] * w[4 * q + 1].y + s[2] * w[4 * q + 2].y + s[3] * w[4 * q + 3].y; } }
        }
#pragma unroll
        for (int r = 0; r < 17; ++r) *(LAS f32x2*)(part + (C.wave * 17 + r) * 128 + 2 * C.lane) = (f32x2){a0[r], a1[r]};
        __syncthreads();
        for (int idx = C.tid; idx < 17 * 128; idx += 512) { const int r = idx >> 7, cc = idx & 127; float s = P_b_ada[layer * 6144 + nb + cc];
#pragma unroll
            for (int w = 0; w < 8; ++w) s += part[(w * 17 + r) * 128 + cc];
            P_mod[(size_t)(layer * 17 + r) * 6144 + nb + cc] = s; }
        __syncthreads();
    }
    if (C.bid == C.G - 1) for (int idx = C.tid; idx < 1024; idx += 512) { const int pos = idx >> 4, i = idx & 15;
        const float inv = exp2f(-(float)i * (13.287712379549449f / 16.0f)); const float ang = (float)pos * inv;
        P_rope[idx * 2] = cosf(ang); P_rope[idx * 2 + 1] = sinf(ang); }
}

__device__ __forceinline__ void tr_item(const float* W, int N, int k0, int n0, bf16* WT, int Kd, int drow0, LAS float* scr, int lane) {
    float wv[32];
#pragma unroll
    for (int i = 0; i < 32; ++i) { const int kk = 2 * i + (lane >> 5); wv[i] = W[(size_t)(k0 + kk) * N + n0 + (lane & 31)]; }
#pragma unroll
    for (int i = 0; i < 32; ++i) { const int kk = 2 * i + (lane >> 5); scr[kk * 33 + (lane & 31)] = wv[i]; }
    LDS_WAIT(); asm volatile("" ::: "memory");
    const int c = lane & 7;
#pragma unroll
    for (int j = 0; j < 4; ++j) { const int n = (lane >> 3) + 8 * j; const LAS float* s = scr + (8 * c) * 33 + n;
        v4u o; o.x = pk2(s[0 * 33], s[1 * 33]); o.y = pk2(s[2 * 33], s[3 * 33]); o.z = pk2(s[4 * 33], s[5 * 33]); o.w = pk2(s[6 * 33], s[7 * 33]);
        *(v4u*)(WT + (size_t)(drow0 + n) * Kd + k0 + 8 * c) = o; }
    LDS_WAIT(); asm volatile("" ::: "memory");
}
__device__ __forceinline__ int convert_nitems(int layer) { return 3 * 32 * 256 + 16 * ((layer % 3) == 0 ? 48 : 96) + 512; }
__device__ __forceinline__ void convert_item(KArgs ap, Ctx& C, int layer, int it, LAS float* scr) {
    const int kind = layer % 3, j = layer / 3;
    if (it < 3 * 32 * 256) {
        const int which = it >> 13, r = it & 8191, e = r >> 8, q = r & 255;
        if (which < 2) { const float* W = (which ? P_e_wu : P_e_wg) + (size_t)(layer * 32 + e) * 1024 * 512; const int kb = q >> 4, n0 = 32 * (q & 15);
            tr_item(W, 512, 64 * kb, n0, P_W1, 1024, e * 1024 + 256 * (n0 >> 7) + 64 * ((n0 >> 5) & 3) + 32 * which, scr, C.lane); }
        else { const float* W = P_e_wd + (size_t)(layer * 32 + e) * 512 * 1024; const int kb = q >> 5, n0 = 32 * (q & 31);
            tr_item(W, 1024, 64 * kb, n0, P_W2, 512, e * 1024 + n0, scr, C.lane); }
        return;
    }
    it -= 3 * 32 * 256;
    const int nblk = kind == 0 ? 48 : 96;
    if (it < 16 * nblk) {
        const float* W; int N;
        if (kind == 0) { W = P_attn_w_qkv + (size_t)j * 1024 * 1536; N = 1536; }
        else if (kind == 1) { W = P_conv_w_in + (size_t)j * 1024 * 3072; N = 3072; }
        else { W = P_nat_w_qkv + (size_t)j * 1024 * 3072; N = 3072; }
        const int kb = it / nblk, n0 = 32 * (it % nblk); int drow0 = n0;
        if (kind == 1) { if (n0 < 1024) drow0 = 2048 + n0; else if (n0 < 2048) { const int jj = n0 - 1024; drow0 = 256 * (jj >> 7) + 64 * ((jj >> 5) & 3); } else { const int jj = n0 - 2048; drow0 = 256 * (jj >> 7) + 64 * ((jj >> 5) & 3) + 32; } }
        tr_item(W, N, 64 * kb, n0, P_WM_IN, 1024, drow0, scr, C.lane);
        return;
    }
    it -= 16 * nblk;
    const float* W = (kind == 0 ? P_attn_w_o : kind == 1 ? P_conv_w_out : P_nat_w_o) + (size_t)j * 1024 * 1024;
    const int kb = it >> 5, n0 = 32 * (it & 31); tr_item(W, 1024, 64 * kb, n0, P_WM_O, 1024, n0, scr, C.lane);
}
struct CvItem { const float* src; bf16* dst; int N, Kd; };
__device__ __forceinline__ CvItem convert_addr(KArgs ap, int layer, int it) {
    const int kind = layer % 3, j = layer / 3; CvItem r;
    if (it < 3 * 32 * 256) {
        const int which = it >> 13, rr = it & 8191, e = rr >> 8, q = rr & 255;
        if (which < 2) { const float* W = (which ? P_e_wu : P_e_wg) + (size_t)(layer * 32 + e) * 1024 * 512; const int kb = q >> 4, n0 = 32 * (q & 15);
            r.src = W + (size_t)(64 * kb) * 512 + n0; r.N = 512; r.dst = P_W1 + (size_t)(e * 1024 + 256 * (n0 >> 7) + 64 * ((n0 >> 5) & 3) + 32 * which) * 1024 + 64 * kb; r.Kd = 1024; }
        else { const float* W = P_e_wd + (size_t)(layer * 32 + e) * 512 * 1024; const int kb = q >> 5, n0 = 32 * (q & 31);
            r.src = W + (size_t)(64 * kb) * 1024 + n0; r.N = 1024; r.dst = P_W2 + (size_t)(e * 1024 + n0) * 512 + 64 * kb; r.Kd = 512; }
        return r;
    }
    it -= 3 * 32 * 256;
    const int nblk = kind == 0 ? 48 : 96;
    if (it < 16 * nblk) {
        const float* W; int N;
        if (kind == 0) { W = P_attn_w_qkv + (size_t)j * 1024 * 1536; N = 1536; }
        else if (kind == 1) { W = P_conv_w_in + (size_t)j * 1024 * 3072; N = 3072; }
        else { W = P_nat_w_qkv + (size_t)j * 1024 * 3072; N = 3072; }
        const int kb = it / nblk, n0 = 32 * (it % nblk); int drow0 = n0;
        if (kind == 1) { if (n0 < 1024) drow0 = 2048 + n0; else if (n0 < 2048) { const int jj = n0 - 1024; drow0 = 256 * (jj >> 7) + 64 * ((jj >> 5) & 3); } else { const int jj = n0 - 2048; drow0 = 256 * (jj >> 7) + 64 * ((jj >> 5) & 3) + 32; } }
        r.src = W + (size_t)(64 * kb) * N + n0; r.N = N; r.dst = P_WM_IN + (size_t)drow0 * 1024 + 64 * kb; r.Kd = 1024;
        return r;
    }
    it -= 16 * nblk;
    const float* W = (kind == 0 ? P_attn_w_o : kind == 1 ? P_conv_w_out : P_nat_w_o) + (size_t)j * 1024 * 1024;
    const int kb = it >> 5, n0 = 32 * (it & 31);
    r.src = W + (size_t)(64 * kb) * 1024 + n0; r.N = 1024; r.dst = P_WM_O + (size_t)n0 * 1024 + 64 * kb; r.Kd = 1024;
    return r;
}
__device__ __forceinline__ void tr_load(const CvItem& I, f32x4 (&wv)[8], int lane) {
    const float* p = I.src + (size_t)(lane >> 3) * I.N + 4 * (lane & 7);
#pragma unroll
    for (int i = 0; i < 8; ++i) wv[i] = __builtin_nontemporal_load((const f32x4*)(p + (size_t)(8 * i) * I.N));
}
__device__ __forceinline__ void tr_store(const CvItem& I, const f32x4 (&wv)[8], LAS float* scr, int lane) {
    LAS float* wp = scr + (lane >> 3) * 33 + 4 * (lane & 7);
#pragma unroll
    for (int i = 0; i < 8; ++i) { wp[(8 * i) * 33] = wv[i][0]; wp[(8 * i) * 33 + 1] = wv[i][1]; wp[(8 * i) * 33 + 2] = wv[i][2]; wp[(8 * i) * 33 + 3] = wv[i][3]; }
    LDS_WAIT(); asm volatile("" ::: "memory");
    const int c = lane & 7;
#pragma unroll
    for (int j = 0; j < 4; ++j) { const int n = (lane >> 3) + 8 * j; const LAS float* s = scr + (8 * c) * 33 + n;
        v4u o; o.x = pk2(s[0 * 33], s[1 * 33]); o.y = pk2(s[2 * 33], s[3 * 33]); o.z = pk2(s[4 * 33], s[5 * 33]); o.w = pk2(s[6 * 33], s[7 * 33]);
        pst16_nt(I.dst, ((size_t)n * I.Kd + 8 * c) * 2, o); }
    LDS_WAIT(); asm volatile("" ::: "memory");
}
__device__ __forceinline__ void convert_seq(KArgs ap, Ctx& C, int layer, int first, int stride, int hi) {
    LAS float* scr = (LAS float*)(C.lds + C.wave * 16384);
    if (first >= hi) return;
    f32x4 w0[8], w1[8], w2[8], w3[8]; CvItem i0, i1, i2, i3;
    int it = first;
    i0 = convert_addr(ap, layer, it); tr_load(i0, w0, C.lane);
    if (it + stride < hi) { i1 = convert_addr(ap, layer, it + stride); tr_load(i1, w1, C.lane); }
    if (it + 2 * stride < hi) { i2 = convert_addr(ap, layer, it + 2 * stride); tr_load(i2, w2, C.lane); }
#pragma unroll 1
    for (;;) {
        if (it + 3 * stride < hi) { i3 = convert_addr(ap, layer, it + 3 * stride); tr_load(i3, w3, C.lane); }
        tr_store(i0, w0, scr, C.lane);
        if (it + 4 * stride < hi) { i0 = convert_addr(ap, layer, it + 4 * stride); tr_load(i0, w0, C.lane); }
        if (it + stride >= hi) break;
        tr_store(i1, w1, scr, C.lane);
        if (it + 5 * stride < hi) { i1 = convert_addr(ap, layer, it + 5 * stride); tr_load(i1, w1, C.lane); }
        if (it + 2 * stride >= hi) break;
        tr_store(i2, w2, scr, C.lane);
        if (it + 6 * stride < hi) { i2 = convert_addr(ap, layer, it + 6 * stride); tr_load(i2, w2, C.lane); }
        if (it + 3 * stride >= hi) break;
        tr_store(i3, w3, scr, C.lane);
        it += 4 * stride;
        if (it >= hi) break;
    }
}
__device__ __forceinline__ void convert_pull(KArgs ap, Ctx& C, int layer, const unsigned* done) {
    LAS float* scr = (LAS float*)(C.lds + C.wave * 16384); volatile LAS int* slot = (volatile LAS int*)(C.lds + LDS_MISC + 64);
    const int nit = convert_nitems(layer); unsigned* qh = P_ctl + CW_Q + 64 * layer;
    for (;;) {
        if (C.tid == 0) { int base = -1;
            if (!(done && __hip_atomic_load(done, __ATOMIC_RELAXED, __HIP_MEMORY_SCOPE_AGENT) >= (unsigned)C.G)) { const unsigned b = __hip_atomic_fetch_add(qh, 16u, __ATOMIC_RELAXED, __HIP_MEMORY_SCOPE_AGENT); if (b < (unsigned)nit) base = (int)b; }
            slot[0] = base; }
        __syncthreads();
        const int base = __builtin_amdgcn_readfirstlane(slot[0]);
        if (base < 0) break;
#pragma unroll 1
        for (int k = 0; k < 2; ++k) { const int it = base + 8 * k + C.wave; if (it < nit) convert_item(ap, C, layer, it, scr); }
        __syncthreads();
    }
}
#ifndef FA0
#define FA0 10240
#endif
#ifndef FA12
#define FA12 0
#endif
#ifndef FA3
#define FA3 20480
#endif
#ifndef FB0
#define FB0 14336
#endif
#ifndef FB12
#define FB12 24576
#endif
__device__ __forceinline__ int fill_a(int layer) { return layer == 0 ? FA0 : layer == 3 ? FA3 : FA12; }
__device__ __forceinline__ int fill_b(int layer) { return layer == 0 ? FB0 : layer == DEPTH - 1 ? 0 : FB12; }
__device__ __forceinline__ void convert_rest(KArgs ap, Ctx& C, int layer) {
    convert_seq(ap, C, layer, fill_a(layer) + fill_b(layer) + C.gw, C.ngw, convert_nitems(layer));
}
__device__ __forceinline__ void convert_fill(KArgs ap, Ctx& C, int layer, int lo, int hi, int l0, int nl, int tl) {
    convert_seq(ap, C, layer, lo + l0 * 8 + C.wave, tl * 8, hi);
}
__device__ __forceinline__ void tail_convert(KArgs ap, Ctx& C, int layer_next, int phase) {
    unsigned* done = P_ctl + CW_DONE + 64 * phase;
    __syncthreads();
    if (C.tid == 0) __hip_atomic_fetch_add(done, 1u, __ATOMIC_RELAXED, __HIP_MEMORY_SCOPE_AGENT);
    convert_pull(ap, C, layer_next, done);
}
__device__ __forceinline__ void phase_hprep(KArgs ap, Ctx& C) {
    for (int row = C.gw; row < MTOT; row += C.ngw) {
        const float* xr = xin_row(ap, C, row); const float* md = P_mod + (size_t)row_bidx(row) * 6144;
#pragma unroll
        for (int i = 0; i < 4; ++i) { const int off = 4 * C.lane + 256 * i; const f32x4 x = *(const f32x4*)(xr + off), sh = *(const f32x4*)(md + off), sc = *(const f32x4*)(md + 1024 + off);
            const f32x4 h = x * (1.0f + sc) + sh; v2u w; w.x = pk2(h[0], h[1]); w.y = pk2(h[2], h[3]); pst8(P_H, ((size_t)row * D + off) * 2, w); }
    }
}

__device__ __forceinline__ int crow(int r, int hi) { return (r & 3) + 8 * (r >> 2) + 4 * hi; }
__device__ __forceinline__ int clampi(int v, int lo, int hi) { return v < lo ? lo : (v > hi ? hi : v); }
#define MFMA32(a, b, c) __builtin_amdgcn_mfma_f32_32x32x16_bf16(a, b, c, 0, 0, 0)
struct TileArg { int a, kr, r_q, c_q, rs_q, qs_q; };
__device__ __forceinline__ int kidx(int reg, int hi) { return (reg & 3) + 4 * ((reg >> 2) & 1) + 8 * hi + 16 * (reg >> 3); }
template <int MODE, int FIX = 0>
__device__ __forceinline__ void attn_tile(f32x16& o0, f32x16& o1, float& m, float& l, const LAS unsigned char* ck, int koff, const bf16x8 (&qf)[4], int r32, int hi, const TileArg& T, const LAS float* bias, const float (&cmm)[16]) {
    const int row = koff + ((r32 & 3) | ((r32 & 4) << 1) | ((r32 & 8) >> 1) | (r32 & 16)); const LAS unsigned char* kp = ck + row * 128; const int sw = (row >> 1) & 7;
    const bf16x8 kf0 = *(const LAS bf16x8*)(kp + (((0 + hi) ^ sw) << 4)), kf1 = *(const LAS bf16x8*)(kp + (((2 + hi) ^ sw) << 4));
    const bf16x8 kf2 = *(const LAS bf16x8*)(kp + (((4 + hi) ^ sw) << 4)), kf3 = *(const LAS bf16x8*)(kp + (((6 + hi) ^ sw) << 4));
    const int c0 = (koff >> 3) + hi;
    const LAS unsigned char* vp0 = ck + 8192 + r32 * 128; const int sw0 = (r32 >> 1) & 7;
    const LAS unsigned char* vp1 = ck + 8192 + (32 + r32) * 128; const int sw1 = ((32 + r32) >> 1) & 7;
    const bf16x8 vf0 = *(const LAS bf16x8*)(vp0 + (((c0) ^ sw0) << 4)), vf1 = *(const LAS bf16x8*)(vp0 + (((c0 + 2) ^ sw0) << 4));
    const bf16x8 vf2 = *(const LAS bf16x8*)(vp1 + (((c0) ^ sw1) << 4)), vf3 = *(const LAS bf16x8*)(vp1 + (((c0 + 2) ^ sw1) << 4));
    __builtin_amdgcn_sched_barrier(0);
    f32x16 p;
#pragma unroll
    for (int r = 0; r < 16; ++r) p[r] = 0.f;
    p = MFMA32(kf0, qf[0], p); p = MFMA32(kf1, qf[1], p); p = MFMA32(kf2, qf[2], p); p = MFMA32(kf3, qf[3], p);
    if constexpr (MODE == 1) {
#pragma unroll
        for (int r = 0; r < 16; ++r) { const int d = T.a + kidx(r, hi); if (d > 128 || d < -128) p[r] = NEGBIG; }
    }
    if constexpr (MODE == 2) {
        const bool rowok = (T.kr >= T.rs_q) && (T.kr < T.rs_q + 8); const int drow = rowok ? T.kr - T.r_q + 7 : 15;
        const LAS float* bp = bias + 16 + drow * 31 + T.a;
#pragma unroll
        for (int r = 0; r < 16; ++r) p[r] = (p[r] + bp[(r & 3) + 4 * ((r >> 2) & 1) + 16 * (r >> 3)]) + cmm[r];
    }
    if constexpr (FIX == 0) {
        float tm = p[0];
#pragma unroll
        for (int r = 1; r < 16; ++r) tm = fmaxf(tm, p[r]);
        tm = xor32_max(tm);
        const float mn = fmaxf(m, tm), alpha = __builtin_amdgcn_exp2f(m - mn);
        float rs = 0.f;
#pragma unroll
        for (int r = 0; r < 16; ++r) { p[r] = __builtin_amdgcn_exp2f(p[r] - mn); rs += p[r]; }
        l = l * alpha + rs; m = mn;
#pragma unroll
        for (int r = 0; r < 16; ++r) { o0[r] *= alpha; o1[r] *= alpha; }
    } else {
        if constexpr (FIX == 1) {
            float tm = p[0];
#pragma unroll
            for (int r = 1; r < 16; ++r) tm = fmaxf(tm, p[r]);
            tm = xor32_max(tm);
            const float mn = fmaxf(m, tm); l *= __builtin_amdgcn_exp2f(m - mn); m = mn;
        }
        float rs = 0.f;
#pragma unroll
        for (int r = 0; r < 16; ++r) { p[r] = __builtin_amdgcn_exp2f(MODE == 2 ? p[r] : p[r] - m); rs += p[r]; }
        l += rs;
    }
    v4u w0, w1;
    w0.x = pk2c(p[0], p[1]); w0.y = pk2c(p[2], p[3]); w0.z = pk2c(p[4], p[5]); w0.w = pk2c(p[6], p[7]);
    w1.x = pk2c(p[8], p[9]); w1.y = pk2c(p[10], p[11]); w1.z = pk2c(p[12], p[13]); w1.w = pk2c(p[14], p[15]);
    const bf16x8 pb0 = __builtin_bit_cast(bf16x8, w0), pb1 = __builtin_bit_cast(bf16x8, w1);
    o0 = MFMA32(vf0, pb0, o0); o1 = MFMA32(vf2, pb0, o1);
    o0 = MFMA32(vf1, pb1, o0); o1 = MFMA32(vf3, pb1, o1);
}
__device__ __forceinline__ void attn_store(bf16* O, size_t rowq0, int hi16, int head, const f32x16& o0, const f32x16& o1, float l, int r32, int hi, LAS unsigned char* ost, int lane) {
    l = xor32_sum(l); const float inv = __builtin_amdgcn_rcpf(l);
    LAS unsigned char* wr_ = ost + r32 * 128;
#pragma unroll
    for (int g = 0; g < 4; ++g) { v2u w; w.x = pk2(o0[4 * g] * inv, o0[4 * g + 1] * inv); w.y = pk2(o0[4 * g + 2] * inv, o0[4 * g + 3] * inv);
        *(LAS v2u*)(wr_ + (((g) ^ (r32 & 7)) << 4) + 8 * hi) = w; }
#pragma unroll
    for (int g = 0; g < 4; ++g) { v2u w; w.x = pk2(o1[4 * g] * inv, o1[4 * g + 1] * inv); w.y = pk2(o1[4 * g + 2] * inv, o1[4 * g + 3] * inv);
        *(LAS v2u*)(wr_ + (((4 + g) ^ (r32 & 7)) << 4) + 8 * hi) = w; }
#pragma unroll
    for (int k = 0; k < 4; ++k) { const int row = 8 * k + (lane >> 3), pc = lane & 7;
        const v4u v = *(const LAS v4u*)(ost + row * 128 + ((pc ^ (row & 7)) << 4));
        gst16(O, ((rowq0 + (size_t)((row & 15) + (row >> 4) * hi16)) * D + head * 64 + 8 * pc) * 2, v); }
}
template <int KIND>
__device__ __forceinline__ size_t attn_rowq(int b, int part, int qi, int wave, int r32) {
    constexpr int NLATQ = KIND == 0 ? 8 : 4;
    if (KIND == 0) { if (qi < NLATQ) return (size_t)b * SEQ + 32 * (2 * (8 * part + qi) + (wave >> 2)) + r32; return (size_t)NLAT + b * CTXL + 64 * part + 32 * (wave >> 2) + r32; }
    if (qi < NLATQ) { const int r0 = 4 * (4 * part + qi) + 2 * (wave >> 2); return (size_t)b * SEQ + (r0 + (r32 >> 4)) * 64 + 16 * (wave & 3) + (r32 & 15); }
    return (size_t)NLAT + b * CTXL + 128 * part + 32 * (wave & 3) + r32;
}
constexpr int ATT_CTX_OFF = 0, ATT_BUF_OFF = 65536, ATT_OST_OFF = 100352, ATT_RPB_OFF = 133120;
template <int KIND>
__device__ __forceinline__ void phase_attn(KArgs ap, Ctx& C, int j, bool last) {
    const bf16* Q = P_R1; const bf16* Kb = P_R1 + (size_t)MTOT * D; const bf16* VTb = P_R1 + (size_t)2 * MTOT * D; bf16* O = P_R2;
    constexpr int NH = KIND == 0 ? 4 : 16, NLATQ = KIND == 0 ? 8 : 4, NUNITS = KIND == 0 ? 256 : 512;
    const int r32 = C.lane & 31, hi = C.lane >> 5, t = C.tid;
    const LAS unsigned char* ctxc = C.lds + ATT_CTX_OFF; LAS unsigned char* sbuf = C.lds + ATT_BUF_OFF; LAS float* rpb = (LAS float*)(C.lds + ATT_RPB_OFF);
    const int pr = t >> 3, pc = t & 7;
    const int kdst = pr * 128 + ((pc ^ ((pr >> 1) & 7)) << 4), vdst = 8192 + pr * 128 + ((pc ^ ((pr >> 1) & 7)) << 4);
    int par = 0;
    for (int unit = C.bid; unit < NUNITS; unit += C.G) {
        int b, h, part; if (KIND == 0) { b = unit >> 4; h = (unit >> 2) & 3; part = unit & 3; } else { b = unit >> 5; h = (unit >> 1) & 15; part = unit & 1; }
        const bf16* Kh = Kb + (size_t)(b * NH + h) * KVTOK * 64; const bf16* Vh = VTb + (size_t)(b * NH + h) * 64 * KVTOK;
        const bf16* kg = Kh + t * 8; const bf16* vg = Vh + (size_t)pr * KVTOK + pc * 8;
        __syncthreads();
#pragma unroll
        for (int cc = 0; cc < 4; ++cc) { const int tok0 = SEQ + 64 * cc; const v4u kv = *(const v4u*)(kg + (size_t)tok0 * 64), vv = *(const v4u*)(vg + tok0);
            *(LAS v4u*)(C.lds + ATT_CTX_OFF + cc * 16384 + kdst) = kv; *(LAS v4u*)(C.lds + ATT_CTX_OFF + cc * 16384 + vdst) = vv; }
        if (KIND == 2) {
            for (int e = t; e < 544; e += 512) rpb[e] = e < 16 ? 0.0f : (e < 16 + 465 ? P_nat_rpb[(size_t)(j * 16 + h) * 465 + (e - 16)] * LOG2E : NEGBIG); }
        __syncthreads();
        const int nqi = last ? NLATQ : NLATQ + 1;
        int qlo0, qhi0; if (KIND == 0) { const int qb = 8 * part; qlo0 = qb - 2 < 0 ? 0 : qb - 2; qhi0 = qb + 2 > 31 ? 31 : qb + 2; } else { const int quad = 4 * part; qlo0 = clampi(4 * quad - 4, 0, 24); qhi0 = clampi(4 * quad - 1, 0, 24) + 7; }
        v4u pk = *(const v4u*)(kg + (size_t)(64 * qlo0) * 64), pv = *(const v4u*)(vg + 64 * qlo0);
        const int headq = KIND == 0 ? 4 * h + (C.wave & 3) : h;
        bf16x8 qn[4];
        {   const size_t rq = attn_rowq<KIND>(b, part, 0, C.wave, r32);
#pragma unroll
            for (int s = 0; s < 4; ++s) qn[s] = *(const bf16x8*)(Q + rq * D + headq * 64 + 16 * s + 8 * hi); }
        for (int qi = 0; qi < nqi; ++qi) {
            const bool isctx = qi == NLATQ;
            int head, clo = 0, chi = -1; size_t rowq; bool active = true; TileArg T; T.a = 0; T.kr = 0; T.r_q = 0; T.c_q = 0; T.rs_q = 0; T.qs_q = 0;
            int qt = 0, wlo = 0, whi = -1, kc0 = 0;
            if (KIND == 0) {
                head = 4 * h + (C.wave & 3);
                if (!isctx) { const int qb = 8 * part + qi; clo = qb - 2 < 0 ? 0 : qb - 2; chi = qb + 2 > 31 ? 31 : qb + 2; qt = 2 * qb + (C.wave >> 2); rowq = (size_t)b * SEQ + 32 * qt + r32; }
                else rowq = (size_t)NLAT + b * CTXL + 64 * part + 32 * (C.wave >> 2) + r32;
            } else {
                head = h;
                if (!isctx) { const int quad = 4 * part + qi; clo = clampi(4 * quad - 4, 0, 24); chi = clampi(4 * quad - 1, 0, 24) + 7;
                    const int r0 = 4 * quad + 2 * (C.wave >> 2), cb = C.wave & 3; T.r_q = r0 + (r32 >> 4); T.c_q = 16 * cb + (r32 & 15); rowq = (size_t)b * SEQ + T.r_q * 64 + T.c_q;
                    T.rs_q = clampi(T.r_q - 4, 0, 24); T.qs_q = clampi(T.c_q - 8, 0, 48); wlo = clampi(r0 - 4, 0, 24); whi = clampi(r0 - 3, 0, 24) + 7; kc0 = clampi(16 * cb - 8, 0, 32); T.a = kc0 + 8 * hi - T.c_q + 15; }
                else { active = C.wave < 4; rowq = (size_t)NLAT + b * CTXL + 128 * part + 32 * (C.wave & 3) + r32; }
            }
            bf16x8 qf[4];
#pragma unroll
            for (int s = 0; s < 4; ++s) qf[s] = qn[s];
            if (qi + 1 < nqi) { const size_t rq = attn_rowq<KIND>(b, part, qi + 1, C.wave, r32);
#pragma unroll
                for (int s = 0; s < 4; ++s) qn[s] = *(const bf16x8*)(Q + rq * D + headq * 64 + 16 * s + 8 * hi); }
            f32x16 o0, o1; float cmm[16];
#pragma unroll
            for (int r = 0; r < 16; ++r) { o0[r] = 0.f; o1[r] = 0.f; cmm[r] = 0.f; }
            float m, l; if (KIND == 0) { m = P_attn_sink[j * 16 + head] * LOG2E; l = hi == 0 ? 1.0f : 0.0f; } else { m = NEGBIG; l = 0.0f; }
            if (active) {
                if (true) {
                    attn_tile<0, 1>(o0, o1, m, l, ctxc, 0, qf, r32, hi, T, rpb, cmm);
#pragma unroll 2
                    for (int jt = 1; jt < 8; ++jt) attn_tile<0, 2>(o0, o1, m, l, ctxc + (jt >> 1) * 16384, 32 * (jt & 1), qf, r32, hi, T, rpb, cmm);
                } else {
#pragma unroll 1
                    for (int jt = 0; jt < 8; ++jt) attn_tile<0>(o0, o1, m, l, ctxc + (jt >> 1) * 16384, 32 * (jt & 1), qf, r32, hi, T, rpb, cmm);
                }
            }
            if (KIND == 2 && !isctx) {
#pragma unroll
                for (int r = 0; r < 16; ++r) { const int kc = kc0 + kidx(r, hi); cmm[r] = ((kc >= T.qs_q && kc < T.qs_q + 16) ? 0.0f : NEGBIG) - m; }
            }
#pragma unroll 1
            for (int ch = clo; ch <= chi; ++ch) {
                LAS unsigned char* buf = sbuf + par * 16384;
                *(LAS v4u*)(buf + kdst) = pk; *(LAS v4u*)(buf + vdst) = pv;
                __syncthreads();
                {
                    int nch = ch + 1; bool ok = true;
                    if (nch > chi) { const int nq = qi + 1; if (nq < NLATQ) { if (KIND == 0) { const int qb = 8 * part + nq; nch = qb - 2 < 0 ? 0 : qb - 2; } else { const int quad = 4 * part + nq; nch = clampi(4 * quad - 4, 0, 24); } } else ok = false; }
                    if (ok) { pk = *(const v4u*)(kg + (size_t)(64 * nch) * 64); pv = *(const v4u*)(vg + 64 * nch); }
                }
                if (KIND == 0) {
#pragma unroll
                    for (int tau = 0; tau < 2; ++tau) { const int kt = 2 * ch + tau; if (kt >= qt - 4 && kt <= qt + 4) { T.a = 32 * kt - (32 * qt + r32); if (kt == qt - 4 || kt == qt + 4) attn_tile<1, 2>(o0, o1, m, l, buf, 32 * tau, qf, r32, hi, T, rpb, cmm); else attn_tile<0, 2>(o0, o1, m, l, buf, 32 * tau, qf, r32, hi, T, rpb, cmm); } }
                } else {
                    if (ch >= wlo && ch <= whi) { T.kr = ch; attn_tile<2, 2>(o0, o1, m, l, buf, kc0, qf, r32, hi, T, rpb, cmm); }
                }
                par ^= 1;
            }
            if (active) attn_store(O, rowq - (size_t)((r32 & 15) + (r32 >> 4) * ((KIND == 2 && !isctx) ? 64 : 16)), (KIND == 2 && !isctx) ? 64 : 16, head, o0, o1, l, r32, hi, C.lds + ATT_OST_OFF + C.wave * 4096, C.lane);
        }
    }
}
__device__ __forceinline__ void phase_conv(KArgs ap, Ctx& C, int j, bool last) {
    const bf16* Vc = P_R1; const bf16* GB = P_R1 + (size_t)MTOT * D; bf16* Z = P_R2; const float* cw = P_conv_w + (size_t)j * 3 * D;
    const int nrows = last ? NLAT : MTOT;
    const int rpw = nrows / C.ngw, r0 = C.gw * rpw;
    float w0[2][8], w1[2][8], w2[2][8];
#pragma unroll
    for (int i = 0; i < 2; ++i)
#pragma unroll
        for (int q = 0; q < 8; ++q) { const int c = 8 * C.lane + 512 * i + q; w0[i][q] = cw[c]; w1[i][q] = cw[D + c]; w2[i][q] = cw[2 * D + c]; }
    v4u va[2], vb[2], vc[2], g[2], vn[2], gn[2];
#pragma unroll
    for (int i = 0; i < 2; ++i) { const size_t o = (size_t)r0 * D + 8 * C.lane + 512 * i;
        va[i] = *(const v4u*)(Vc + (r0 > 0 ? o - D : o)); vb[i] = *(const v4u*)(Vc + o); vc[i] = *(const v4u*)(Vc + o + D); g[i] = *(const v4u*)(GB + o); }
#pragma unroll 1
    for (int k = 0; k < rpw; ++k) {
        const int row = r0 + k;
        if (k + 1 < rpw) {
#pragma unroll
            for (int i = 0; i < 2; ++i) { const size_t o = (size_t)(row + 1) * D + 8 * C.lane + 512 * i; vn[i] = *(const v4u*)(Vc + o + D); gn[i] = *(const v4u*)(GB + o); } }
        int pos, len; if (row < NLAT) { pos = row & 2047; len = SEQ; } else { pos = (row - NLAT) & 255; len = CTXL; }
        const bool hasm = pos > 0, hasp = pos < len - 1;
#pragma unroll
        for (int i = 0; i < 2; ++i) {
            v4u r;
#pragma unroll
            for (int q = 0; q < 4; ++q) {
                const unsigned am = hasm ? va[i][q] : 0u, cp = hasp ? vc[i][q] : 0u;
                const float lo = bflo(g[i][q]) * (w0[i][2 * q] * bflo(am) + w1[i][2 * q] * bflo(vb[i][q]) + w2[i][2 * q] * bflo(cp));
                const float hh = bfhi(g[i][q]) * (w0[i][2 * q + 1] * bfhi(am) + w1[i][2 * q + 1] * bfhi(vb[i][q]) + w2[i][2 * q + 1] * bfhi(cp));
                r[q] = pk2(lo, hh); }
            gst16(Z, ((size_t)row * D + 8 * C.lane + 512 * i) * 2, r);
            va[i] = vb[i]; vb[i] = vc[i]; vc[i] = vn[i]; g[i] = gn[i]; }
    }
}

__device__ __forceinline__ void wave_sum2(float& a, float& b) { a = wave_sum(a); b = wave_sum(b); }
__device__ __forceinline__ void phase_ln1(KArgs ap, Ctx& C, int layer, bool last, int dry = 0) {
    LAS float* WrT = (LAS float*)C.lds;
    LAS int* hist = (LAS int*)(C.lds + 147456);
    LAS int* gbase = hist + 32;
    LAS int* le = gbase + 32;
    LAS int* lr = le + 288;
    const float* wg = P_r_wg + (size_t)layer * 1024 * 4; const float* we = P_r_we + (size_t)layer * 1024 * 32;
    {
        f32x4 gq[2], eq[16];
#pragma unroll
        for (int j = 0; j < 2; ++j) gq[j] = *(const f32x4*)(wg + 4 * (j * 512 + C.tid));
#pragma unroll
        for (int j = 0; j < 16; ++j) eq[j] = *(const f32x4*)(we + 4 * (j * 512 + C.tid));
#pragma unroll
        for (int j = 0; j < 2; ++j) { const int k = j * 512 + C.tid;
#pragma unroll
            for (int q = 0; q < 4; ++q) WrT[q * 1024 + ((k + 4 * q) & 1023)] = gq[j][q]; }
#pragma unroll
        for (int j = 0; j < 16; ++j) { const int f = j * 512 + C.tid, k = f >> 3;
#pragma unroll
            for (int q = 0; q < 4; ++q) { const int o = 4 + 4 * (f & 7) + q; WrT[o * 1024 + ((k + 4 * o) & 1023)] = eq[j][q]; } }
    }
    if (C.tid < 32) hist[C.tid] = 0;
    __syncthreads();
    const int nrows = last ? NLAT : MTOT, rpb = nrows / C.G, rpw = rpb >> 3, row0 = C.bid * rpb;
    const bf16* Y = P_R3;
    f32x4 g1[4], b1[4];
#pragma unroll
    for (int i = 0; i < 4; ++i) { const int off = 4 * C.lane + 256 * i; g1[i] = *(const f32x4*)(P_ln1_g + layer * D + off); b1[i] = *(const f32x4*)(P_ln1_b + layer * D + off); }
    int curb = -1; f32x4 gt[4], sh[4], sc[4];
#pragma unroll
    for (int i = 0; i < 4; ++i) { gt[i] = (f32x4){0.f, 0.f, 0.f, 0.f}; sh[i] = gt[i]; sc[i] = gt[i]; }
    const int lbeg = C.wave * rpw, lend = lbeg + rpw;
    h16x4 pxh[2][4]; v2u pyv[2][4];
    if (layer != 0) {
#pragma unroll
        for (int rr = 0; rr < 2; ++rr) { const int row = row0 + lbeg + rr;
#pragma unroll
            for (int i = 0; i < 4; ++i) { const int off = 4 * C.lane + 256 * i; pxh[rr][i] = *(const h16x4*)(P_X + (size_t)row * D + off); pyv[rr][i] = *(const v2u*)(Y + (size_t)row * D + off); } }
    }
#pragma unroll 1
    for (int l0 = lbeg; l0 < lend; l0 += 2) {
        f32x4 xv[2][4]; v2u yv[2][4];
        if (layer == 0) {
#pragma unroll
            for (int rr = 0; rr < 2; ++rr) { const int row = row0 + l0 + rr; const float* xr = xin_row(ap, C, row); const bf16* yr = Y + (size_t)row * D;
#pragma unroll
                for (int i = 0; i < 4; ++i) { const int off = 4 * C.lane + 256 * i; xv[rr][i] = *(const f32x4*)(xr + off); yv[rr][i] = *(const v2u*)(yr + off); } }
        } else {
#pragma unroll
            for (int rr = 0; rr < 2; ++rr)
#pragma unroll
                for (int i = 0; i < 4; ++i) { xv[rr][i] = __builtin_convertvector(pxh[rr][i], f32x4); yv[rr][i] = pyv[rr][i]; }
            if (l0 + 2 < lend) {
#pragma unroll
                for (int rr = 0; rr < 2; ++rr) { const int row = row0 + l0 + 2 + rr;
#pragma unroll
                    for (int i = 0; i < 4; ++i) { const int off = 4 * C.lane + 256 * i; pxh[rr][i] = *(const h16x4*)(P_X + (size_t)row * D + off); pyv[rr][i] = *(const v2u*)(Y + (size_t)row * D + off); } }
            }
        }
        float hv[2][16];
#pragma unroll
        for (int rr = 0; rr < 2; ++rr) {
            const int row = row0 + l0 + rr; const int bi = row_bidx(row);
            if (bi != curb) { curb = bi; const float* md = P_mod + (size_t)(layer * 17 + bi) * 6144;
#pragma unroll
                for (int i = 0; i < 4; ++i) { const int off = 4 * C.lane + 256 * i; gt[i] = *(const f32x4*)(md + 2 * 1024 + off); sh[i] = *(const f32x4*)(md + 3 * 1024 + off); sc[i] = *(const f32x4*)(md + 4 * 1024 + off); } }
            f32x4 v[4]; float s = 0.f;
#pragma unroll
            for (int i = 0; i < 4; ++i) { v[i] = xv[rr][i] * ALPHA + gt[i] * bf4(yv[rr][i]); s += (v[i][0] + v[i][1]) + (v[i][2] + v[i][3]); }
            const float mean = wave_sum(s) * (1.0f / D); float s2 = 0.f;
#pragma unroll
            for (int i = 0; i < 4; ++i) { v[i] = v[i] - mean; s2 += (v[i][0] * v[i][0] + v[i][1] * v[i][1]) + (v[i][2] * v[i][2] + v[i][3] * v[i][3]); }
            const float rstd = __builtin_amdgcn_rsqf(wave_sum(s2) * (1.0f / D) + LN_EPS);
#pragma unroll
            for (int i = 0; i < 4; ++i) { const int off = 4 * C.lane + 256 * i;
                const f32x4 xn = v[i] * rstd * g1[i] + b1[i]; stx4(ap, row, off, xn, dry);
                const f32x4 h = xn * (1.0f + sc[i]) + sh[i];
                hv[rr][4 * i] = h[0]; hv[rr][4 * i + 1] = h[1]; hv[rr][4 * i + 2] = h[2]; hv[rr][4 * i + 3] = h[3];
                v2u w; w.x = pk2(h[0], h[1]); w.y = pk2(h[2], h[3]); pst8(dry ? (bf16*)(ap->ws + WS_R1 + 80 * MiB) : P_H, ((size_t)row * D + off) * 2, w); }
        }
        float glg[2][4];
#pragma unroll
        for (int o = 0; o < 4; ++o) { float a0 = 0.f, a1 = 0.f;
#pragma unroll
            for (int i = 0; i < 4; ++i) { const f32x4 w = *(const LAS f32x4*)(WrT + o * 1024 + ((4 * C.lane + 256 * i + 4 * o) & 1023));
                a0 += w[0] * hv[0][4 * i] + w[1] * hv[0][4 * i + 1] + w[2] * hv[0][4 * i + 2] + w[3] * hv[0][4 * i + 3];
                a1 += w[0] * hv[1][4 * i] + w[1] * hv[1][4 * i + 1] + w[2] * hv[1][4 * i + 2] + w[3] * hv[1][4 * i + 3]; }
            wave_sum2(a0, a1); glg[0][o] = a0; glg[1][o] = a1; }
#pragma unroll
        for (int rr = 0; rr < 2; ++rr) {
            const int row = row0 + l0 + rr;
            float gl[4];
#pragma unroll
            for (int g = 0; g < 4; ++g) gl[g] = glg[rr][g] + P_r_bg[layer * 4 + g];
            int gi = 0; float gm = gl[0];
#pragma unroll
            for (int g = 1; g < 4; ++g) if (gl[g] > gm) { gm = gl[g]; gi = g; }
            gi = __builtin_amdgcn_readfirstlane(gi);
            float gsum = 0.f;
#pragma unroll
            for (int g = 0; g < 4; ++g) gsum += __builtin_amdgcn_exp2f((gl[g] - gm) * LOG2E);
            const float gprob = __builtin_amdgcn_rcpf(gsum);
            float el[8];
#pragma unroll
            for (int q = 0; q < 8; q += 2) { float a = 0.f, c = 0.f; const int o = 4 + gi * 8 + q;
#pragma unroll
                for (int i = 0; i < 4; ++i) { const f32x4 w = *(const LAS f32x4*)(WrT + o * 1024 + ((4 * C.lane + 256 * i + 4 * o) & 1023)), w2 = *(const LAS f32x4*)(WrT + (o + 1) * 1024 + ((4 * C.lane + 256 * i + 4 * (o + 1)) & 1023));
                    a += w[0] * hv[rr][4 * i] + w[1] * hv[rr][4 * i + 1] + w[2] * hv[rr][4 * i + 2] + w[3] * hv[rr][4 * i + 3];
                    c += w2[0] * hv[rr][4 * i] + w2[1] * hv[rr][4 * i + 1] + w2[2] * hv[rr][4 * i + 2] + w2[3] * hv[rr][4 * i + 3]; }
                wave_sum2(a, c); el[q] = a + P_r_be[layer * 32 + gi * 8 + q]; el[q + 1] = c + P_r_be[layer * 32 + gi * 8 + q + 1]; }
            int i0 = 0; float v0 = el[0];
#pragma unroll
            for (int q = 1; q < 8; ++q) if (el[q] > v0) { v0 = el[q]; i0 = q; }
            int i1 = -1; float v1 = -3.0e38f;
#pragma unroll
            for (int q = 0; q < 8; ++q) if (q != i0 && el[q] > v1) { v1 = el[q]; i1 = q; }
            const float e1 = __builtin_amdgcn_exp2f((v1 - v0) * LOG2E), p0 = __builtin_amdgcn_rcpf(1.0f + e1), p1 = e1 * p0;
            if (C.lane == 0 && !dry) { const int lrow = l0 + rr;
                P_r_eid[row * 2] = gi * 8 + i0; P_r_eid[row * 2 + 1] = gi * 8 + i1; P_r_gate[row * 2] = p0 * gprob; P_r_gate[row * 2 + 1] = p1 * gprob;
                le[lrow * 2] = gi * 8 + i0; le[lrow * 2 + 1] = gi * 8 + i1; }
        }
    }
    __syncthreads();
    if (dry) return;
    const int nas = 2 * rpb;
    if (C.tid < nas) lr[C.tid] = __hip_atomic_fetch_add(&hist[le[C.tid]], 1, __ATOMIC_RELAXED, __HIP_MEMORY_SCOPE_WORKGROUP);
    __syncthreads();
    if (C.tid < 32) gbase[C.tid] = (int)__hip_atomic_fetch_add(P_ctl + CW_CNT + 64 * layer + C.tid, (unsigned)hist[C.tid], __ATOMIC_RELAXED, __HIP_MEMORY_SCOPE_AGENT);
    __syncthreads();
    if (C.tid < nas) { const int e = le[C.tid], rk = gbase[e] + lr[C.tid]; P_r_rank[row0 * 2 + C.tid] = rk; P_tokrow[(size_t)e * TOKCAP + rk] = row0 + (C.tid >> 1); }
}
__device__ __noinline__ int moe_offsets_impl(const GAS unsigned* cnts, LAS int* poffs, LAS int* tile_e, int tid) {
    if (tid < 64) {
        const int e = tid & 31; const int cnt = (int)cnts[e]; const int nt = (cnt + 255) >> 8;
        int incl = nt;
#pragma unroll
        for (int o = 1; o < 32; o <<= 1) { const int v = __shfl_up(incl, o, 32); if (e >= o) incl += v; }
        const int first = incl - nt;
        if (tid < 32) { poffs[e] = first * 256; if (e == 31) poffs[32] = incl * 256; tile_e[400 + e] = cnt;
#pragma nounroll
            for (int k = 0; k < nt; ++k) tile_e[first + k] = e; }
    }
    __syncthreads();
    return __builtin_amdgcn_readfirstlane(poffs[32]) >> 8;
}
__device__ __forceinline__ int moe_offsets(KArgs ap, Ctx& C, int layer, LAS int* poffs, LAS int* tile_e) { return __builtin_amdgcn_readfirstlane(moe_offsets_impl((const GAS unsigned*)(P_ctl + CW_CNT + 64 * layer), poffs, tile_e, C.tid)); }
__device__ __forceinline__ void moe_rows(KArgs ap, Ctx& C, int layer, const LAS int* poffs, const LAS int* tile_e, LAS int* rows, int ntiles) {
    if (C.tid < 256) {
        int val[5];
#pragma unroll
        for (int ui = 0; ui < 5; ++ui) { const int tile = ui * 64 + (C.bid & 7) * 8 + (C.bid >> 5); val[ui] = 0;
            if (tile < ntiles) { const int e = tile_e[tile], r = tile * 256 - poffs[e] + C.tid, cnt = tile_e[400 + e];
                if (r < cnt) val[ui] = P_tokrow[(size_t)e * TOKCAP + r]; } }
#pragma unroll
        for (int ui = 0; ui < 5; ++ui) { const int tile = ui * 64 + (C.bid & 7) * 8 + (C.bid >> 5); if (tile < ntiles) rows[ui * 256 + C.tid] = val[ui]; }
    }
    __syncthreads();
}
__device__ __forceinline__ void phase_ln2(KArgs ap, Ctx& C, int layer, bool last, int dry = 0) {
    LAS int* poffs = (LAS int*)(C.lds + LDS_MOE);
    const int nrows = last ? NLAT : MTOT, rpw = nrows / C.ngw, r0 = C.gw * rpw; const bf16* ys = P_R3;
    int ld0 = 0, ld1 = 0; float lg0 = 0.f, lg1 = 0.f;
    if (C.lane < rpw) { const int row = r0 + C.lane; ld0 = poffs[P_r_eid[row * 2]] + P_r_rank[row * 2]; ld1 = poffs[P_r_eid[row * 2 + 1]] + P_r_rank[row * 2 + 1]; lg0 = P_r_gate[row * 2]; lg1 = P_r_gate[row * 2 + 1]; }
#define LN2_OFF(j) (8 * C.lane + 512 * ((j) >> 1) + 4 * ((j) & 1))
    f32x4 g2[4], b2[4];
#pragma unroll
    for (int j = 0; j < 4; ++j) { g2[j] = *(const f32x4*)(P_ln2_g + layer * D + LN2_OFF(j)); b2[j] = *(const f32x4*)(P_ln2_b + layer * D + LN2_OFF(j)); }
    int curb = -1; f32x4 gt[4], sh[4], sc[4];
#pragma unroll
    for (int j = 0; j < 4; ++j) { gt[j] = (f32x4){0.f, 0.f, 0.f, 0.f}; sh[j] = gt[j]; sc[j] = gt[j]; }
    h16x8 px[2][2]; v4u pa[2][2], pb[2][2];
#pragma unroll
    for (int rr = 0; rr < 2; ++rr) { const int row = r0 + rr; const int d0 = __builtin_amdgcn_readlane(ld0, rr), d1 = __builtin_amdgcn_readlane(ld1, rr);
#pragma unroll
        for (int i = 0; i < 2; ++i) { const int off = 8 * C.lane + 512 * i; px[rr][i] = *(const h16x8*)(P_X + (size_t)row * D + off); pa[rr][i] = *(const v4u*)(ys + (size_t)d0 * D + off); pb[rr][i] = *(const v4u*)(ys + (size_t)d1 * D + off); } }
#pragma unroll 1
    for (int it = 0; it < rpw; it += 2) {
        f32x4 xv[2][4], ya[2][4], yb[2][4]; float gg[2][2];
#pragma unroll
        for (int rr = 0; rr < 2; ++rr) { gg[rr][0] = __builtin_bit_cast(float, __builtin_amdgcn_readlane(__builtin_bit_cast(int, lg0), it + rr)); gg[rr][1] = __builtin_bit_cast(float, __builtin_amdgcn_readlane(__builtin_bit_cast(int, lg1), it + rr));
#pragma unroll
            for (int i = 0; i < 2; ++i) {
                xv[rr][2 * i] = __builtin_convertvector(__builtin_shufflevector(px[rr][i], px[rr][i], 0, 1, 2, 3), f32x4); xv[rr][2 * i + 1] = __builtin_convertvector(__builtin_shufflevector(px[rr][i], px[rr][i], 4, 5, 6, 7), f32x4);
                ya[rr][2 * i] = bf4((v2u){pa[rr][i].x, pa[rr][i].y}); ya[rr][2 * i + 1] = bf4((v2u){pa[rr][i].z, pa[rr][i].w});
                yb[rr][2 * i] = bf4((v2u){pb[rr][i].x, pb[rr][i].y}); yb[rr][2 * i + 1] = bf4((v2u){pb[rr][i].z, pb[rr][i].w}); } }
        if (it + 2 < rpw) {
#pragma unroll
            for (int rr = 0; rr < 2; ++rr) { const int row = r0 + it + 2 + rr; const int d0 = __builtin_amdgcn_readlane(ld0, it + 2 + rr), d1 = __builtin_amdgcn_readlane(ld1, it + 2 + rr);
#pragma unroll
                for (int i = 0; i < 2; ++i) { const int off = 8 * C.lane + 512 * i; px[rr][i] = *(const h16x8*)(P_X + (size_t)row * D + off); pa[rr][i] = *(const v4u*)(ys + (size_t)d0 * D + off); pb[rr][i] = *(const v4u*)(ys + (size_t)d1 * D + off); } }
        }
#pragma unroll
        for (int rr = 0; rr < 2; ++rr) {
            const int row = r0 + it + rr; const int bi = row_bidx(row);
            if (bi != curb) { curb = bi; const float* md = P_mod + (size_t)(layer * 17 + bi) * 6144; const float* md2 = P_mod + (size_t)((layer + 1 < DEPTH ? layer + 1 : layer) * 17 + bi) * 6144;
#pragma unroll
                for (int j = 0; j < 4; ++j) { gt[j] = *(const f32x4*)(md + 5 * 1024 + LN2_OFF(j)); sh[j] = *(const f32x4*)(md2 + LN2_OFF(j)); sc[j] = *(const f32x4*)(md2 + 1024 + LN2_OFF(j)); } }
            f32x4 v[4]; float s = 0.f;
#pragma unroll
            for (int j = 0; j < 4; ++j) { v[j] = xv[rr][j] * ALPHA + gt[j] * (ya[rr][j] * gg[rr][0] + yb[rr][j] * gg[rr][1]); s += (v[j][0] + v[j][1]) + (v[j][2] + v[j][3]); }
            const float mean = wave_sum(s) * (1.0f / D); float s2 = 0.f;
#pragma unroll
            for (int j = 0; j < 4; ++j) { v[j] = v[j] - mean; s2 += (v[j][0] * v[j][0] + v[j][1] * v[j][1]) + (v[j][2] * v[j][2] + v[j][3] * v[j][3]); }
            const float rstd = __builtin_amdgcn_rsqf(wave_sum(s2) * (1.0f / D) + LN_EPS);
            f32x4 xn[4];
#pragma unroll
            for (int j = 0; j < 4; ++j) xn[j] = v[j] * rstd * g2[j] + b2[j];
            if (last) {
#pragma unroll
                for (int j = 0; j < 4; ++j) *(f32x4*)((dry ? (float*)(ap->ws + WS_R1) : P_out) + (size_t)row * D + LN2_OFF(j)) = xn[j];
            } else {
#pragma unroll
                for (int i = 0; i < 2; ++i) { const int off = 8 * C.lane + 512 * i;
                    const h16x4 xa = __builtin_convertvector(xn[2 * i], h16x4), xb = __builtin_convertvector(xn[2 * i + 1], h16x4);
                    pst16(dry ? (f16*)(ap->ws + WS_R1) : P_X, ((size_t)row * D + off) * 2, __builtin_bit_cast(v4u, __builtin_shufflevector(xa, xb, 0, 1, 2, 3, 4, 5, 6, 7)));
                    const f32x4 ha = xn[2 * i] * (1.0f + sc[2 * i]) + sh[2 * i], hb = xn[2 * i + 1] * (1.0f + sc[2 * i + 1]) + sh[2 * i + 1];
                    v4u w; w.x = pk2(ha[0], ha[1]); w.y = pk2(ha[2], ha[3]); w.z = pk2(hb[0], hb[1]); w.w = pk2(hb[2], hb[3]);
                    pst16(dry ? (bf16*)(ap->ws + WS_R1 + 80 * MiB) : P_H, ((size_t)row * D + off) * 2, w); }
            }
        }
    }
#undef LN2_OFF
}

__device__ __forceinline__ Ctx fresh(const Ctx& C) { Ctx R = C; const int ln = lane_id_fresh(); R.lane = ln; R.tid = C.wave * 64 + ln; return R; }
constexpr int NPH_LAYER = 8, NPHASES = 1 + DEPTH * NPH_LAYER;
__global__ void __launch_bounds__(512, 2) mk_fwd(Args args) {
    extern __shared__ __attribute__((aligned(16))) unsigned char lds_raw[];
    Ctx C;
    C.lds = (LAS unsigned char*)lds_raw; C.tid = threadIdx.x; C.lane = C.tid & 63; C.wave = __builtin_amdgcn_readfirstlane(C.tid >> 6); C.G = gridDim.x; C.bid = blockIdx.x;
    C.gw = C.bid * 8 + C.wave; C.ngw = C.G * 8;
    volatile LAS unsigned* MISC = (volatile LAS unsigned*)(C.lds + LDS_MISC);
    if (C.tid < 64) MISC[C.tid] = 0u;
    __syncthreads();
    const int lo = args.ph_lo, hi = args.ph_hi;
    XcdBarrier bar; { const KArgs ap = kargs(); bar.bar = P_ctl + CW_BAR; bar.x = 0; bar.st = nullptr; if (hi - lo > 1) bar = xcd_barrier_post(P_ctl + CW_BAR, MISC + 8); }
#ifndef PHMASK
#define PHMASK 0xFFFFFFFFu
#endif
#ifndef REP_GEMM
#define REP_GEMM 1
#endif
#ifndef REP_G3
#define REP_G3 REP_GEMM
#endif
#ifndef REP_G4
#define REP_G4 REP_GEMM
#endif
#ifndef REP_G8
#define REP_G8 REP_GEMM
#endif
#ifndef REP_G11
#define REP_G11 REP_GEMM
#endif
#ifndef REP_G12
#define REP_G12 REP_GEMM
#endif
#ifndef DRY_LN1
#define DRY_LN1 0
#endif
#ifndef DRY_LN2
#define DRY_LN2 0
#endif
#ifndef COLD_CONV
#define COLD_CONV 0
#endif
#ifndef NOSTORE_PROBE
#define NOSTORE_PROBE 0
#endif
#ifndef REP_ATTN
#define REP_ATTN 1
#endif
#ifndef REP_MEM
#define REP_MEM 1
#endif
#define REPEAT(n) _Pragma("nounroll") for (int rep_ = 0; rep_ < (n); ++rep_)
#define IN(k) (lo <= (k) && (k) < hi)
#define EN(b) ((PHMASK >> (b)) & 1u)
#define SEAM(k) do { if ((k) + 1 < hi) xcd_barrier(bar); } while (0)
    LAS unsigned char* ring = C.lds;

    if (IN(0)) { if (EN(0)) REPEAT(REP_MEM) { Ctx Cx = fresh(C); phase_mod(kargs(), Cx); __syncthreads(); } __syncthreads(); if (EN(1)) { Ctx Cx = fresh(C); convert_rest(kargs(), Cx, 0); } SEAM(0); }
#pragma nounroll
    for (int layer = 0; layer < DEPTH; ++layer) {
        const int base = 1 + NPH_LAYER * layer, kind = layer % 3, j = layer / 3; const bool last = layer == DEPTH - 1;
        const int nrows = last ? NLAT : MTOT;
        if (IN(base + 0)) { if (layer == 0) { Ctx Cx = fresh(C); if (EN(2)) REPEAT(REP_MEM) phase_hprep(kargs(), Cx); SEAM(base + 0); } }
        if (IN(base + 1)) {
            int fl_pre = -1, fl_post = -1; const int ftl = kind == 0 ? 160 : 64;
            { const int b_ = C.bid, odd = (b_ >> 3) & 1; int l1 = -1;
              if (kind == 0) { if (b_ >= 208) { fl_pre = 64 + 2 * (b_ - 208); fl_post = fl_pre + 1; } else if (b_ >= 144) l1 = b_ - 144; }
              else if (kind == 1) { if (b_ >= 192) l1 = b_ - 192; }
              else if (b_ >= 128 && b_ < 192) l1 = b_ - 128;
              if (l1 >= 0) { if (odd) fl_pre = l1; else fl_post = l1; } }
            if (EN(1) && fl_pre >= 0) { Ctx Cx = fresh(C); convert_fill(kargs(), Cx, layer, 0, fill_a(layer), fl_pre, 1, ftl); __syncthreads(); }
            if (kind != 1 && EN(3)) REPEAT(REP_G3) {
                const KArgs ap = kargs();
                const int nq = kind == 0 ? 1280 : 2048;
                pg8::Gemm g{P_H, P_WM_IN, MTOT, nq, D}; pg8::StaticOrder S; S.init(MTOT, nq, C.G, C.bid);
                pg8::EpiQK E{P_R1, P_R1 + (size_t)MTOT * D, kind == 0 ? P_rope : nullptr, kind == 0 ? 4 : 16, QSCALE};
                pg8::gemm_phase<pg8::EpiQK, pg8::StaticOrder, true, true>(ring, g, S, E, C.wave);
            }
            if (EN(4)) REPEAT(REP_G4) {
                const KArgs ap = kargs();
                pg8::Gemm g; pg8::StaticOrder S; pg8::EpiP<2> E;
                if (kind == 1) { g = pg8::Gemm{P_H, P_WM_IN, MTOT, 3072, D}; S.init(MTOT, 3072, C.G, C.bid); E = pg8::EpiP<2>{P_R1, P_R1 + (size_t)MTOT * D, D, -1, 1, 0}; }
                else { const int nq = kind == 0 ? 1280 : 2048, nv = kind == 0 ? 256 : 1024; g = pg8::Gemm{P_WM_IN + (size_t)nq * D, P_H, nv, MTOT, D}; S.init(nv, MTOT, C.G, kind == 2 ? C.G - 1 - C.bid : C.bid);     E = pg8::EpiP<2>{P_R1 + (size_t)2 * MTOT * D, nullptr, 0, -1, 0, kind == 0 ? 4 : 16}; }
                pg8::gemm_phase<pg8::EpiP<2>, pg8::StaticOrder, true, true>(ring, g, S, E, C.wave);
            }
            if (EN(1) && fl_post >= 0) { __syncthreads(); Ctx Cx = fresh(C); convert_fill(kargs(), Cx, layer, 0, fill_a(layer), fl_post, 1, ftl); }
            SEAM(base + 1);
        }
        if (IN(base + 2)) { Ctx Cx = fresh(C); if (kind == 0) { if (EN(5)) REPEAT(REP_ATTN) phase_attn<0>(kargs(), Cx, j, last); } else if (kind == 1) { if (EN(6)) REPEAT(REP_ATTN) phase_conv(kargs(), Cx, j, last); } else if (EN(7)) REPEAT(REP_ATTN) phase_attn<2>(kargs(), Cx, j, last); SEAM(base + 2); }
        if (IN(base + 3)) {
            if (!last && EN(1) && C.bid >= 64 && ((C.bid >> 3) & 1)) {
                Ctx Cx = fresh(C);
                convert_fill(kargs(), Cx, layer, fill_a(layer), fill_a(layer) + fill_b(layer), C.bid - 64, 1, 192);
                __syncthreads();
            }
            if (EN(8)) REPEAT(REP_G8) {
                const KArgs ap = kargs();
                pg8::Gemm g{P_R2, P_WM_O, nrows, D, D}; pg8::StaticOrder S; S.init(nrows, D, C.G, C.bid);
                pg8::EpiP<0> E{P_R3, nullptr, D, -1, 0, 0};
                if (NOSTORE_PROBE) { pg8::EpiP<9> E9{P_R3, nullptr, D, -1, 0, 0}; pg8::gemm_phase<pg8::EpiP<9>, pg8::StaticOrder, true, true>(ring, g, S, E9, C.wave); }
                pg8::gemm_phase<pg8::EpiP<0>, pg8::StaticOrder, true, true>(ring, g, S, E, C.wave);
            }
            if (!last && EN(1) && C.bid >= 64 && !((C.bid >> 3) & 1)) {
                __syncthreads(); Ctx Cx = fresh(C);
                convert_fill(kargs(), Cx, layer, fill_a(layer), fill_a(layer) + fill_b(layer), C.bid - 64, 1, 192);
            }
            SEAM(base + 3);
        }
        if (IN(base + 4)) { Ctx Cx = fresh(C); if (EN(9)) { if (DRY_LN1) { phase_ln1(kargs(), Cx, layer, last, 1); __syncthreads(); } phase_ln1(kargs(), Cx, layer, last); } SEAM(base + 4); }
        if (IN(base + 5)) {
            if (EN(11)) REPEAT(REP_G11) {
                const KArgs ap = kargs(); Ctx Cx = fresh(C);
                LAS int* poffs = (LAS int*)(C.lds + LDS_MOE); LAS int* tile_e = poffs + 64; LAS int* rows = poffs + 512;
                const int ntiles = moe_offsets(ap, Cx, layer, poffs, tile_e);
                moe_rows(ap, Cx, layer, poffs, tile_e, rows, ntiles);
                pg8::Gemm g{P_H, P_W1, MTOT, NEXP * 1024, D}; pg8::MoeOrder S{(const LAS int*)tile_e, (const LAS int*)rows, ntiles, C.bid};
                pg8::EpiP<1> E{P_R2, nullptr, EFF, 3, 0, 0};
                pg8::gemm_phase<pg8::EpiP<1>, pg8::MoeOrder, true, true, true>(ring, g, S, E, C.wave);
            }
            SEAM(base + 5);
        }
        if (IN(base + 6)) {
            if (EN(12)) REPEAT(REP_G12) {
                const KArgs ap = kargs(); Ctx Cx = fresh(C);
                LAS int* poffs = (LAS int*)(C.lds + LDS_MOE); LAS int* tile_e = poffs + 64;
                const int ntiles = __builtin_amdgcn_readfirstlane(poffs[32]) >> 8;
                pg8::Gemm g{P_R2, P_W2, ntiles * 256, NEXP * 1024, EFF}; pg8::MoeOrder S{(const LAS int*)tile_e, (const LAS int*)tile_e, ntiles, C.bid};
                pg8::EpiP<0> E{P_R3, nullptr, D, 3, 0, 0};
                pg8::gemm_phase<pg8::EpiP<0>, pg8::MoeOrder, true, true, false, true>(ring, g, S, E, C.wave);
            }
            SEAM(base + 6);
        }
        if (IN(base + 7)) { Ctx Cx = fresh(C); if (EN(13)) { if (DRY_LN2) { phase_ln2(kargs(), Cx, layer, last, 1); __syncthreads(); } phase_ln2(kargs(), Cx, layer, last); } if (!last && EN(1)) { __syncthreads(); convert_rest(kargs(), Cx, layer + 1); } SEAM(base + 7); }
    }
#undef IN
#undef SEAM
}

#ifndef MK_ONE_LAUNCH
#define MK_ONE_LAUNCH 1
#endif
extern "C" void kernel_launch(void* const* d_in, const int* in_sizes, int n_in, void* d_out, int out_size, void* d_ws, size_t ws_size, hipStream_t stream) {
    static int grid = 0;
    if (grid == 0) {
        if (n_in != 26 || in_sizes[0] != NLAT * D || out_size != NLAT * D || ws_size < WS_END) { fprintf(stderr, "kernel_launch: unexpected shapes (n_in %d, in0 %d, out %d, ws %zu < %zu); nothing launched\n", n_in, n_in > 0 ? in_sizes[0] : -1, out_size, ws_size, (size_t)WS_END); grid = -1; return; }
        int dev = 0, cus = 0, per_cu = 0;
        if (hipGetDevice(&dev) != hipSuccess || hipDeviceGetAttribute(&cus, hipDeviceAttributeMultiprocessorCount, dev) != hipSuccess) { fprintf(stderr, "kernel_launch: device query failed\n"); grid = -1; return; }
        if (hipFuncSetAttribute((const void*)mk_fwd, hipFuncAttributeMaxDynamicSharedMemorySize, LDS_BYTES) != hipSuccess) { fprintf(stderr, "kernel_launch: hipFuncSetAttribute failed\n"); grid = -1; return; }
        if (hipOccupancyMaxActiveBlocksPerMultiprocessor(&per_cu, (const void*)mk_fwd, 512, LDS_BYTES) != hipSuccess || per_cu < 1) { fprintf(stderr, "kernel_launch: occupancy query reports %d workgroups per CU\n", per_cu); }
        (void)hipGetLastError();
        grid = 256;
        if (cus < 256) { fprintf(stderr, "kernel_launch: %d CUs < 256: the grid would not be resident; nothing launched\n", cus); grid = -1; return; }
    }
    if (grid < 0) return;
    if (hipMemsetAsync((char*)d_ws + WS_CTL, 0, CTL_ZERO_BYTES, stream) != hipSuccess) { fprintf(stderr, "kernel_launch: hipMemsetAsync failed\n"); return; }
    Args a{};
    for (int i = 0; i < 26; ++i) a.in[i] = (const float*)d_in[i];
    a.out = (float*)d_out; a.ws = (unsigned char*)d_ws;
#if MK_ONE_LAUNCH
    a.ph_lo = 0; a.ph_hi = NPHASES;
    hipLaunchKernelGGL(mk_fwd, dim3(grid), dim3(512), LDS_BYTES, stream, a);
#else
    for (int p = 0; p < NPHASES; ++p) { a.ph_lo = p; a.ph_hi = p + 1; hipLaunchKernelGGL(mk_fwd, dim3(grid), dim3(512), LDS_BYTES, stream, a); }
#endif
    const hipError_t le = hipPeekAtLastError();
    if (le != hipSuccess) fprintf(stderr, "kernel_launch: launch failed: %s\n", hipGetErrorName(le));
}
```

```cpp
#include <hip/hip_runtime.h>
#include <cstdio>
#include <cstdint>

constexpr int D = 1024, NB = 16, SEQ = 2048, CTXL = 256, DEPTH = 4;
constexpr int NLAT = NB * SEQ;
constexpr int NCTX = NB * CTXL;
constexpr int MTOT = NLAT + NCTX;
constexpr int KVTOK = SEQ + CTXL;
constexpr int NEXP = 32, EFF = 512;
constexpr float LN_EPS = 1e-5f;
constexpr float ALPHA = 1.681792830507429f;
constexpr float LOG2E = 1.4426950408889634f;
constexpr float QSCALE = 0.125f * LOG2E;
constexpr float NEGBIG = -1e30f;
namespace pg8 {
#define PG8_LAS __attribute__((address_space(3)))
typedef unsigned short bf16_t;
typedef short bf16x8 __attribute__((ext_vector_type(8)));
typedef float f32x4 __attribute__((ext_vector_type(4)));
typedef unsigned u32x4 __attribute__((ext_vector_type(4)));
constexpr int BM = 256, BK = 64, HALF = 128, HTB = HALF * BK * 2  , STAGE_BYTES = 8 * HTB, NXCD = 8, WGM = 8;

__host__ __device__ __forceinline__ int lds_byte(int r, int c) { const int st = (r >> 4) * 2 + (c >> 5), rr = r & 15, cc = c & 31, ob = rr * 64 + cc * 2; return st * 1024 + (ob ^ (((ob >> 9) & 1) << 5)); }
__host__ __device__ __forceinline__ void stage_rc(int b, int& R, int& C) { const int st = b / 1024, sb = b % 1024, swz = sb ^ (((sb >> 9) & 1) << 5); R = (st >> 1) * 16 + swz / 64; C = (st & 1) * 32 + (swz % 64) / 2; }
__host__ __device__ __forceinline__ int perm32(int rho) { const int n = rho >> 4, i = rho & 15; return 8 * (i >> 2) + 4 * n + (i & 3); }

struct Unit { int pm, pn; };
struct Gemm { const bf16_t* A; const bf16_t* Bt; int M, N, K; };

struct StaticOrder {
    int nM, nN, nwg, G, c;
    __host__ __device__ void init(int M, int N, int G_, int c_) { nM = M / BM; nN = N / BM; nwg = nM * nN; G = G_; c = c_; }
    __host__ __device__ bool next(int i, Unit& u) const {
        const long L = (long)i * G + c; if (L >= nwg) return false;
        int wgid = (int)L; { const int q = nwg / NXCD, r = nwg % NXCD, xcd = wgid % NXCD, off = wgid / NXCD; wgid = (xcd < r ? xcd * (q + 1) : r * (q + 1) + (xcd - r) * q) + off; }
        const int nig = WGM * nN, gid = wgid / nig, fm = gid * WGM, gsz = (nM - fm) < WGM ? (nM - fm) : WGM;
        u.pm = fm + ((wgid % nig) % gsz); u.pn = (wgid % nig) / gsz; return true;
    }
    __device__ __forceinline__ void a_ready(const Unit&) const {}
    __device__ __forceinline__ void done(const Unit&) const {}
};


__device__ __forceinline__ unsigned cvt_pk_bf16(float lo, float hi) { unsigned r; asm volatile("v_cvt_pk_bf16_f32 %0, %1, %2" : "=v"(r) : "v"(lo), "v"(hi)); return r; }
typedef unsigned u32x2 __attribute__((ext_vector_type(2)));
__device__ __forceinline__ u32x2 pk4(const f32x4 v) { u32x2 w; w.x = cvt_pk_bf16(v[0], v[1]); w.y = cvt_pk_bf16(v[2], v[3]); return w; }
__device__ __forceinline__ u32x4 pk8(const f32x4 a, const f32x4 b) { u32x4 w; w.x = cvt_pk_bf16(a[0], a[1]); w.y = cvt_pk_bf16(a[2], a[3]); w.z = cvt_pk_bf16(b[0], b[1]); w.w = cvt_pk_bf16(b[2], b[3]); return w; }
#ifndef WT_STORES
#define WT_STORES 1
#endif
__device__ __forceinline__ void st16(bf16_t* p, const u32x4 v) {
#if WT_STORES
    asm volatile("global_store_dwordx4 %0, %1, off sc1\n\ts_nop 1" :: "v"(p), "v"(v) : "memory");
#else
    *(u32x4*)p = v;
#endif
}
__device__ __forceinline__ void st8(bf16_t* p, const u32x2 v) {
#if WT_STORES
    asm volatile("global_store_dwordx2 %0, %1, off sc1\n\ts_nop 1" :: "v"(p), "v"(v) : "memory");
#else
    *(u32x2*)p = v;
#endif
}
__device__ __forceinline__ void row_bt(int row, int& b, int& tok) { if (row < NLAT) { b = row >> 11; tok = row & 2047; } else { const int r = row - NLAT; b = r >> 8; tok = SEQ + (r & 255); } }

struct EpiQK {
    static constexpr bool PERM = false, AFTER_DRAIN = false;
    bf16_t* Q; bf16_t* Kb; const float* rope; int nkvh; float qscale;
    __device__ __forceinline__ void operator()(const f32x4 (&acc)[2][2][4][2], const Unit& u, int wr, int wc, int fr, int fq) const {
        const bool isQ = u.pn < 4, dorope = (rope != nullptr) && (u.pm < NLAT / BM);
        const int qi_ = fr & 3;
#pragma unroll
        for (int ai = 0; ai < 2; ++ai)
#pragma unroll
            for (int m = 0; m < 4; ++m) {
                const int row = u.pm * BM + ai * HALF + wr * 64 + m * 16 + fr;
                int b, tok; row_bt(row, b, tok);
                u32x2 pc[4];
#pragma unroll
                for (int bj = 0; bj < 2; ++bj) {
                    f32x4 cs = {1.f, 1.f, 1.f, 1.f}, sn = {0.f, 0.f, 0.f, 0.f};
                    if (dorope) { const int pos = bj ? (tok & 63) : (tok >> 6); const float* t = rope + (pos * 16 + 4 * fq) * 2;
                        const f32x4 t0 = *(const f32x4*)t, t1 = *(const f32x4*)(t + 4); cs = (f32x4){t0[0], t0[2], t1[0], t1[2]}; sn = (f32x4){t0[1], t0[3], t1[1], t1[3]}; }
                    const f32x4 x1 = acc[ai][bj][m][0], x2 = acc[ai][bj][m][1];
                    f32x4 o1 = x1 * cs - x2 * sn, o2 = x1 * sn + x2 * cs;
                    if (isQ) { o1 = o1 * qscale; o2 = o2 * qscale; }
                    pc[2 * bj] = pk4(o1); pc[2 * bj + 1] = pk4(o2);
                }
#pragma unroll
                for (int q = 0; q < 2; ++q) {
                    u32x2 snd = (qi_ & 1) ? pc[2 * q] : pc[2 * q + 1], rcv;
                    rcv.x = (unsigned)__builtin_amdgcn_mov_dpp((int)snd.x, 0xB1, 0xF, 0xF, true); rcv.y = (unsigned)__builtin_amdgcn_mov_dpp((int)snd.y, 0xB1, 0xF, 0xF, true);
                    if (qi_ & 1) pc[2 * q] = rcv; else pc[2 * q + 1] = rcv; }
#pragma unroll
                for (int q = 0; q < 2; ++q) {
                    u32x2 snd = (qi_ & 2) ? pc[q] : pc[q + 2], rcv;
                    rcv.x = (unsigned)__builtin_amdgcn_mov_dpp((int)snd.x, 0x4E, 0xF, 0xF, true); rcv.y = (unsigned)__builtin_amdgcn_mov_dpp((int)snd.y, 0x4E, 0xF, 0xF, true);
                    if (qi_ & 2) pc[q] = rcv; else pc[q + 2] = rcv; }
                if (isQ) { bf16_t* dst = Q + (size_t)(row - qi_) * D + u.pn * BM + wc * 64 + 16 * qi_ + 4 * fq;
#pragma unroll
                    for (int r = 0; r < 4; ++r) st8(dst + (size_t)r * D, pc[r]); }
                else { const int head = (u.pn - 4) * 4 + wc; bf16_t* dst = Kb + ((size_t)(b * nkvh + head) * KVTOK + (tok - qi_)) * 64 + 16 * qi_ + 4 * fq;
#pragma unroll
                    for (int r = 0; r < 4; ++r) st8(dst + r * 64, pc[r]); }
            }
    }
};

__device__ __forceinline__ void store_pair_rows(bf16_t* rowp_even, size_t ld, const u32x4 w0, const u32x4 w1, int odd) {
    u32x4 snd, rcv, s1, s2;
#pragma unroll
    for (int q = 0; q < 4; ++q) { snd[q] = odd ? w0[q] : w1[q]; rcv[q] = (unsigned)__builtin_amdgcn_mov_dpp((int)snd[q], 0xB1, 0xF, 0xF, true); }
#pragma unroll
    for (int q = 0; q < 4; ++q) { s1[q] = odd ? rcv[q] : w0[q]; s2[q] = odd ? w1[q] : rcv[q]; }
    st16(rowp_even, s1); st16(rowp_even + ld, s2);
}
template <int MODE> struct EpiP {
    static constexpr bool PERM = true, AFTER_DRAIN = false;
    bf16_t* O; bf16_t* O2; int ldc, pnmask, sub, nkvh;
    __device__ __forceinline__ void operator()(const f32x4 (&acc)[2][2][4][2], const Unit& u, int wr, int wc, int fr, int fq) const {
        if constexpr (MODE == 9) {
#pragma unroll
            for (int ai = 0; ai < 2; ++ai)
#pragma unroll
                for (int m = 0; m < 4; ++m)
#pragma unroll
                    for (int bj = 0; bj < 2; ++bj) asm volatile("" :: "v"(acc[ai][bj][m][0]), "v"(acc[ai][bj][m][1]));
        } else if constexpr (MODE == 0) {
            const int odd = fr & 1, col0 = (u.pn & pnmask) * BM + wc * 64 + 8 * fq + 32 * odd;
#pragma unroll
            for (int ai = 0; ai < 2; ++ai)
#pragma unroll
                for (int m = 0; m < 4; ++m) { bf16_t* rowp = O + (size_t)(u.pm * BM + ai * HALF + wr * 64 + m * 16 + fr - odd) * ldc + col0;
                    store_pair_rows(rowp, (size_t)ldc, pk8(acc[ai][0][m][0], acc[ai][0][m][1]), pk8(acc[ai][1][m][0], acc[ai][1][m][1]), odd); }
        } else if constexpr (MODE == 1) {
            bf16_t* blk = O + (size_t)u.pm * (BM * 512) + (size_t)((u.pn & 3) * 4 + wc) * (BM * 32) + (size_t)wr * (64 * 32);
            const unsigned lo = (unsigned)(fr * 32 + 8 * fq);
#pragma unroll
            for (int ai = 0; ai < 2; ++ai)
#pragma unroll
                for (int m = 0; m < 4; ++m) { bf16_t* rowp = blk + (ai * HALF + m * 16) * 32 + lo;
                    f32x4 h[2];
#pragma unroll
                    for (int n = 0; n < 2; ++n) { const f32x4 g = acc[ai][0][m][n], up = acc[ai][1][m][n];
#pragma unroll
                        for (int j = 0; j < 4; ++j) { const float e = __builtin_amdgcn_exp2f(-g[j] * LOG2E); h[n][j] = g[j] * __builtin_amdgcn_rcpf(1.0f + e) * up[j]; } }
                    st16(rowp, pk8(h[0], h[1])); }
        } else {
            if (sub == 0) {
                int b, tok0; row_bt(u.pn * BM, b, tok0);
                const int odd = fr & 1, tcol = tok0 + wc * 64 + 8 * fq + 32 * odd;
#pragma unroll
                for (int ai = 0; ai < 2; ++ai)
#pragma unroll
                    for (int m = 0; m < 4; ++m) { const int f = u.pm * BM + ai * HALF + wr * 64 + m * 16 + fr - odd; const int head = f >> 6, d = f & 63;
                        bf16_t* rowp = O + ((size_t)(b * nkvh + head) * 64 + d) * KVTOK + tcol;
                        store_pair_rows(rowp, (size_t)KVTOK, pk8(acc[ai][0][m][0], acc[ai][0][m][1]), pk8(acc[ai][1][m][0], acc[ai][1][m][1]), odd); }
            } else {
                if (u.pn < 8) {
                    const int col0 = u.pn * HALF + wc * 32 + 8 * fq;
#pragma unroll
                    for (int ai = 0; ai < 2; ++ai)
#pragma unroll
                        for (int m = 0; m < 4; ++m) { bf16_t* rowp = O + (size_t)(u.pm * BM + ai * HALF + wr * 64 + m * 16 + fr) * D + col0;
                            st16(rowp, pk8(acc[ai][0][m][0] * acc[ai][1][m][0], acc[ai][0][m][1] * acc[ai][1][m][1])); }
                } else {
                    const int odd = fr & 1, col0 = (u.pn - 8) * BM + wc * 64 + 8 * fq + 32 * odd;
#pragma unroll
                    for (int ai = 0; ai < 2; ++ai)
#pragma unroll
                        for (int m = 0; m < 4; ++m) { bf16_t* rowp = O2 + (size_t)(u.pm * BM + ai * HALF + wr * 64 + m * 16 + fr - odd) * D + col0;
                            store_pair_rows(rowp, (size_t)D, pk8(acc[ai][0][m][0], acc[ai][0][m][1]), pk8(acc[ai][1][m][0], acc[ai][1][m][1]), odd); }
                }
            }
        }
    }
};

struct MoeOrder {
    const PG8_LAS int* tile_e; const PG8_LAS int* rows; int ntiles, c;
    __device__ __forceinline__ bool next(int i, Unit& u) const {
        const int tile = i * 64 + (c & 7) * 8 + (c >> 5); if (tile >= ntiles) return false;
        u.pm = tile; u.pn = __builtin_amdgcn_readfirstlane(tile_e[tile]) * 4 + ((c >> 3) & 3); return true;
    }
    __device__ __forceinline__ int row(int ui, int r) const { return rows[ui * 256 + r]; }
    __device__ __forceinline__ void a_ready(const Unit&) const {}
    __device__ __forceinline__ void done(const Unit&) const {}
};
template <class Epi, class Sched, bool ALIGN_EPI = false, bool SP2 = true, bool GATHER = false, bool ABLK = false>
__device__ __forceinline__ void gemm_phase(PG8_LAS unsigned char* lds, const Gemm g, const Sched& S, const Epi& E, int wv  ) {
    int tid_; asm volatile("v_mbcnt_lo_u32_b32 %0, -1, 0\n\tv_mbcnt_hi_u32_b32 %0, -1, %0" : "=v"(tid_)); tid_ += wv * 64;
    static_assert(SP2, "the 64-column-per-wave B mapping reads both of a wave's B fragments from ONE half buffer in SP1: only the two-super-phase loop has them retired together");
    const int tid = tid_, wid = __builtin_amdgcn_readfirstlane(tid >> 6), lane = tid & 63, wr = wid >> 2, wc = wid & 3, fr = lane & 15, fq = lane >> 4;
    const int K = g.K, nt = K / BK;
    unsigned voffA[2][2], voffB[2];
#pragma unroll
    for (int i = 0; i < 2; ++i) { int R, C; stage_rc(tid * 16 + i * 8192, R, C); const int Rb = Epi::PERM ? ((R & ~31) + perm32(R & 31)) : R;
        voffA[0][i] = ABLK ? (unsigned)((C >> 5) * 16384 + R * 64 + (C & 31) * 2) : (unsigned)(R * K + C) * 2u; voffA[1][i] = voffA[0][i];     voffB[i] = (unsigned)(Rb * K + C) * 2u; }
#define PG8_GOFF(dst, uidx) do { _Pragma("unroll") for (int _i = 0; _i < 2; ++_i) { int R_, C_; stage_rc(tid * 16 + _i * 8192, R_, C_); \
        dst[0][_i] = (unsigned)(S.row(uidx, R_) * K + C_) * 2u; dst[1][_i] = (unsigned)(S.row(uidx, R_ + HALF) * K + C_) * 2u; } } while (0)
    const size_t kstep = (size_t)(BK * 2);
    const size_t kstepA = ABLK ? (size_t)32768 : kstep;
    const size_t hstep = (size_t)HALF * K * 2;
    const size_t hstepA = GATHER ? (size_t)0 : (ABLK ? (size_t)(HALF * 64) : hstep);
    const size_t tstep = 2 * hstep;
    const unsigned ldsw = (unsigned)wid * 1024u;
    const int aoff = lds_byte(wr * 64 + fr, fq * 8), boff = lds_byte((wc & 1) * 64 + fr, fq * 8) + (wc >> 1) * HTB;
#define PG8_SA(b, h) (((b) * 2 + (h)) * HTB)
#define PG8_SB(b, h) ((4 + (b) * 2 + (h)) * HTB)
#define PG8_STAGE(bufoff, gbase, voff) do { _Pragma("unroll") for (int _i = 0; _i < 2; ++_i) \
        __builtin_amdgcn_global_load_lds((const unsigned*)((const char*)(gbase) + (voff)[_i]), (PG8_LAS unsigned*)(lds + (bufoff) + ldsw + _i * 8192), 16, 0, 0); } while (0)
#define PG8_LDA(dst, b, h) do { _Pragma("unroll") for (int m = 0; m < 4; ++m) _Pragma("unroll") for (int k = 0; k < 2; ++k) dst[m][k] = *(const PG8_LAS bf16x8*)(lds + PG8_SA(b, h) + aoff + m * 2048 + k * 1024); } while (0)
#define PG8_LDB(dst, b, h) do { _Pragma("unroll") for (int n = 0; n < 2; ++n) _Pragma("unroll") for (int k = 0; k < 2; ++k) dst[n][k] = *(const PG8_LAS bf16x8*)(lds + PG8_SB(b, 0) + boff + (h) * 4096 + n * 2048 + k * 1024); } while (0)
#define PG8_MMA(ai, bj, At, Bt) do { __builtin_amdgcn_s_setprio(1); _Pragma("unroll") for (int m = 0; m < 4; ++m) _Pragma("unroll") for (int n = 0; n < 2; ++n) _Pragma("unroll") for (int k = 0; k < 2; ++k) \
        acc[ai][bj][m][n] = __builtin_amdgcn_mfma_f32_16x16x32_bf16(Bt[n][k], At[m][k], acc[ai][bj][m][n], 0, 0, 0); __builtin_amdgcn_s_setprio(0); } while (0)
#define PG8_WAIT_V(n) asm volatile("s_waitcnt vmcnt(" #n ")" ::: "memory")
#define PG8_WAIT_L(n) asm volatile("s_waitcnt lgkmcnt(" #n ")" ::: "memory")
#define PG8_BAR __builtin_amdgcn_s_barrier()
#define PG8_SCHED __builtin_amdgcn_sched_barrier(0)
    Unit cur, nxt; int ui = 0;
    if (!S.next(0, cur)) return;
    f32x4 acc[2][2][4][2];
#pragma unroll
    for (int a = 0; a < 2; ++a)
#pragma unroll
        for (int b = 0; b < 2; ++b)
#pragma unroll
            for (int m = 0; m < 4; ++m)
#pragma unroll
                for (int n = 0; n < 2; ++n) acc[a][b][m][n] = (f32x4){0.f, 0.f, 0.f, 0.f};
    bf16x8 At[4][2], B0[2][2], B1[2][2];
    const char* cA = (const char*)g.A + (GATHER ? (size_t)0 : (size_t)cur.pm * tstep); const char* cB = (const char*)g.Bt + (size_t)cur.pn * tstep;
    if constexpr (GATHER) PG8_GOFF(voffA, 0);
    S.a_ready(cur);
    if constexpr (SP2) {
        PG8_STAGE(PG8_SB(0, 0), cB, voffB); PG8_STAGE(PG8_SB(0, 1), cB + hstep, voffB); PG8_STAGE(PG8_SA(0, 0), cA, voffA[0]); PG8_STAGE(PG8_SA(0, 1), cA + hstepA, voffA[1]);
        if (wr == 1) PG8_BAR;
        PG8_WAIT_V(2); PG8_BAR;
        PG8_STAGE(PG8_SB(1, 0), cB + kstep, voffB); PG8_STAGE(PG8_SA(1, 0), cA + kstepA, voffA[0]); PG8_STAGE(PG8_SB(1, 1), cB + hstep + kstep, voffB);
        PG8_WAIT_V(6); PG8_BAR;
    } else {
        PG8_STAGE(PG8_SB(0, 0), cB, voffB); PG8_STAGE(PG8_SA(0, 0), cA, voffA[0]); PG8_STAGE(PG8_SB(0, 1), cB + hstep, voffB); PG8_STAGE(PG8_SA(0, 1), cA + hstepA, voffA[1]);
        if (wr == 1) PG8_BAR;
        PG8_WAIT_V(4); PG8_BAR;
        PG8_STAGE(PG8_SB(1, 0), cB + kstep, voffB); PG8_STAGE(PG8_SA(1, 0), cA + kstepA, voffA[0]); PG8_STAGE(PG8_SB(1, 1), cB + hstep + kstep, voffB);
        PG8_WAIT_V(6); PG8_BAR;
    }
    for (;;) {
        const bool has_next = S.next(ui + 1, nxt);
        const char* nA = (has_next && !GATHER) ? (const char*)g.A + (size_t)nxt.pm * tstep : cA; const char* nB = has_next ? (const char*)g.Bt + (size_t)nxt.pn * tstep : cB;
#pragma nounroll
        for (int t = 0; t < nt; t += 2) {
            const bool last = (t == nt - 2);
            const char* a1 = cA + (size_t)(t + 1) * kstepA;
            const char* a2 = last ? nA : cA + (size_t)(t + 2) * kstepA; const char* b2 = last ? nB : cB + (size_t)(t + 2) * kstep;
            const char* a3 = a2 + kstepA; const char* b3 = b2 + kstep;
            if (last && has_next) S.a_ready(nxt);
            if constexpr (SP2) {
            PG8_LDB(B0, 0, 0); PG8_LDB(B1, 0, 1); PG8_SCHED; PG8_LDA(At, 0, 0); PG8_STAGE(PG8_SA(1, 1), a1 + hstepA, voffA[1]);
            if constexpr (GATHER) { if (last && has_next) PG8_GOFF(voffA, ui + 1); }
            PG8_WAIT_V(8); PG8_WAIT_L(0); PG8_BAR; PG8_MMA(0, 0, At, B0); PG8_MMA(0, 1, At, B1); PG8_BAR; PG8_SCHED;
            PG8_LDA(At, 0, 1); PG8_STAGE(PG8_SB(0, 0), b2, voffB); PG8_STAGE(PG8_SB(0, 1), b2 + hstep, voffB); PG8_STAGE(PG8_SA(0, 0), a2, voffA[0]);
            PG8_WAIT_V(8); PG8_WAIT_L(0); PG8_BAR; PG8_MMA(1, 0, At, B0); PG8_MMA(1, 1, At, B1); PG8_BAR; PG8_SCHED;
            PG8_LDB(B0, 1, 0); PG8_LDB(B1, 1, 1); PG8_SCHED; PG8_LDA(At, 1, 0); PG8_STAGE(PG8_SA(0, 1), a2 + hstepA, voffA[1]);
            PG8_WAIT_V(8); PG8_WAIT_L(0); PG8_BAR; PG8_MMA(0, 0, At, B0); PG8_MMA(0, 1, At, B1); PG8_BAR; PG8_SCHED;
            PG8_LDA(At, 1, 1); PG8_STAGE(PG8_SB(1, 0), b3, voffB); PG8_STAGE(PG8_SB(1, 1), b3 + hstep, voffB); PG8_STAGE(PG8_SA(1, 0), a3, voffA[0]);
            PG8_WAIT_V(8); PG8_WAIT_L(0); PG8_BAR; PG8_MMA(1, 0, At, B0); PG8_MMA(1, 1, At, B1); PG8_BAR; PG8_SCHED;
            } else {
            PG8_LDB(B0, 0, 0); PG8_SCHED; PG8_LDA(At, 0, 0); PG8_STAGE(PG8_SA(1, 1), a1 + hstepA, voffA[1]);
            PG8_WAIT_L(8); PG8_BAR; PG8_WAIT_L(0); PG8_MMA(0, 0, At, B0); PG8_BAR; PG8_SCHED;
            PG8_LDB(B1, 0, 1); PG8_STAGE(PG8_SB(0, 0), b2, voffB);
            PG8_BAR; PG8_WAIT_L(0); PG8_MMA(0, 1, At, B1); PG8_BAR;
            PG8_LDA(At, 0, 1); PG8_STAGE(PG8_SA(0, 0), a2, voffA[0]);
            PG8_BAR; PG8_WAIT_L(0); PG8_MMA(1, 0, At, B0); PG8_BAR; PG8_SCHED;
            PG8_STAGE(PG8_SB(0, 1), b2 + hstep, voffB);
            PG8_WAIT_V(6); PG8_BAR; PG8_MMA(1, 1, At, B1); PG8_BAR;
            PG8_LDB(B0, 1, 0); PG8_SCHED; PG8_LDA(At, 1, 0); PG8_STAGE(PG8_SA(0, 1), a2 + hstepA, voffA[1]);
            PG8_WAIT_L(8); PG8_BAR; PG8_WAIT_L(0); PG8_MMA(0, 0, At, B0); PG8_BAR; PG8_SCHED;
            PG8_LDB(B1, 1, 1); PG8_STAGE(PG8_SB(1, 0), b3, voffB);
            PG8_BAR; PG8_WAIT_L(0); PG8_MMA(0, 1, At, B1); PG8_BAR;
            PG8_LDA(At, 1, 1); PG8_STAGE(PG8_SA(1, 0), a3, voffA[0]);
            PG8_BAR; PG8_WAIT_L(0); PG8_MMA(1, 0, At, B0); PG8_BAR; PG8_SCHED;
            PG8_STAGE(PG8_SB(1, 1), b3 + hstep, voffB);
            PG8_WAIT_V(6); PG8_BAR; PG8_MMA(1, 1, At, B1); PG8_BAR;
            }
        }
        if constexpr (ALIGN_EPI) { if (wr == 0) PG8_BAR; }
        if constexpr (!Epi::AFTER_DRAIN) { E(acc, cur, wr, wc, fr, fq); S.done(cur); }
        if (!has_next) break;
#pragma unroll
        for (int a = 0; a < 2; ++a)
#pragma unroll
            for (int b = 0; b < 2; ++b)
#pragma unroll
                for (int m = 0; m < 4; ++m)
#pragma unroll
                    for (int n = 0; n < 2; ++n) acc[a][b][m][n] = (f32x4){0.f, 0.f, 0.f, 0.f};
        cur = nxt; cA = nA; cB = nB; ++ui;
        if constexpr (ALIGN_EPI) { if (wr == 1) PG8_BAR; }
    }
    PG8_WAIT_V(0);
    if constexpr (!ALIGN_EPI) { if (wr == 0) PG8_BAR; }
    PG8_BAR;
    if constexpr (Epi::AFTER_DRAIN) { E.fused(acc, cur, wr, wc, fr, fq, lds, wid, lane); S.done(cur); }
#undef PG8_SA
#undef PG8_SB
#undef PG8_STAGE
#undef PG8_GOFF
#undef PG8_LDA
#undef PG8_LDB
#undef PG8_MMA
#undef PG8_WAIT_V
#undef PG8_WAIT_L
#undef PG8_BAR
#undef PG8_SCHED
}
}

constexpr size_t MiB = 1u << 20;
constexpr size_t WS_CTL = 0, CTL_ZERO_BYTES = 1 * MiB;
constexpr size_t WS_MOD = 1 * MiB;
constexpr size_t WS_ROPE = 3 * MiB;
constexpr size_t WS_ROUT = 4 * MiB;
constexpr size_t WS_X = 8 * MiB;
constexpr size_t WS_H = 152 * MiB;
constexpr size_t WS_R1 = 224 * MiB;
constexpr size_t WS_R2 = 440 * MiB;
constexpr size_t WS_R3 = 520 * MiB;
constexpr size_t WS_WM = 680 * MiB;
constexpr size_t WS_W1 = 688 * MiB;
constexpr size_t WS_W2 = 752 * MiB;
constexpr size_t WS_END = 784 * MiB;
constexpr int CW_BAR = 4096;
constexpr int CW_CNT = 16384;
constexpr int CW_Q = 20480;
constexpr int CW_DONE = 24576;
constexpr int LDS_BYTES = 155648;
constexpr int LDS_MOE = 131072;
constexpr int LDS_MISC = LDS_BYTES - 256;

#define GAS __attribute__((address_space(1)))
#define LAS __attribute__((address_space(3)))
typedef unsigned short bf16;
typedef unsigned v4u __attribute__((ext_vector_type(4)));
typedef unsigned v2u __attribute__((ext_vector_type(2)));
typedef float f32x4 __attribute__((ext_vector_type(4)));
typedef float f32x2 __attribute__((ext_vector_type(2)));
typedef float f32x16 __attribute__((ext_vector_type(16)));
typedef short bf16x8 __attribute__((ext_vector_type(8)));
typedef _Float16 f16;
typedef _Float16 h16x4 __attribute__((ext_vector_type(4)));
typedef _Float16 h16x8 __attribute__((ext_vector_type(8)));
#ifndef WT_PHASE
#define WT_PHASE 1
#endif
__device__ __forceinline__ __amdgpu_buffer_rsrc_t mkrs(const void* p) { return __builtin_amdgcn_make_buffer_rsrc((void*)p, 0, 0x7fffffff, 0x00020000); }
__device__ __forceinline__ void gst16(void* base, size_t boff, const v4u v) {
#if WT_PHASE
    __builtin_amdgcn_raw_buffer_store_b128(v, mkrs(base), (int)boff, 0, 16);
#else
    *(v4u*)((char*)base + boff) = v;
#endif
}
__device__ __forceinline__ void gst8(void* base, size_t boff, const v2u v) {
#if WT_PHASE
    __builtin_amdgcn_raw_buffer_store_b64(v, mkrs(base), (int)boff, 0, 16);
#else
    *(v2u*)((char*)base + boff) = v;
#endif
}
__device__ __forceinline__ void pst16(void* base, size_t boff, const v4u v) { *(v4u*)((char*)base + boff) = v; }
__device__ __forceinline__ void pst8(void* base, size_t boff, const v2u v) { *(v2u*)((char*)base + boff) = v; }
__device__ __forceinline__ void pst16_nt(void* base, size_t boff, const v4u v) { __builtin_nontemporal_store(v, (v4u*)((char*)base + boff)); }
__device__ __forceinline__ void gst16_nt(void* base, size_t boff, const v4u v) {
#if WT_PHASE
    __builtin_amdgcn_raw_buffer_store_b128(v, mkrs(base), (int)boff, 0, 18);
#else
    __builtin_nontemporal_store(v, (v4u*)((char*)base + boff));
#endif
}
#define LDS_WAIT() asm volatile("s_waitcnt lgkmcnt(0)" ::: "memory")
__device__ __forceinline__ unsigned f2bf(float f) { unsigned u = __builtin_bit_cast(unsigned, f); return (u + 0x7fffu + ((u >> 16) & 1u)) >> 16; }
__device__ __forceinline__ unsigned pk2(float lo, float hi) { return pg8::cvt_pk_bf16(lo, hi); }
typedef __bf16 bf16x2_t __attribute__((ext_vector_type(2)));
__device__ __forceinline__ unsigned pk2c(float lo, float hi) { const f32x2 v = {lo, hi}; return __builtin_bit_cast(unsigned, __builtin_convertvector(v, bf16x2_t)); }
__device__ __forceinline__ float bflo(unsigned w) { return __uint_as_float(w << 16); }
__device__ __forceinline__ float bfhi(unsigned w) { return __uint_as_float(w & 0xffff0000u); }
__device__ __forceinline__ f32x4 bf4(v2u w) { return (f32x4){bflo(w.x), bfhi(w.x), bflo(w.y), bfhi(w.y)}; }
__device__ __forceinline__ int lane_id_fresh() { int ln; asm volatile("v_mbcnt_lo_u32_b32 %0, -1, 0\n\tv_mbcnt_hi_u32_b32 %0, -1, %0" : "=v"(ln)); return ln; }
template <int CTRL, int RM> __device__ __forceinline__ float dpp0(float src) {
    return __builtin_bit_cast(float, __builtin_amdgcn_update_dpp(0, __builtin_bit_cast(int, src), CTRL, RM, 0xF, true)); }
__device__ __forceinline__ float wave_sum(float v) {
    v += dpp0<0xB1, 0xF>(v); v += dpp0<0x4E, 0xF>(v); v += dpp0<0x141, 0xF>(v); v += dpp0<0x140, 0xF>(v);
    v += dpp0<0x142, 0xA>(v); v += dpp0<0x143, 0xC>(v);
    return __builtin_bit_cast(float, __builtin_amdgcn_readlane(__builtin_bit_cast(int, v), 63));
}
__device__ __forceinline__ float xor32_max(float v) { const auto rr = __builtin_amdgcn_permlane32_swap(__float_as_uint(v), __float_as_uint(v), false, false); return fmaxf(__uint_as_float(rr[0]), __uint_as_float(rr[1])); }
__device__ __forceinline__ float xor32_sum(float v) { const auto rr = __builtin_amdgcn_permlane32_swap(__float_as_uint(v), __float_as_uint(v), false, false); return __uint_as_float(rr[0]) + __uint_as_float(rr[1]); }
#define XB_TMO      128
#define XB_XCNT(j)  (256  + 64 * (j))
#define XB_XSUB(j)  (1280 + 64 * (j))
#define XB_XGEN(j)  (2304 + 64 * (j))
#define XB_TOP      3328
#define XB_TOPGEN   3392
#define XCD_BAR_WORDS 3456
#define XB_SPIN_CAP (1u << 18)

__device__ __forceinline__ unsigned xb_ld(unsigned* p)              { return __hip_atomic_load(p, __ATOMIC_RELAXED, __HIP_MEMORY_SCOPE_AGENT); }
__device__ __forceinline__ unsigned xb_add(unsigned* p, unsigned v) { return __hip_atomic_fetch_add(p, v, __ATOMIC_RELAXED, __HIP_MEMORY_SCOPE_AGENT); }
__device__ __forceinline__ unsigned xb_xcc_id() { return (unsigned)__builtin_amdgcn_s_getreg((3 << 11) | 20) & 0xFu; }
#define XB_SPIN(cond, bar) do { unsigned _sp = 0; while (cond) { __builtin_amdgcn_s_sleep(1); \
    if ((++_sp & 255u) == 0u) { if (xb_ld(&(bar)[XB_TMO])) break; if (_sp > XB_SPIN_CAP) { atomicAdd(&(bar)[XB_TMO], 1u); break; } } } } while (0)

struct XcdBarrier {
    unsigned* bar; unsigned x;
    volatile LAS unsigned* st;
};

__device__ __forceinline__ XcdBarrier xcd_barrier_post(unsigned* bar, volatile LAS unsigned* st) {
    XcdBarrier b; b.bar = bar; b.x = xb_xcc_id(); b.st = st;
    if (threadIdx.x == 0) (void)xb_add(&bar[XB_XCNT(b.x)], 1u);
    return b;
}
__device__ __forceinline__ void xcd_barrier_complete(unsigned* bar, unsigned x, unsigned& nloc, unsigned& nx) {
    const unsigned G = gridDim.x * gridDim.y * gridDim.z;
    unsigned sum, cnt, mine, sp = 0u;
    for (;;) {
        sum = 0u; cnt = 0u; mine = 0u;
#pragma unroll
        for (unsigned j = 0; j < 16; ++j) { const unsigned c = xb_ld(&bar[XB_XCNT(j)]); sum += c; cnt += (c > 0u) ? 1u : 0u; mine = (j == x) ? c : mine; }
        if (sum == G) break;
        __builtin_amdgcn_s_sleep(1);
        if ((++sp & 255u) == 0u) { if (xb_ld(&bar[XB_TMO])) break; if (sp > XB_SPIN_CAP) { atomicAdd(&bar[XB_TMO], 1u); break; } }
    }
    nloc = mine > 0u ? mine : 1u; nx = cnt > 0u ? cnt : 1u;
}

__device__ __forceinline__ void xcd_barrier(const XcdBarrier& b) {
    asm volatile("s_waitcnt vmcnt(0)" ::: "memory");
    __syncthreads();
    if (threadIdx.x == 0) {
        unsigned* bar = b.bar;
        __builtin_amdgcn_s_waitcnt(0);
        unsigned nloc = b.st[0], nx = b.st[1];
        if (nloc == 0u) { xcd_barrier_complete(bar, b.x, nloc, nx); b.st[0] = nloc; b.st[1] = nx; }
        const unsigned old = xb_add(&bar[XB_XSUB(b.x)], 1u);
        const unsigned gen = old / nloc;
        if (old + 1u == (gen + 1u) * nloc) {
            __builtin_amdgcn_fence(__ATOMIC_RELEASE, "agent");
            asm volatile("s_waitcnt vmcnt(0)" ::: "memory");
            const unsigned og = xb_add(&bar[XB_TOP], 1u);
            const unsigned tg = og / nx;
            if (og + 1u == (tg + 1u) * nx) xb_add(&bar[XB_TOPGEN], 1u);
            else XB_SPIN(xb_ld(&bar[XB_TOPGEN]) == tg, bar);
            __builtin_amdgcn_fence(__ATOMIC_ACQUIRE, "agent");
            xb_add(&bar[XB_XGEN(b.x)], 1u);
            asm volatile("s_waitcnt vmcnt(0)" ::: "memory");
        } else {
            XB_SPIN(xb_ld(&bar[XB_XGEN(b.x)]) == gen, bar);
            __builtin_amdgcn_fence(__ATOMIC_ACQUIRE, "agent");
            asm volatile("s_waitcnt vmcnt(0)" ::: "memory");
        }
    }
    __syncthreads();
}
struct Args { const float* in[26]; float* out; unsigned char* ws; int ph_lo, ph_hi; };
typedef const Args __attribute__((address_space(4)))* KArgs;
__device__ __forceinline__ KArgs kargs() { KArgs p = (KArgs)__builtin_amdgcn_kernarg_segment_ptr(); asm volatile("" : "+s"(p)); return p; }
#define P_x (ap->in[0])
#define P_c (ap->in[1])
#define P_ctx (ap->in[2])
#define P_c_ctx (ap->in[3])
#define P_w_ada (ap->in[4])
#define P_b_ada (ap->in[5])
#define P_ln1_g (ap->in[6])
#define P_ln1_b (ap->in[7])
#define P_ln2_g (ap->in[8])
#define P_ln2_b (ap->in[9])
#define P_attn_w_qkv (ap->in[10])
#define P_attn_w_o (ap->in[11])
#define P_attn_sink (ap->in[12])
#define P_conv_w_in (ap->in[13])
#define P_conv_w (ap->in[14])
#define P_conv_w_out (ap->in[15])
#define P_nat_w_qkv (ap->in[16])
#define P_nat_w_o (ap->in[17])
#define P_nat_rpb (ap->in[18])
#define P_r_wg (ap->in[19])
#define P_r_bg (ap->in[20])
#define P_r_we (ap->in[21])
#define P_r_be (ap->in[22])
#define P_e_wg (ap->in[23])
#define P_e_wu (ap->in[24])
#define P_e_wd (ap->in[25])
#define P_out (ap->out)
#define P_ctl ((unsigned*)(ap->ws + WS_CTL))
#define P_mod ((float*)(ap->ws + WS_MOD))
#define P_rope ((float*)(ap->ws + WS_ROPE))
#define P_r_eid ((int*)(ap->ws + WS_ROUT))
#define P_r_gate ((float*)(ap->ws + WS_ROUT) + 2 * MTOT)
#define P_r_rank ((int*)(ap->ws + WS_ROUT) + 4 * MTOT)
#define P_r_dest ((int*)(ap->ws + WS_ROUT) + 6 * MTOT)
#define P_X ((f16*)(ap->ws + WS_X))
#define P_tokrow ((int*)(ap->ws + WS_R1))
constexpr int TOKCAP = 2 * MTOT;
#define P_H ((bf16*)(ap->ws + WS_H))
#define P_R1 ((bf16*)(ap->ws + WS_R1))
#define P_R2 ((bf16*)(ap->ws + WS_R2))
#define P_R3 ((bf16*)(ap->ws + WS_R3))
#define P_WM_IN ((bf16*)(ap->ws + WS_WM))
#define P_WM_O ((bf16*)(ap->ws + WS_WM + 6 * MiB))
#define P_W1 ((bf16*)(ap->ws + WS_W1))
#define P_W2 ((bf16*)(ap->ws + WS_W2))

struct Ctx {
    LAS unsigned char* lds; int tid, lane, wave, G, bid, gw, ngw;
};
__device__ __forceinline__ const float* xin_row(KArgs ap, const Ctx& C, int row) {
    return row < NLAT ? P_x + (size_t)row * D : P_ctx + (size_t)(row - NLAT) * D;
}
__device__ __forceinline__ f32x4 ldx4(KArgs ap, const Ctx& C, int layer, int row, int off) {
    if (layer == 0) return *(const f32x4*)(xin_row(ap, C, row) + off);
    return __builtin_convertvector(*(const h16x4*)(P_X + (size_t)row * D + off), f32x4);
}
__device__ __forceinline__ void stx4(KArgs ap, int row, int off, const f32x4 v, size_t dry = 0) { gst8(dry ? (f16*)(ap->ws + WS_R1) : P_X, ((size_t)row * D + off) * 2, __builtin_bit_cast(v2u, __builtin_convertvector(v, h16x4))); }
__device__ __forceinline__ int row_bidx(int row) { return row < NLAT ? (row >> 11) : 16; }

__device__ __forceinline__ void phase_mod(KArgs ap, Ctx& C) {
    LAS float* sl = (LAS float*)C.lds;
    LAS float* part = (LAS float*)(C.lds + 69632);
    {
        f32x4 cv[9];
#pragma unroll
        for (int j = 0; j < 9; ++j) { const int idx = (j * 512 + C.tid) * 4; const int r = idx >> 10, k = idx & 1023;
            cv[j] = idx < 17 * 1024 ? *(const f32x4*)(r < 16 ? P_c + r * 1024 + k : P_c_ctx + k) : (f32x4){0.f, 0.f, 0.f, 0.f}; }
#pragma unroll
        for (int j = 0; j < 9; ++j) { const int idx = (j * 512 + C.tid) * 4;
            if (idx < 17 * 1024) { f32x4 o;
#pragma unroll
                for (int q = 0; q < 4; ++q) o[q] = cv[j][q] * __builtin_amdgcn_rcpf(1.0f + __builtin_amdgcn_exp2f(-cv[j][q] * LOG2E));
                *(LAS f32x4*)(sl + idx) = o; } }
    }
    __syncthreads();
    for (int unit = C.bid; unit < DEPTH * 48; unit += C.G) {
        const int layer = unit / 48, nb = (unit % 48) * 128;
        const float* W = P_w_ada + (size_t)layer * 1024 * 6144 + nb + 2 * C.lane;
        float a0[17], a1[17];
#pragma unroll
        for (int r = 0; r < 17; ++r) { a0[r] = 0.f; a1[r] = 0.f; }
        const int k0 = C.wave * 128;
#pragma nounroll
        for (int kk = 0; kk < 128; kk += 16) {
            f32x2 w[16];
#pragma unroll
            for (int j = 0; j < 16; ++j) w[j] = *(const f32x2*)(W + (size_t)(k0 + kk + j) * 6144);
#pragma unroll
            for (int r = 0; r < 17; ++r) {
#pragma unroll
                for (int q = 0; q < 4; ++q) { const f32x4 s = *(const LAS f32x4*)(sl + r * 1024 + k0 + kk + 4 * q);
                    a0[r] += s[0] * w[4 * q].x + s[1] * w[4 * q + 1].x + s[2] * w[4 * q + 2].x + s[3] * w[4 * q + 3].x;
                    a1[r] += s[0] * w[4 * q].y + s[1] * w[4 * q + 1].y + s[2] * w[4 * q + 2].y + s[3] * w[4 * q + 3].y; } }
        }
#pragma unroll
        for (int r = 0; r < 17; ++r) *(LAS f32x2*)(part + (C.wave * 17 + r) * 128 + 2 * C.lane) = (f32x2){a0[r], a1[r]};
        __syncthreads();
        for (int idx = C.tid; idx < 17 * 128; idx += 512) { const int r = idx >> 7, cc = idx & 127; float s = P_b_ada[layer * 6144 + nb + cc];
#pragma unroll
            for (int w = 0; w < 8; ++w) s += part[(w * 17 + r) * 128 + cc];
            P_mod[(size_t)(layer * 17 + r) * 6144 + nb + cc] = s; }
        __syncthreads();
    }
    if (C.bid == C.G - 1) for (int idx = C.tid; idx < 1024; idx += 512) { const int pos = idx >> 4, i = idx & 15;
        const float inv = exp2f(-(float)i * (13.287712379549449f / 16.0f)); const float ang = (float)pos * inv;
        P_rope[idx * 2] = cosf(ang); P_rope[idx * 2 + 1] = sinf(ang); }
}

__device__ __forceinline__ void tr_item(const float* W, int N, int k0, int n0, bf16* WT, int Kd, int drow0, LAS float* scr, int lane) {
    float wv[32];
#pragma unroll
    for (int i = 0; i < 32; ++i) { const int kk = 2 * i + (lane >> 5); wv[i] = W[(size_t)(k0 + kk) * N + n0 + (lane & 31)]; }
#pragma unroll
    for (int i = 0; i < 32; ++i) { const int kk = 2 * i + (lane >> 5); scr[kk * 33 + (lane & 31)] = wv[i]; }
    LDS_WAIT(); asm volatile("" ::: "memory");
    const int c = lane & 7;
#pragma unroll
    for (int j = 0; j < 4; ++j) { const int n = (lane >> 3) + 8 * j; const LAS float* s = scr + (8 * c) * 33 + n;
        v4u o; o.x = pk2(s[0 * 33], s[1 * 33]); o.y = pk2(s[2 * 33], s[3 * 33]); o.z = pk2(s[4 * 33], s[5 * 33]); o.w = pk2(s[6 * 33], s[7 * 33]);
        *(v4u*)(WT + (size_t)(drow0 + n) * Kd + k0 + 8 * c) = o; }
    LDS_WAIT(); asm volatile("" ::: "memory");
}
__device__ __forceinline__ int convert_nitems(int layer) { return 3 * 32 * 256 + 16 * ((layer % 3) == 0 ? 48 : 96) + 512; }
__device__ __forceinline__ void convert_item(KArgs ap, Ctx& C, int layer, int it, LAS float* scr) {
    const int kind = layer % 3, j = layer / 3;
    if (it < 3 * 32 * 256) {
        const int which = it >> 13, r = it & 8191, e = r >> 8, q = r & 255;
        if (which < 2) { const float* W = (which ? P_e_wu : P_e_wg) + (size_t)(layer * 32 + e) * 1024 * 512; const int kb = q >> 4, n0 = 32 * (q & 15);
            tr_item(W, 512, 64 * kb, n0, P_W1, 1024, e * 1024 + 256 * (n0 >> 7) + 64 * ((n0 >> 5) & 3) + 32 * which, scr, C.lane); }
        else { const float* W = P_e_wd + (size_t)(layer * 32 + e) * 512 * 1024; const int kb = q >> 5, n0 = 32 * (q & 31);
            tr_item(W, 1024, 64 * kb, n0, P_W2, 512, e * 1024 + n0, scr, C.lane); }
        return;
    }
    it -= 3 * 32 * 256;
    const int nblk = kind == 0 ? 48 : 96;
    if (it < 16 * nblk) {
        const float* W; int N;
        if (kind == 0) { W = P_attn_w_qkv + (size_t)j * 1024 * 1536; N = 1536; }
        else if (kind == 1) { W = P_conv_w_in + (size_t)j * 1024 * 3072; N = 3072; }
        else { W = P_nat_w_qkv + (size_t)j * 1024 * 3072; N = 3072; }
        const int kb = it / nblk, n0 = 32 * (it % nblk); int drow0 = n0;
        if (kind == 1) { if (n0 < 1024) drow0 = 2048 + n0; else if (n0 < 2048) { const int jj = n0 - 1024; drow0 = 256 * (jj >> 7) + 64 * ((jj >> 5) & 3); } else { const int jj = n0 - 2048; drow0 = 256 * (jj >> 7) + 64 * ((jj >> 5) & 3) + 32; } }
        tr_item(W, N, 64 * kb, n0, P_WM_IN, 1024, drow0, scr, C.lane);
        return;
    }
    it -= 16 * nblk;
    const float* W = (kind == 0 ? P_attn_w_o : kind == 1 ? P_conv_w_out : P_nat_w_o) + (size_t)j * 1024 * 1024;
    const int kb = it >> 5, n0 = 32 * (it & 31); tr_item(W, 1024, 64 * kb, n0, P_WM_O, 1024, n0, scr, C.lane);
}
struct CvItem { const float* src; bf16* dst; int N, Kd; };
__device__ __forceinline__ CvItem convert_addr(KArgs ap, int layer, int it) {
    const int kind = layer % 3, j = layer / 3; CvItem r;
    if (it < 3 * 32 * 256) {
        const int which = it >> 13, rr = it & 8191, e = rr >> 8, q = rr & 255;
        if (which < 2) { const float* W = (which ? P_e_wu : P_e_wg) + (size_t)(layer * 32 + e) * 1024 * 512; const int kb = q >> 4, n0 = 32 * (q & 15);
            r.src = W + (size_t)(64 * kb) * 512 + n0; r.N = 512; r.dst = P_W1 + (size_t)(e * 1024 + 256 * (n0 >> 7) + 64 * ((n0 >> 5) & 3) + 32 * which) * 1024 + 64 * kb; r.Kd = 1024; }
        else { const float* W = P_e_wd + (size_t)(layer * 32 + e) * 512 * 1024; const int kb = q >> 5, n0 = 32 * (q & 31);
            r.src = W + (size_t)(64 * kb) * 1024 + n0; r.N = 1024; r.dst = P_W2 + (size_t)(e * 1024 + n0) * 512 + 64 * kb; r.Kd = 512; }
        return r;
    }
    it -= 3 * 32 * 256;
    const int nblk = kind == 0 ? 48 : 96;
    if (it < 16 * nblk) {
        const float* W; int N;
        if (kind == 0) { W = P_attn_w_qkv + (size_t)j * 1024 * 1536; N = 1536; }
        else if (kind == 1) { W = P_conv_w_in + (size_t)j * 1024 * 3072; N = 3072; }
        else { W = P_nat_w_qkv + (size_t)j * 1024 * 3072; N = 3072; }
        const int kb = it / nblk, n0 = 32 * (it % nblk); int drow0 = n0;
        if (kind == 1) { if (n0 < 1024) drow0 = 2048 + n0; else if (n0 < 2048) { const int jj = n0 - 1024; drow0 = 256 * (jj >> 7) + 64 * ((jj >> 5) & 3); } else { const int jj = n0 - 2048; drow0 = 256 * (jj >> 7) + 64 * ((jj >> 5) & 3) + 32; } }
        r.src = W + (size_t)(64 * kb) * N + n0; r.N = N; r.dst = P_WM_IN + (size_t)drow0 * 1024 + 64 * kb; r.Kd = 1024;
        return r;
    }
    it -= 16 * nblk;
    const float* W = (kind == 0 ? P_attn_w_o : kind == 1 ? P_conv_w_out : P_nat_w_o) + (size_t)j * 1024 * 1024;
    const int kb = it >> 5, n0 = 32 * (it & 31);
    r.src = W + (size_t)(64 * kb) * 1024 + n0; r.N = 1024; r.dst = P_WM_O + (size_t)n0 * 1024 + 64 * kb; r.Kd = 1024;
    return r;
}
__device__ __forceinline__ void tr_load(const CvItem& I, f32x4 (&wv)[8], int lane) {
    const float* p = I.src + (size_t)(lane >> 3) * I.N + 4 * (lane & 7);
#pragma unroll
    for (int i = 0; i < 8; ++i) wv[i] = __builtin_nontemporal_load((const f32x4*)(p + (size_t)(8 * i) * I.N));
}
__device__ __forceinline__ void tr_store(const CvItem& I, const f32x4 (&wv)[8], LAS float* scr, int lane) {
    LAS float* wp = scr + (lane >> 3) * 33 + 4 * (lane & 7);
#pragma unroll
    for (int i = 0; i < 8; ++i) { wp[(8 * i) * 33] = wv[i][0]; wp[(8 * i) * 33 + 1] = wv[i][1]; wp[(8 * i) * 33 + 2] = wv[i][2]; wp[(8 * i) * 33 + 3] = wv[i][3]; }
    LDS_WAIT(); asm volatile("" ::: "memory");
    const int c = lane & 7;
#pragma unroll
    for (int j = 0; j < 4; ++j) { const int n = (lane >> 3) + 8 * j; const LAS float* s = scr + (8 * c) * 33 + n;
        v4u o; o.x = pk2(s[0 * 33], s[1 * 33]); o.y = pk2(s[2 * 33], s[3 * 33]); o.z = pk2(s[4 * 33], s[5 * 33]); o.w = pk2(s[6 * 33], s[7 * 33]);
        pst16_nt(I.dst, ((size_t)n * I.Kd + 8 * c) * 2, o); }
    LDS_WAIT(); asm volatile("" ::: "memory");
}
__device__ __forceinline__ void convert_seq(KArgs ap, Ctx& C, int layer, int first, int stride, int hi) {
    LAS float* scr = (LAS float*)(C.lds + C.wave * 16384);
    if (first >= hi) return;
    f32x4 w0[8], w1[8], w2[8], w3[8]; CvItem i0, i1, i2, i3;
    int it = first;
    i0 = convert_addr(ap, layer, it); tr_load(i0, w0, C.lane);
    if (it + stride < hi) { i1 = convert_addr(ap, layer, it + stride); tr_load(i1, w1, C.lane); }
    if (it + 2 * stride < hi) { i2 = convert_addr(ap, layer, it + 2 * stride); tr_load(i2, w2, C.lane); }
#pragma unroll 1
    for (;;) {
        if (it + 3 * stride < hi) { i3 = convert_addr(ap, layer, it + 3 * stride); tr_load(i3, w3, C.lane); }
        tr_store(i0, w0, scr, C.lane);
        if (it + 4 * stride < hi) { i0 = convert_addr(ap, layer, it + 4 * stride); tr_load(i0, w0, C.lane); }
        if (it + stride >= hi) break;
        tr_store(i1, w1, scr, C.lane);
        if (it + 5 * stride < hi) { i1 = convert_addr(ap, layer, it + 5 * stride); tr_load(i1, w1, C.lane); }
        if (it + 2 * stride >= hi) break;
        tr_store(i2, w2, scr, C.lane);
        if (it + 6 * stride < hi) { i2 = convert_addr(ap, layer, it + 6 * stride); tr_load(i2, w2, C.lane); }
        if (it + 3 * stride >= hi) break;
        tr_store(i3, w3, scr, C.lane);
        it += 4 * stride;
        if (it >= hi) break;
    }
}
__device__ __forceinline__ void convert_pull(KArgs ap, Ctx& C, int layer, const unsigned* done) {
    LAS float* scr = (LAS float*)(C.lds + C.wave * 16384); volatile LAS int* slot = (volatile LAS int*)(C.lds + LDS_MISC + 64);
    const int nit = convert_nitems(layer); unsigned* qh = P_ctl + CW_Q + 64 * layer;
    for (;;) {
        if (C.tid == 0) { int base = -1;
            if (!(done && __hip_atomic_load(done, __ATOMIC_RELAXED, __HIP_MEMORY_SCOPE_AGENT) >= (unsigned)C.G)) { const unsigned b = __hip_atomic_fetch_add(qh, 16u, __ATOMIC_RELAXED, __HIP_MEMORY_SCOPE_AGENT); if (b < (unsigned)nit) base = (int)b; }
            slot[0] = base; }
        __syncthreads();
        const int base = __builtin_amdgcn_readfirstlane(slot[0]);
        if (base < 0) break;
#pragma unroll 1
        for (int k = 0; k < 2; ++k) { const int it = base + 8 * k + C.wave; if (it < nit) convert_item(ap, C, layer, it, scr); }
        __syncthreads();
    }
}
#ifndef FA0
#define FA0 10240
#endif
#ifndef FA12
#define FA12 0
#endif
#ifndef FA3
#define FA3 20480
#endif
#ifndef FB0
#define FB0 14336
#endif
#ifndef FB12
#define FB12 24576
#endif
__device__ __forceinline__ int fill_a(int layer) { return layer == 0 ? FA0 : layer == 3 ? FA3 : FA12; }
__device__ __forceinline__ int fill_b(int layer) { return layer == 0 ? FB0 : layer == DEPTH - 1 ? 0 : FB12; }
__device__ __forceinline__ void convert_rest(KArgs ap, Ctx& C, int layer) {
    convert_seq(ap, C, layer, fill_a(layer) + fill_b(layer) + C.gw, C.ngw, convert_nitems(layer));
}
__device__ __forceinline__ void convert_fill(KArgs ap, Ctx& C, int layer, int lo, int hi, int l0, int nl, int tl) {
    convert_seq(ap, C, layer, lo + l0 * 8 + C.wave, tl * 8, hi);
}
__device__ __forceinline__ void tail_convert(KArgs ap, Ctx& C, int layer_next, int phase) {
    unsigned* done = P_ctl + CW_DONE + 64 * phase;
    __syncthreads();
    if (C.tid == 0) __hip_atomic_fetch_add(done, 1u, __ATOMIC_RELAXED, __HIP_MEMORY_SCOPE_AGENT);
    convert_pull(ap, C, layer_next, done);
}
__device__ __forceinline__ void phase_hprep(KArgs ap, Ctx& C) {
    for (int row = C.gw; row < MTOT; row += C.ngw) {
        const float* xr = xin_row(ap, C, row); const float* md = P_mod + (size_t)row_bidx(row) * 6144;
#pragma unroll
        for (int i = 0; i < 4; ++i) { const int off = 4 * C.lane + 256 * i; const f32x4 x = *(const f32x4*)(xr + off), sh = *(const f32x4*)(md + off), sc = *(const f32x4*)(md + 1024 + off);
            const f32x4 h = x * (1.0f + sc) + sh; v2u w; w.x = pk2(h[0], h[1]); w.y = pk2(h[2], h[3]); pst8(P_H, ((size_t)row * D + off) * 2, w); }
    }
}

__device__ __forceinline__ int crow(int r, int hi) { return (r & 3) + 8 * (r >> 2) + 4 * hi; }
__device__ __forceinline__ int clampi(int v, int lo, int hi) { return v < lo ? lo : (v > hi ? hi : v); }
#define MFMA32(a, b, c) __builtin_amdgcn_mfma_f32_32x32x16_bf16(a, b, c, 0, 0, 0)
struct TileArg { int a, kr, r_q, c_q, rs_q, qs_q; };
__device__ __forceinline__ int kidx(int reg, int hi) { return (reg & 3) + 4 * ((reg >> 2) & 1) + 8 * hi + 16 * (reg >> 3); }
template <int MODE, int FIX = 0>
__device__ __forceinline__ void attn_tile(f32x16& o0, f32x16& o1, float& m, float& l, const LAS unsigned char* ck, int koff, const bf16x8 (&qf)[4], int r32, int hi, const TileArg& T, const LAS float* bias, const float (&cmm)[16]) {
    const int row = koff + ((r32 & 3) | ((r32 & 4) << 1) | ((r32 & 8) >> 1) | (r32 & 16)); const LAS unsigned char* kp = ck + row * 128; const int sw = (row >> 1) & 7;
    const bf16x8 kf0 = *(const LAS bf16x8*)(kp + (((0 + hi) ^ sw) << 4)), kf1 = *(const LAS bf16x8*)(kp + (((2 + hi) ^ sw) << 4));
    const bf16x8 kf2 = *(const LAS bf16x8*)(kp + (((4 + hi) ^ sw) << 4)), kf3 = *(const LAS bf16x8*)(kp + (((6 + hi) ^ sw) << 4));
    const int c0 = (koff >> 3) + hi;
    const LAS unsigned char* vp0 = ck + 8192 + r32 * 128; const int sw0 = (r32 >> 1) & 7;
    const LAS unsigned char* vp1 = ck + 8192 + (32 + r32) * 128; const int sw1 = ((32 + r32) >> 1) & 7;
    const bf16x8 vf0 = *(const LAS bf16x8*)(vp0 + (((c0) ^ sw0) << 4)), vf1 = *(const LAS bf16x8*)(vp0 + (((c0 + 2) ^ sw0) << 4));
    const bf16x8 vf2 = *(const LAS bf16x8*)(vp1 + (((c0) ^ sw1) << 4)), vf3 = *(const LAS bf16x8*)(vp1 + (((c0 + 2) ^ sw1) << 4));
    __builtin_amdgcn_sched_barrier(0);
    f32x16 p;
#pragma unroll
    for (int r = 0; r < 16; ++r) p[r] = 0.f;
    p = MFMA32(kf0, qf[0], p); p = MFMA32(kf1, qf[1], p); p = MFMA32(kf2, qf[2], p); p = MFMA32(kf3, qf[3], p);
    if constexpr (MODE == 1) {
#pragma unroll
        for (int r = 0; r < 16; ++r) { const int d = T.a + kidx(r, hi); if (d > 128 || d < -128) p[r] = NEGBIG; }
    }
    if constexpr (MODE == 2) {
        const bool rowok = (T.kr >= T.rs_q) && (T.kr < T.rs_q + 8); const int drow = rowok ? T.kr - T.r_q + 7 : 15;
        const LAS float* bp = bias + 16 + drow * 31 + T.a;
#pragma unroll
        for (int r = 0; r < 16; ++r) p[r] = (p[r] + bp[(r & 3) + 4 * ((r >> 2) & 1) + 16 * (r >> 3)]) + cmm[r];
    }
    if constexpr (FIX == 0) {
        float tm = p[0];
#pragma unroll
        for (int r = 1; r < 16; ++r) tm = fmaxf(tm, p[r]);
        tm = xor32_max(tm);
        const float mn = fmaxf(m, tm), alpha = __builtin_amdgcn_exp2f(m - mn);
        float rs = 0.f;
#pragma unroll
        for (int r = 0; r < 16; ++r) { p[r] = __builtin_amdgcn_exp2f(p[r] - mn); rs += p[r]; }
        l = l * alpha + rs; m = mn;
#pragma unroll
        for (int r = 0; r < 16; ++r) { o0[r] *= alpha; o1[r] *= alpha; }
    } else {
        if constexpr (FIX == 1) {
            float tm = p[0];
#pragma unroll
            for (int r = 1; r < 16; ++r) tm = fmaxf(tm, p[r]);
            tm = xor32_max(tm);
            const float mn = fmaxf(m, tm); l *= __builtin_amdgcn_exp2f(m - mn); m = mn;
        }
        float rs = 0.f;
#pragma unroll
        for (int r = 0; r < 16; ++r) { p[r] = __builtin_amdgcn_exp2f(MODE == 2 ? p[r] : p[r] - m); rs += p[r]; }
        l += rs;
    }
    v4u w0, w1;
    w0.x = pk2c(p[0], p[1]); w0.y = pk2c(p[2], p[3]); w0.z = pk2c(p[4], p[5]); w0.w = pk2c(p[6], p[7]);
    w1.x = pk2c(p[8], p[9]); w1.y = pk2c(p[10], p[11]); w1.z = pk2c(p[12], p[13]); w1.w = pk2c(p[14], p[15]);
    const bf16x8 pb0 = __builtin_bit_cast(bf16x8, w0), pb1 = __builtin_bit_cast(bf16x8, w1);
    o0 = MFMA32(vf0, pb0, o0); o1 = MFMA32(vf2, pb0, o1);
    o0 = MFMA32(vf1, pb1, o0); o1 = MFMA32(vf3, pb1, o1);
}
__device__ __forceinline__ void attn_store(bf16* O, size_t rowq0, int hi16, int head, const f32x16& o0, const f32x16& o1, float l, int r32, int hi, LAS unsigned char* ost, int lane) {
    l = xor32_sum(l); const float inv = __builtin_amdgcn_rcpf(l);
    LAS unsigned char* wr_ = ost + r32 * 128;
#pragma unroll
    for (int g = 0; g < 4; ++g) { v2u w; w.x = pk2(o0[4 * g] * inv, o0[4 * g + 1] * inv); w.y = pk2(o0[4 * g + 2] * inv, o0[4 * g + 3] * inv);
        *(LAS v2u*)(wr_ + (((g) ^ (r32 & 7)) << 4) + 8 * hi) = w; }
#pragma unroll
    for (int g = 0; g < 4; ++g) { v2u w; w.x = pk2(o1[4 * g] * inv, o1[4 * g + 1] * inv); w.y = pk2(o1[4 * g + 2] * inv, o1[4 * g + 3] * inv);
        *(LAS v2u*)(wr_ + (((4 + g) ^ (r32 & 7)) << 4) + 8 * hi) = w; }
#pragma unroll
    for (int k = 0; k < 4; ++k) { const int row = 8 * k + (lane >> 3), pc = lane & 7;
        const v4u v = *(const LAS v4u*)(ost + row * 128 + ((pc ^ (row & 7)) << 4));
        gst16(O, ((rowq0 + (size_t)((row & 15) + (row >> 4) * hi16)) * D + head * 64 + 8 * pc) * 2, v); }
}
template <int KIND>
__device__ __forceinline__ size_t attn_rowq(int b, int part, int qi, int wave, int r32) {
    constexpr int NLATQ = KIND == 0 ? 8 : 4;
    if (KIND == 0) { if (qi < NLATQ) return (size_t)b * SEQ + 32 * (2 * (8 * part + qi) + (wave >> 2)) + r32; return (size_t)NLAT + b * CTXL + 64 * part + 32 * (wave >> 2) + r32; }
    if (qi < NLATQ) { const int r0 = 4 * (4 * part + qi) + 2 * (wave >> 2); return (size_t)b * SEQ + (r0 + (r32 >> 4)) * 64 + 16 * (wave & 3) + (r32 & 15); }
    return (size_t)NLAT + b * CTXL + 128 * part + 32 * (wave & 3) + r32;
}
constexpr int ATT_CTX_OFF = 0, ATT_BUF_OFF = 65536, ATT_OST_OFF = 100352, ATT_RPB_OFF = 133120;
template <int KIND>
__device__ __forceinline__ void phase_attn(KArgs ap, Ctx& C, int j, bool last) {
    const bf16* Q = P_R1; const bf16* Kb = P_R1 + (size_t)MTOT * D; const bf16* VTb = P_R1 + (size_t)2 * MTOT * D; bf16* O = P_R2;
    constexpr int NH = KIND == 0 ? 4 : 16, NLATQ = KIND == 0 ? 8 : 4, NUNITS = KIND == 0 ? 256 : 512;
    const int r32 = C.lane & 31, hi = C.lane >> 5, t = C.tid;
    const LAS unsigned char* ctxc = C.lds + ATT_CTX_OFF; LAS unsigned char* sbuf = C.lds + ATT_BUF_OFF; LAS float* rpb = (LAS float*)(C.lds + ATT_RPB_OFF);
    const int pr = t >> 3, pc = t & 7;
    const int kdst = pr * 128 + ((pc ^ ((pr >> 1) & 7)) << 4), vdst = 8192 + pr * 128 + ((pc ^ ((pr >> 1) & 7)) << 4);
    int par = 0;
    for (int unit = C.bid; unit < NUNITS; unit += C.G) {
        int b, h, part; if (KIND == 0) { b = unit >> 4; h = (unit >> 2) & 3; part = unit & 3; } else { b = unit >> 5; h = (unit >> 1) & 15; part = unit & 1; }
        const bf16* Kh = Kb + (size_t)(b * NH + h) * KVTOK * 64; const bf16* Vh = VTb + (size_t)(b * NH + h) * 64 * KVTOK;
        const bf16* kg = Kh + t * 8; const bf16* vg = Vh + (size_t)pr * KVTOK + pc * 8;
        __syncthreads();
#pragma unroll
        for (int cc = 0; cc < 4; ++cc) { const int tok0 = SEQ + 64 * cc; const v4u kv = *(const v4u*)(kg + (size_t)tok0 * 64), vv = *(const v4u*)(vg + tok0);
            *(LAS v4u*)(C.lds + ATT_CTX_OFF + cc * 16384 + kdst) = kv; *(LAS v4u*)(C.lds + ATT_CTX_OFF + cc * 16384 + vdst) = vv; }
        if (KIND == 2) {
            for (int e = t; e < 544; e += 512) rpb[e] = e < 16 ? 0.0f : (e < 16 + 465 ? P_nat_rpb[(size_t)(j * 16 + h) * 465 + (e - 16)] * LOG2E : NEGBIG); }
        __syncthreads();
        const int nqi = last ? NLATQ : NLATQ + 1;
        int qlo0, qhi0; if (KIND == 0) { const int qb = 8 * part; qlo0 = qb - 2 < 0 ? 0 : qb - 2; qhi0 = qb + 2 > 31 ? 31 : qb + 2; } else { const int quad = 4 * part; qlo0 = clampi(4 * quad - 4, 0, 24); qhi0 = clampi(4 * quad - 1, 0, 24) + 7; }
        v4u pk = *(const v4u*)(kg + (size_t)(64 * qlo0) * 64), pv = *(const v4u*)(vg + 64 * qlo0);
        const int headq = KIND == 0 ? 4 * h + (C.wave & 3) : h;
        bf16x8 qn[4];
        {   const size_t rq = attn_rowq<KIND>(b, part, 0, C.wave, r32);
#pragma unroll
            for (int s = 0; s < 4; ++s) qn[s] = *(const bf16x8*)(Q + rq * D + headq * 64 + 16 * s + 8 * hi); }
        for (int qi = 0; qi < nqi; ++qi) {
            const bool isctx = qi == NLATQ;
            int head, clo = 0, chi = -1; size_t rowq; bool active = true; TileArg T; T.a = 0; T.kr = 0; T.r_q = 0; T.c_q = 0; T.rs_q = 0; T.qs_q = 0;
            int qt = 0, wlo = 0, whi = -1, kc0 = 0;
            if (KIND == 0) {
                head = 4 * h + (C.wave & 3);
                if (!isctx) { const int qb = 8 * part + qi; clo = qb - 2 < 0 ? 0 : qb - 2; chi = qb + 2 > 31 ? 31 : qb + 2; qt = 2 * qb + (C.wave >> 2); rowq = (size_t)b * SEQ + 32 * qt + r32; }
                else rowq = (size_t)NLAT + b * CTXL + 64 * part + 32 * (C.wave >> 2) + r32;
            } else {
                head = h;
                if (!isctx) { const int quad = 4 * part + qi; clo = clampi(4 * quad - 4, 0, 24); chi = clampi(4 * quad - 1, 0, 24) + 7;
                    const int r0 = 4 * quad + 2 * (C.wave >> 2), cb = C.wave & 3; T.r_q = r0 + (r32 >> 4); T.c_q = 16 * cb + (r32 & 15); rowq = (size_t)b * SEQ + T.r_q * 64 + T.c_q;
                    T.rs_q = clampi(T.r_q - 4, 0, 24); T.qs_q = clampi(T.c_q - 8, 0, 48); wlo = clampi(r0 - 4, 0, 24); whi = clampi(r0 - 3, 0, 24) + 7; kc0 = clampi(16 * cb - 8, 0, 32); T.a = kc0 + 8 * hi - T.c_q + 15; }
                else { active = C.wave < 4; rowq = (size_t)NLAT + b * CTXL + 128 * part + 32 * (C.wave & 3) + r32; }
            }
            bf16x8 qf[4];
#pragma unroll
            for (int s = 0; s < 4; ++s) qf[s] = qn[s];
            if (qi + 1 < nqi) { const size_t rq = attn_rowq<KIND>(b, part, qi + 1, C.wave, r32);
#pragma unroll
                for (int s = 0; s < 4; ++s) qn[s] = *(const bf16x8*)(Q + rq * D + headq * 64 + 16 * s + 8 * hi); }
            f32x16 o0, o1; float cmm[16];
#pragma unroll
            for (int r = 0; r < 16; ++r) { o0[r] = 0.f; o1[r] = 0.f; cmm[r] = 0.f; }
            float m, l; if (KIND == 0) { m = P_attn_sink[j * 16 + head] * LOG2E; l = hi == 0 ? 1.0f : 0.0f; } else { m = NEGBIG; l = 0.0f; }
            if (active) {
                if (true) {
                    attn_tile<0, 1>(o0, o1, m, l, ctxc, 0, qf, r32, hi, T, rpb, cmm);
#pragma unroll 2
                    for (int jt = 1; jt < 8; ++jt) attn_tile<0, 2>(o0, o1, m, l, ctxc + (jt >> 1) * 16384, 32 * (jt & 1), qf, r32, hi, T, rpb, cmm);
                } else {
#pragma unroll 1
                    for (int jt = 0; jt < 8; ++jt) attn_tile<0>(o0, o1, m, l, ctxc + (jt >> 1) * 16384, 32 * (jt & 1), qf, r32, hi, T, rpb, cmm);
                }
            }
            if (KIND == 2 && !isctx) {
#pragma unroll
                for (int r = 0; r < 16; ++r) { const int kc = kc0 + kidx(r, hi); cmm[r] = ((kc >= T.qs_q && kc < T.qs_q + 16) ? 0.0f : NEGBIG) - m; }
            }
#pragma unroll 1
            for (int ch = clo; ch <= chi; ++ch) {
                LAS unsigned char* buf = sbuf + par * 16384;
                *(LAS v4u*)(buf + kdst) = pk; *(LAS v4u*)(buf + vdst) = pv;
                __syncthreads();
                {
                    int nch = ch + 1; bool ok = true;
                    if (nch > chi) { const int nq = qi + 1; if (nq < NLATQ) { if (KIND == 0) { const int qb = 8 * part + nq; nch = qb - 2 < 0 ? 0 : qb - 2; } else { const int quad = 4 * part + nq; nch = clampi(4 * quad - 4, 0, 24); } } else ok = false; }
                    if (ok) { pk = *(const v4u*)(kg + (size_t)(64 * nch) * 64); pv = *(const v4u*)(vg + 64 * nch); }
                }
                if (KIND == 0) {
#pragma unroll
                    for (int tau = 0; tau < 2; ++tau) { const int kt = 2 * ch + tau; if (kt >= qt - 4 && kt <= qt + 4) { T.a = 32 * kt - (32 * qt + r32); if (kt == qt - 4 || kt == qt + 4) attn_tile<1, 2>(o0, o1, m, l, buf, 32 * tau, qf, r32, hi, T, rpb, cmm); else attn_tile<0, 2>(o0, o1, m, l, buf, 32 * tau, qf, r32, hi, T, rpb, cmm); } }
                } else {
                    if (ch >= wlo && ch <= whi) { T.kr = ch; attn_tile<2, 2>(o0, o1, m, l, buf, kc0, qf, r32, hi, T, rpb, cmm); }
                }
                par ^= 1;
            }
            if (active) attn_store(O, rowq - (size_t)((r32 & 15) + (r32 >> 4) * ((KIND == 2 && !isctx) ? 64 : 16)), (KIND == 2 && !isctx) ? 64 : 16, head, o0, o1, l, r32, hi, C.lds + ATT_OST_OFF + C.wave * 4096, C.lane);
        }
    }
}
__device__ __forceinline__ void phase_conv(KArgs ap, Ctx& C, int j, bool last) {
    const bf16* Vc = P_R1; const bf16* GB = P_R1 + (size_t)MTOT * D; bf16* Z = P_R2; const float* cw = P_conv_w + (size_t)j * 3 * D;
    const int nrows = last ? NLAT : MTOT;
    const int rpw = nrows / C.ngw, r0 = C.gw * rpw;
    float w0[2][8], w1[2][8], w2[2][8];
#pragma unroll
    for (int i = 0; i < 2; ++i)
#pragma unroll
        for (int q = 0; q < 8; ++q) { const int c = 8 * C.lane + 512 * i + q; w0[i][q] = cw[c]; w1[i][q] = cw[D + c]; w2[i][q] = cw[2 * D + c]; }
    v4u va[2], vb[2], vc[2], g[2], vn[2], gn[2];
#pragma unroll
    for (int i = 0; i < 2; ++i) { const size_t o = (size_t)r0 * D + 8 * C.lane + 512 * i;
        va[i] = *(const v4u*)(Vc + (r0 > 0 ? o - D : o)); vb[i] = *(const v4u*)(Vc + o); vc[i] = *(const v4u*)(Vc + o + D); g[i] = *(const v4u*)(GB + o); }
#pragma unroll 1
    for (int k = 0; k < rpw; ++k) {
        const int row = r0 + k;
        if (k + 1 < rpw) {
#pragma unroll
            for (int i = 0; i < 2; ++i) { const size_t o = (size_t)(row + 1) * D + 8 * C.lane + 512 * i; vn[i] = *(const v4u*)(Vc + o + D); gn[i] = *(const v4u*)(GB + o); } }
        int pos, len; if (row < NLAT) { pos = row & 2047; len = SEQ; } else { pos = (row - NLAT) & 255; len = CTXL; }
        const bool hasm = pos > 0, hasp = pos < len - 1;
#pragma unroll
        for (int i = 0; i < 2; ++i) {
            v4u r;
#pragma unroll
            for (int q = 0; q < 4; ++q) {
                const unsigned am = hasm ? va[i][q] : 0u, cp = hasp ? vc[i][q] : 0u;
                const float lo = bflo(g[i][q]) * (w0[i][2 * q] * bflo(am) + w1[i][2 * q] * bflo(vb[i][q]) + w2[i][2 * q] * bflo(cp));
                const float hh = bfhi(g[i][q]) * (w0[i][2 * q + 1] * bfhi(am) + w1[i][2 * q + 1] * bfhi(vb[i][q]) + w2[i][2 * q + 1] * bfhi(cp));
                r[q] = pk2(lo, hh); }
            gst16(Z, ((size_t)row * D + 8 * C.lane + 512 * i) * 2, r);
            va[i] = vb[i]; vb[i] = vc[i]; vc[i] = vn[i]; g[i] = gn[i]; }
    }
}

__device__ __forceinline__ void wave_sum2(float& a, float& b) { a = wave_sum(a); b = wave_sum(b); }
__device__ __forceinline__ void phase_ln1(KArgs ap, Ctx& C, int layer, bool last, int dry = 0) {
    LAS float* WrT = (LAS float*)C.lds;
    LAS int* hist = (LAS int*)(C.lds + 147456);
    LAS int* gbase = hist + 32;
    LAS int* le = gbase + 32;
    LAS int* lr = le + 288;
    const float* wg = P_r_wg + (size_t)layer * 1024 * 4; const float* we = P_r_we + (size_t)layer * 1024 * 32;
    {
        f32x4 gq[2], eq[16];
#pragma unroll
        for (int j = 0; j < 2; ++j) gq[j] = *(const f32x4*)(wg + 4 * (j * 512 + C.tid));
#pragma unroll
        for (int j = 0; j < 16; ++j) eq[j] = *(const f32x4*)(we + 4 * (j * 512 + C.tid));
#pragma unroll
        for (int j = 0; j < 2; ++j) { const int k = j * 512 + C.tid;
#pragma unroll
            for (int q = 0; q < 4; ++q) WrT[q * 1024 + ((k + 4 * q) & 1023)] = gq[j][q]; }
#pragma unroll
        for (int j = 0; j < 16; ++j) { const int f = j * 512 + C.tid, k = f >> 3;
#pragma unroll
            for (int q = 0; q < 4; ++q) { const int o = 4 + 4 * (f & 7) + q; WrT[o * 1024 + ((k + 4 * o) & 1023)] = eq[j][q]; } }
    }
    if (C.tid < 32) hist[C.tid] = 0;
    __syncthreads();
    const int nrows = last ? NLAT : MTOT, rpb = nrows / C.G, rpw = rpb >> 3, row0 = C.bid * rpb;
    const bf16* Y = P_R3;
    f32x4 g1[4], b1[4];
#pragma unroll
    for (int i = 0; i < 4; ++i) { const int off = 4 * C.lane + 256 * i; g1[i] = *(const f32x4*)(P_ln1_g + layer * D + off); b1[i] = *(const f32x4*)(P_ln1_b + layer * D + off); }
    int curb = -1; f32x4 gt[4], sh[4], sc[4];
#pragma unroll
    for (int i = 0; i < 4; ++i) { gt[i] = (f32x4){0.f, 0.f, 0.f, 0.f}; sh[i] = gt[i]; sc[i] = gt[i]; }
    const int lbeg = C.wave * rpw, lend = lbeg + rpw;
    h16x4 pxh[2][4]; v2u pyv[2][4];
    if (layer != 0) {
#pragma unroll
        for (int rr = 0; rr < 2; ++rr) { const int row = row0 + lbeg + rr;
#pragma unroll
            for (int i = 0; i < 4; ++i) { const int off = 4 * C.lane + 256 * i; pxh[rr][i] = *(const h16x4*)(P_X + (size_t)row * D + off); pyv[rr][i] = *(const v2u*)(Y + (size_t)row * D + off); } }
    }
#pragma unroll 1
    for (int l0 = lbeg; l0 < lend; l0 += 2) {
        f32x4 xv[2][4]; v2u yv[2][4];
        if (layer == 0) {
#pragma unroll
            for (int rr = 0; rr < 2; ++rr) { const int row = row0 + l0 + rr; const float* xr = xin_row(ap, C, row); const bf16* yr = Y + (size_t)row * D;
#pragma unroll
                for (int i = 0; i < 4; ++i) { const int off = 4 * C.lane + 256 * i; xv[rr][i] = *(const f32x4*)(xr + off); yv[rr][i] = *(const v2u*)(yr + off); } }
        } else {
#pragma unroll
            for (int rr = 0; rr < 2; ++rr)
#pragma unroll
                for (int i = 0; i < 4; ++i) { xv[rr][i] = __builtin_convertvector(pxh[rr][i], f32x4); yv[rr][i] = pyv[rr][i]; }
            if (l0 + 2 < lend) {
#pragma unroll
                for (int rr = 0; rr < 2; ++rr) { const int row = row0 + l0 + 2 + rr;
#pragma unroll
                    for (int i = 0; i < 4; ++i) { const int off = 4 * C.lane + 256 * i; pxh[rr][i] = *(const h16x4*)(P_X + (size_t)row * D + off); pyv[rr][i] = *(const v2u*)(Y + (size_t)row * D + off); } }
            }
        }
        float hv[2][16];
#pragma unroll
        for (int rr = 0; rr < 2; ++rr) {
            const int row = row0 + l0 + rr; const int bi = row_bidx(row);
            if (bi != curb) { curb = bi; const float* md = P_mod + (size_t)(layer * 17 + bi) * 6144;
#pragma unroll
                for (int i = 0; i < 4; ++i) { const int off = 4 * C.lane + 256 * i; gt[i] = *(const f32x4*)(md + 2 * 1024 + off); sh[i] = *(const f32x4*)(md + 3 * 1024 + off); sc[i] = *(const f32x4*)(md + 4 * 1024 + off); } }
            f32x4 v[4]; float s = 0.f;
#pragma unroll
            for (int i = 0; i < 4; ++i) { v[i] = xv[rr][i] * ALPHA + gt[i] * bf4(yv[rr][i]); s += (v[i][0] + v[i][1]) + (v[i][2] + v[i][3]); }
            const float mean = wave_sum(s) * (1.0f / D); float s2 = 0.f;
#pragma unroll
            for (int i = 0; i < 4; ++i) { v[i] = v[i] - mean; s2 += (v[i][0] * v[i][0] + v[i][1] * v[i][1]) + (v[i][2] * v[i][2] + v[i][3] * v[i][3]); }
            const float rstd = __builtin_amdgcn_rsqf(wave_sum(s2) * (1.0f / D) + LN_EPS);
#pragma unroll
            for (int i = 0; i < 4; ++i) { const int off = 4 * C.lane + 256 * i;
                const f32x4 xn = v[i] * rstd * g1[i] + b1[i]; stx4(ap, row, off, xn, dry);
                const f32x4 h = xn * (1.0f + sc[i]) + sh[i];
                hv[rr][4 * i] = h[0]; hv[rr][4 * i + 1] = h[1]; hv[rr][4 * i + 2] = h[2]; hv[rr][4 * i + 3] = h[3];
                v2u w; w.x = pk2(h[0], h[1]); w.y = pk2(h[2], h[3]); gst8(dry ? (bf16*)(ap->ws + WS_R1 + 80 * MiB) : P_H, ((size_t)row * D + off) * 2, w); }
        }
        float glg[2][4];
#pragma unroll
        for (int o = 0; o < 4; ++o) { float a0 = 0.f, a1 = 0.f;
#pragma unroll
            for (int i = 0; i < 4; ++i) { const f32x4 w = *(const LAS f32x4*)(WrT + o * 1024 + ((4 * C.lane + 256 * i + 4 * o) & 1023));
                a0 += w[0] * hv[0][4 * i] + w[1] * hv[0][4 * i + 1] + w[2] * hv[0][4 * i + 2] + w[3] * hv[0][4 * i + 3];
                a1 += w[0] * hv[1][4 * i] + w[1] * hv[1][4 * i + 1] + w[2] * hv[1][4 * i + 2] + w[3] * hv[1][4 * i + 3]; }
            wave_sum2(a0, a1); glg[0][o] = a0; glg[1][o] = a1; }
#pragma unroll
        for (int rr = 0; rr < 2; ++rr) {
            const int row = row0 + l0 + rr;
            float gl[4];
#pragma unroll
            for (int g = 0; g < 4; ++g) gl[g] = glg[rr][g] + P_r_bg[layer * 4 + g];
            int gi = 0; float gm = gl[0];
#pragma unroll
            for (int g = 1; g < 4; ++g) if (gl[g] > gm) { gm = gl[g]; gi = g; }
            gi = __builtin_amdgcn_readfirstlane(gi);
            float gsum = 0.f;
#pragma unroll
            for (int g = 0; g < 4; ++g) gsum += __builtin_amdgcn_exp2f((gl[g] - gm) * LOG2E);
            const float gprob = __builtin_amdgcn_rcpf(gsum);
            float el[8];
#pragma unroll
            for (int q = 0; q < 8; q += 2) { float a = 0.f, c = 0.f; const int o = 4 + gi * 8 + q;
#pragma unroll
                for (int i = 0; i < 4; ++i) { const f32x4 w = *(const LAS f32x4*)(WrT + o * 1024 + ((4 * C.lane + 256 * i + 4 * o) & 1023)), w2 = *(const LAS f32x4*)(WrT + (o + 1) * 1024 + ((4 * C.lane + 256 * i + 4 * (o + 1)) & 1023));
                    a += w[0] * hv[rr][4 * i] + w[1] * hv[rr][4 * i + 1] + w[2] * hv[rr][4 * i + 2] + w[3] * hv[rr][4 * i + 3];
                    c += w2[0] * hv[rr][4 * i] + w2[1] * hv[rr][4 * i + 1] + w2[2] * hv[rr][4 * i + 2] + w2[3] * hv[rr][4 * i + 3]; }
                wave_sum2(a, c); el[q] = a + P_r_be[layer * 32 + gi * 8 + q]; el[q + 1] = c + P_r_be[layer * 32 + gi * 8 + q + 1]; }
            int i0 = 0; float v0 = el[0];
#pragma unroll
            for (int q = 1; q < 8; ++q) if (el[q] > v0) { v0 = el[q]; i0 = q; }
            int i1 = -1; float v1 = -3.0e38f;
#pragma unroll
            for (int q = 0; q < 8; ++q) if (q != i0 && el[q] > v1) { v1 = el[q]; i1 = q; }
            const float e1 = __builtin_amdgcn_exp2f((v1 - v0) * LOG2E), p0 = __builtin_amdgcn_rcpf(1.0f + e1), p1 = e1 * p0;
            if (C.lane == 0 && !dry) { const int lrow = l0 + rr;
                P_r_eid[row * 2] = gi * 8 + i0; P_r_eid[row * 2 + 1] = gi * 8 + i1; P_r_gate[row * 2] = p0 * gprob; P_r_gate[row * 2 + 1] = p1 * gprob;
                le[lrow * 2] = gi * 8 + i0; le[lrow * 2 + 1] = gi * 8 + i1; }
        }
    }
    __syncthreads();
    if (dry) return;
    const int nas = 2 * rpb;
    if (C.tid < nas) lr[C.tid] = __hip_atomic_fetch_add(&hist[le[C.tid]], 1, __ATOMIC_RELAXED, __HIP_MEMORY_SCOPE_WORKGROUP);
    __syncthreads();
    if (C.tid < 32) gbase[C.tid] = (int)__hip_atomic_fetch_add(P_ctl + CW_CNT + 64 * layer + C.tid, (unsigned)hist[C.tid], __ATOMIC_RELAXED, __HIP_MEMORY_SCOPE_AGENT);
    __syncthreads();
    if (C.tid < nas) { const int e = le[C.tid], rk = gbase[e] + lr[C.tid]; P_r_rank[row0 * 2 + C.tid] = rk; P_tokrow[(size_t)e * TOKCAP + rk] = row0 + (C.tid >> 1); }
}
__device__ __noinline__ int moe_offsets_impl(const GAS unsigned* cnts, LAS int* poffs, LAS int* tile_e, int tid) {
    if (tid < 64) {
        const int e = tid & 31; const int cnt = (int)cnts[e]; const int nt = (cnt + 255) >> 8;
        int incl = nt;
#pragma unroll
        for (int o = 1; o < 32; o <<= 1) { const int v = __shfl_up(incl, o, 32); if (e >= o) incl += v; }
        const int first = incl - nt;
        if (tid < 32) { poffs[e] = first * 256; if (e == 31) poffs[32] = incl * 256; tile_e[400 + e] = cnt;
#pragma nounroll
            for (int k = 0; k < nt; ++k) tile_e[first + k] = e; }
    }
    __syncthreads();
    return __builtin_amdgcn_readfirstlane(poffs[32]) >> 8;
}
__device__ __forceinline__ int moe_offsets(KArgs ap, Ctx& C, int layer, LAS int* poffs, LAS int* tile_e) { return __builtin_amdgcn_readfirstlane(moe_offsets_impl((const GAS unsigned*)(P_ctl + CW_CNT + 64 * layer), poffs, tile_e, C.tid)); }
__device__ __forceinline__ void moe_rows(KArgs ap, Ctx& C, int layer, const LAS int* poffs, const LAS int* tile_e, LAS int* rows, int ntiles) {
    if (C.tid < 256) {
        int val[5];
#pragma unroll
        for (int ui = 0; ui < 5; ++ui) { const int tile = ui * 64 + (C.bid & 7) * 8 + (C.bid >> 5); val[ui] = 0;
            if (tile < ntiles) { const int e = tile_e[tile], r = tile * 256 - poffs[e] + C.tid, cnt = tile_e[400 + e];
                if (r < cnt) val[ui] = P_tokrow[(size_t)e * TOKCAP + r]; } }
#pragma unroll
        for (int ui = 0; ui < 5; ++ui) { const int tile = ui * 64 + (C.bid & 7) * 8 + (C.bid >> 5); if (tile < ntiles) rows[ui * 256 + C.tid] = val[ui]; }
    }
    __syncthreads();
}
__device__ __forceinline__ void phase_ln2(KArgs ap, Ctx& C, int layer, bool last, int dry = 0) {
    LAS int* poffs = (LAS int*)(C.lds + LDS_MOE);
    const int nrows = last ? NLAT : MTOT, rpw = nrows / C.ngw, r0 = C.gw * rpw; const bf16* ys = P_R3;
    int ld0 = 0, ld1 = 0; float lg0 = 0.f, lg1 = 0.f;
    if (C.lane < rpw) { const int row = r0 + C.lane; ld0 = poffs[P_r_eid[row * 2]] + P_r_rank[row * 2]; ld1 = poffs[P_r_eid[row * 2 + 1]] + P_r_rank[row * 2 + 1]; lg0 = P_r_gate[row * 2]; lg1 = P_r_gate[row * 2 + 1]; }
#define LN2_OFF(j) (8 * C.lane + 512 * ((j) >> 1) + 4 * ((j) & 1))
    f32x4 g2[4], b2[4];
#pragma unroll
    for (int j = 0; j < 4; ++j) { g2[j] = *(const f32x4*)(P_ln2_g + layer * D + LN2_OFF(j)); b2[j] = *(const f32x4*)(P_ln2_b + layer * D + LN2_OFF(j)); }
    int curb = -1; f32x4 gt[4], sh[4], sc[4];
#pragma unroll
    for (int j = 0; j < 4; ++j) { gt[j] = (f32x4){0.f, 0.f, 0.f, 0.f}; sh[j] = gt[j]; sc[j] = gt[j]; }
    h16x8 px[2][2]; v4u pa[2][2], pb[2][2];
#pragma unroll
    for (int rr = 0; rr < 2; ++rr) { const int row = r0 + rr; const int d0 = __builtin_amdgcn_readlane(ld0, rr), d1 = __builtin_amdgcn_readlane(ld1, rr);
#pragma unroll
        for (int i = 0; i < 2; ++i) { const int off = 8 * C.lane + 512 * i; px[rr][i] = *(const h16x8*)(P_X + (size_t)row * D + off); pa[rr][i] = *(const v4u*)(ys + (size_t)d0 * D + off); pb[rr][i] = *(const v4u*)(ys + (size_t)d1 * D + off); } }
#pragma unroll 1
    for (int it = 0; it < rpw; it += 2) {
        f32x4 xv[2][4], ya[2][4], yb[2][4]; float gg[2][2];
#pragma unroll
        for (int rr = 0; rr < 2; ++rr) { gg[rr][0] = __builtin_bit_cast(float, __builtin_amdgcn_readlane(__builtin_bit_cast(int, lg0), it + rr)); gg[rr][1] = __builtin_bit_cast(float, __builtin_amdgcn_readlane(__builtin_bit_cast(int, lg1), it + rr));
#pragma unroll
            for (int i = 0; i < 2; ++i) {
                xv[rr][2 * i] = __builtin_convertvector(__builtin_shufflevector(px[rr][i], px[rr][i], 0, 1, 2, 3), f32x4); xv[rr][2 * i + 1] = __builtin_convertvector(__builtin_shufflevector(px[rr][i], px[rr][i], 4, 5, 6, 7), f32x4);
                ya[rr][2 * i] = bf4((v2u){pa[rr][i].x, pa[rr][i].y}); ya[rr][2 * i + 1] = bf4((v2u){pa[rr][i].z, pa[rr][i].w});
                yb[rr][2 * i] = bf4((v2u){pb[rr][i].x, pb[rr][i].y}); yb[rr][2 * i + 1] = bf4((v2u){pb[rr][i].z, pb[rr][i].w}); } }
        if (it + 2 < rpw) {
#pragma unroll
            for (int rr = 0; rr < 2; ++rr) { const int row = r0 + it + 2 + rr; const int d0 = __builtin_amdgcn_readlane(ld0, it + 2 + rr), d1 = __builtin_amdgcn_readlane(ld1, it + 2 + rr);
#pragma unroll
                for (int i = 0; i < 2; ++i) { const int off = 8 * C.lane + 512 * i; px[rr][i] = *(const h16x8*)(P_X + (size_t)row * D + off); pa[rr][i] = *(const v4u*)(ys + (size_t)d0 * D + off); pb[rr][i] = *(const v4u*)(ys + (size_t)d1 * D + off); } }
        }
#pragma unroll
        for (int rr = 0; rr < 2; ++rr) {
            const int row = r0 + it + rr; const int bi = row_bidx(row);
            if (bi != curb) { curb = bi; const float* md = P_mod + (size_t)(layer * 17 + bi) * 6144; const float* md2 = P_mod + (size_t)((layer + 1 < DEPTH ? layer + 1 : layer) * 17 + bi) * 6144;
#pragma unroll
                for (int j = 0; j < 4; ++j) { gt[j] = *(const f32x4*)(md + 5 * 1024 + LN2_OFF(j)); sh[j] = *(const f32x4*)(md2 + LN2_OFF(j)); sc[j] = *(const f32x4*)(md2 + 1024 + LN2_OFF(j)); } }
            f32x4 v[4]; float s = 0.f;
#pragma unroll
            for (int j = 0; j < 4; ++j) { v[j] = xv[rr][j] * ALPHA + gt[j] * (ya[rr][j] * gg[rr][0] + yb[rr][j] * gg[rr][1]); s += (v[j][0] + v[j][1]) + (v[j][2] + v[j][3]); }
            const float mean = wave_sum(s) * (1.0f / D); float s2 = 0.f;
#pragma unroll
            for (int j = 0; j < 4; ++j) { v[j] = v[j] - mean; s2 += (v[j][0] * v[j][0] + v[j][1] * v[j][1]) + (v[j][2] * v[j][2] + v[j][3] * v[j][3]); }
            const float rstd = __builtin_amdgcn_rsqf(wave_sum(s2) * (1.0f / D) + LN_EPS);
            f32x4 xn[4];
#pragma unroll
            for (int j = 0; j < 4; ++j) xn[j] = v[j] * rstd * g2[j] + b2[j];
            if (last) {
#pragma unroll
                for (int j = 0; j < 4; ++j) *(f32x4*)((dry ? (float*)(ap->ws + WS_R1) : P_out) + (size_t)row * D + LN2_OFF(j)) = xn[j];
            } else {
#pragma unroll
                for (int i = 0; i < 2; ++i) { const int off = 8 * C.lane + 512 * i;
                    const h16x4 xa = __builtin_convertvector(xn[2 * i], h16x4), xb = __builtin_convertvector(xn[2 * i + 1], h16x4);
                    gst16(dry ? (f16*)(ap->ws + WS_R1) : P_X, ((size_t)row * D + off) * 2, __builtin_bit_cast(v4u, __builtin_shufflevector(xa, xb, 0, 1, 2, 3, 4, 5, 6, 7)));
                    const f32x4 ha = xn[2 * i] * (1.0f + sc[2 * i]) + sh[2 * i], hb = xn[2 * i + 1] * (1.0f + sc[2 * i + 1]) + sh[2 * i + 1];
                    v4u w; w.x = pk2(ha[0], ha[1]); w.y = pk2(ha[2], ha[3]); w.z = pk2(hb[0], hb[1]); w.w = pk2(hb[2], hb[3]);
                    gst16(dry ? (bf16*)(ap->ws + WS_R1 + 80 * MiB) : P_H, ((size_t)row * D + off) * 2, w); }
            }
        }
    }
#undef LN2_OFF
}

__device__ __forceinline__ Ctx fresh(const Ctx& C) { Ctx R = C; const int ln = lane_id_fresh(); R.lane = ln; R.tid = C.wave * 64 + ln; return R; }
constexpr int NPH_LAYER = 8, NPHASES = 1 + DEPTH * NPH_LAYER;
__global__ void __launch_bounds__(512, 2) mk_fwd(Args args) {
    extern __shared__ __attribute__((aligned(16))) unsigned char lds_raw[];
    Ctx C;
    C.lds = (LAS unsigned char*)lds_raw; C.tid = threadIdx.x; C.lane = C.tid & 63; C.wave = __builtin_amdgcn_readfirstlane(C.tid >> 6); C.G = gridDim.x; C.bid = blockIdx.x;
    C.gw = C.bid * 8 + C.wave; C.ngw = C.G * 8;
    volatile LAS unsigned* MISC = (volatile LAS unsigned*)(C.lds + LDS_MISC);
    if (C.tid < 64) MISC[C.tid] = 0u;
    __syncthreads();
    const int lo = args.ph_lo, hi = args.ph_hi;
    XcdBarrier bar; { const KArgs ap = kargs(); bar.bar = P_ctl + CW_BAR; bar.x = 0; bar.st = nullptr; if (hi - lo > 1) bar = xcd_barrier_post(P_ctl + CW_BAR, MISC + 8); }
#ifndef PHMASK
#define PHMASK 0xFFFFFFFFu
#endif
#ifndef REP_GEMM
#define REP_GEMM 1
#endif
#ifndef REP_G3
#define REP_G3 REP_GEMM
#endif
#ifndef REP_G4
#define REP_G4 REP_GEMM
#endif
#ifndef REP_G8
#define REP_G8 REP_GEMM
#endif
#ifndef REP_G11
#define REP_G11 REP_GEMM
#endif
#ifndef REP_G12
#define REP_G12 REP_GEMM
#endif
#ifndef DRY_LN1
#define DRY_LN1 0
#endif
#ifndef DRY_LN2
#define DRY_LN2 0
#endif
#ifndef COLD_CONV
#define COLD_CONV 0
#endif
#ifndef NOSTORE_PROBE
#define NOSTORE_PROBE 0
#endif
#ifndef REP_ATTN
#define REP_ATTN 1
#endif
#ifndef REP_MEM
#define REP_MEM 1
#endif
#define REPEAT(n) _Pragma("nounroll") for (int rep_ = 0; rep_ < (n); ++rep_)
#define IN(k) (lo <= (k) && (k) < hi)
#define EN(b) ((PHMASK >> (b)) & 1u)
#define SEAM(k) do { if ((k) + 1 < hi) xcd_barrier(bar); } while (0)
    LAS unsigned char* ring = C.lds;

    if (IN(0)) { if (EN(0)) REPEAT(REP_MEM) { Ctx Cx = fresh(C); phase_mod(kargs(), Cx); __syncthreads(); } __syncthreads(); if (EN(1)) { Ctx Cx = fresh(C); convert_rest(kargs(), Cx, 0); } SEAM(0); }
#pragma nounroll
    for (int layer = 0; layer < DEPTH; ++layer) {
        const int base = 1 + NPH_LAYER * layer, kind = layer % 3, j = layer / 3; const bool last = layer == DEPTH - 1;
        const int nrows = last ? NLAT : MTOT;
        if (IN(base + 0)) { if (layer == 0) { Ctx Cx = fresh(C); if (EN(2)) REPEAT(REP_MEM) phase_hprep(kargs(), Cx); SEAM(base + 0); } }
        if (IN(base + 1)) {
            int fl_pre = -1, fl_post = -1; const int ftl = kind == 0 ? 160 : 64;
            { const int b_ = C.bid, odd = (b_ >> 3) & 1; int l1 = -1;
              if (kind == 0) { if (b_ >= 208) { fl_pre = 64 + 2 * (b_ - 208); fl_post = fl_pre + 1; } else if (b_ >= 144) l1 = b_ - 144; }
              else if (kind == 1) { if (b_ >= 192) l1 = b_ - 192; }
              else if (b_ >= 128 && b_ < 192) l1 = b_ - 128;
              if (l1 >= 0) { if (odd) fl_pre = l1; else fl_post = l1; } }
            if (EN(1) && fl_pre >= 0) { Ctx Cx = fresh(C); convert_fill(kargs(), Cx, layer, 0, fill_a(layer), fl_pre, 1, ftl); __syncthreads(); }
            if (kind != 1 && EN(3)) REPEAT(REP_G3) {
                const KArgs ap = kargs();
                const int nq = kind == 0 ? 1280 : 2048;
                pg8::Gemm g{P_H, P_WM_IN, MTOT, nq, D}; pg8::StaticOrder S; S.init(MTOT, nq, C.G, C.bid);
                pg8::EpiQK E{P_R1, P_R1 + (size_t)MTOT * D, kind == 0 ? P_rope : nullptr, kind == 0 ? 4 : 16, QSCALE};
                pg8::gemm_phase<pg8::EpiQK, pg8::StaticOrder, true, true>(ring, g, S, E, C.wave);
            }
            if (EN(4)) REPEAT(REP_G4) {
                const KArgs ap = kargs();
                pg8::Gemm g; pg8::StaticOrder S; pg8::EpiP<2> E;
                if (kind == 1) { g = pg8::Gemm{P_H, P_WM_IN, MTOT, 3072, D}; S.init(MTOT, 3072, C.G, C.bid); E = pg8::EpiP<2>{P_R1, P_R1 + (size_t)MTOT * D, D, -1, 1, 0}; }
                else { const int nq = kind == 0 ? 1280 : 2048, nv = kind == 0 ? 256 : 1024; g = pg8::Gemm{P_WM_IN + (size_t)nq * D, P_H, nv, MTOT, D}; S.init(nv, MTOT, C.G, kind == 2 ? C.G - 1 - C.bid : C.bid);     E = pg8::EpiP<2>{P_R1 + (size_t)2 * MTOT * D, nullptr, 0, -1, 0, kind == 0 ? 4 : 16}; }
                pg8::gemm_phase<pg8::EpiP<2>, pg8::StaticOrder, true, true>(ring, g, S, E, C.wave);
            }
            if (EN(1) && fl_post >= 0) { __syncthreads(); Ctx Cx = fresh(C); convert_fill(kargs(), Cx, layer, 0, fill_a(layer), fl_post, 1, ftl); }
            SEAM(base + 1);
        }
        if (IN(base + 2)) { Ctx Cx = fresh(C); if (kind == 0) { if (EN(5)) REPEAT(REP_ATTN) phase_attn<0>(kargs(), Cx, j, last); } else if (kind == 1) { if (EN(6)) REPEAT(REP_ATTN) phase_conv(kargs(), Cx, j, last); } else if (EN(7)) REPEAT(REP_ATTN) phase_attn<2>(kargs(), Cx, j, last); SEAM(base + 2); }
        if (IN(base + 3)) {
            if (!last && EN(1) && C.bid >= 64 && ((C.bid >> 3) & 1)) {
                Ctx Cx = fresh(C);
                convert_fill(kargs(), Cx, layer, fill_a(layer), fill_a(layer) + fill_b(layer), C.bid - 64, 1, 192);
                __syncthreads();
            }
            if (EN(8)) REPEAT(REP_G8) {
                const KArgs ap = kargs();
                pg8::Gemm g{P_R2, P_WM_O, nrows, D, D}; pg8::StaticOrder S; S.init(nrows, D, C.G, C.bid);
                pg8::EpiP<0> E{P_R3, nullptr, D, -1, 0, 0};
                if (NOSTORE_PROBE) { pg8::EpiP<9> E9{P_R3, nullptr, D, -1, 0, 0}; pg8::gemm_phase<pg8::EpiP<9>, pg8::StaticOrder, true, true>(ring, g, S, E9, C.wave); }
                pg8::gemm_phase<pg8::EpiP<0>, pg8::StaticOrder, true, true>(ring, g, S, E, C.wave);
            }
            if (!last && EN(1) && C.bid >= 64 && !((C.bid >> 3) & 1)) {
                __syncthreads(); Ctx Cx = fresh(C);
                convert_fill(kargs(), Cx, layer, fill_a(layer), fill_a(layer) + fill_b(layer), C.bid - 64, 1, 192);
            }
            SEAM(base + 3);
        }
        if (IN(base + 4)) { Ctx Cx = fresh(C); if (EN(9)) { if (DRY_LN1) { phase_ln1(kargs(), Cx, layer, last, 1); __syncthreads(); } phase_ln1(kargs(), Cx, layer, last); } SEAM(base + 4); }
        if (IN(base + 5)) {
            if (EN(11)) REPEAT(REP_G11) {
                const KArgs ap = kargs(); Ctx Cx = fresh(C);
                LAS int* poffs = (LAS int*)(C.lds + LDS_MOE); LAS int* tile_e = poffs + 64; LAS int* rows = poffs + 512;
                const int ntiles = moe_offsets(ap, Cx, layer, poffs, tile_e);
                moe_rows(ap, Cx, layer, poffs, tile_e, rows, ntiles);
                pg8::Gemm g{P_H, P_W1, MTOT, NEXP * 1024, D}; pg8::MoeOrder S{(const LAS int*)tile_e, (const LAS int*)rows, ntiles, C.bid};
                pg8::EpiP<1> E{P_R2, nullptr, EFF, 3, 0, 0};
                pg8::gemm_phase<pg8::EpiP<1>, pg8::MoeOrder, true, true, true>(ring, g, S, E, C.wave);
            }
            SEAM(base + 5);
        }
        if (IN(base + 6)) {
            if (EN(12)) REPEAT(REP_G12) {
                const KArgs ap = kargs(); Ctx Cx = fresh(C);
                LAS int* poffs = (LAS int*)(C.lds + LDS_MOE); LAS int* tile_e = poffs + 64;
                const int ntiles = __builtin_amdgcn_readfirstlane(poffs[32]) >> 8;
                pg8::Gemm g{P_R2, P_W2, ntiles * 256, NEXP * 1024, EFF}; pg8::MoeOrder S{(const LAS int*)tile_e, (const LAS int*)tile_e, ntiles, C.bid};
                pg8::EpiP<0> E{P_R3, nullptr, D, 3, 0, 0};
                pg8::gemm_phase<pg8::EpiP<0>, pg8::MoeOrder, true, true, false, true>(ring, g, S, E, C.wave);
            }
            SEAM(base + 6);
        }
        if (IN(base + 7)) { Ctx Cx = fresh(C); if (EN(13)) { if (DRY_LN2) { phase_ln2(kargs(), Cx, layer, last, 1); __syncthreads(); } phase_ln2(kargs(), Cx, layer, last); } if (!last && EN(1)) { __syncthreads(); convert_rest(kargs(), Cx, layer + 1); } SEAM(base + 7); }
    }
#undef IN
#undef SEAM
}

#ifndef MK_ONE_LAUNCH
#define MK_ONE_LAUNCH 1
#endif
extern "C" void kernel_launch(void* const* d_in, const int* in_sizes, int n_in, void* d_out, int out_size, void* d_ws, size_t ws_size, hipStream_t stream) {
    static int grid = 0;
    if (grid == 0) {
        if (n_in != 26 || in_sizes[0] != NLAT * D || out_size != NLAT * D || ws_size < WS_END) { fprintf(stderr, "kernel_launch: unexpected shapes (n_in %d, in0 %d, out %d, ws %zu < %zu); nothing launched\n", n_in, n_in > 0 ? in_sizes[0] : -1, out_size, ws_size, (size_t)WS_END); grid = -1; return; }
        int dev = 0, cus = 0, per_cu = 0;
        if (hipGetDevice(&dev) != hipSuccess || hipDeviceGetAttribute(&cus, hipDeviceAttributeMultiprocessorCount, dev) != hipSuccess) { fprintf(stderr, "kernel_launch: device query failed\n"); grid = -1; return; }
        if (hipFuncSetAttribute((const void*)mk_fwd, hipFuncAttributeMaxDynamicSharedMemorySize, LDS_BYTES) != hipSuccess) { fprintf(stderr, "kernel_launch: hipFuncSetAttribute failed\n"); grid = -1; return; }
        if (hipOccupancyMaxActiveBlocksPerMultiprocessor(&per_cu, (const void*)mk_fwd, 512, LDS_BYTES) != hipSuccess || per_cu < 1) { fprintf(stderr, "kernel_launch: occupancy query reports %d workgroups per CU\n", per_cu); }
        (void)hipGetLastError();
        grid = 256;
        if (cus < 256) { fprintf(stderr, "kernel_launch: %d CUs < 256: the grid would not be resident; nothing launched\n", cus); grid = -1; return; }
    }
    if (grid < 0) return;
    if (hipMemsetAsync((char*)d_ws + WS_CTL, 0, CTL_ZERO_BYTES, stream) != hipSuccess) { fprintf(stderr, "kernel_launch: hipMemsetAsync failed\n"); return; }
    Args a{};
    for (int i = 0; i < 26; ++i) a.in[i] = (const float*)d_in[i];
    a.out = (float*)d_out; a.ws = (unsigned char*)d_ws;
#if MK_ONE_LAUNCH
    a.ph_lo = 0; a.ph_hi = NPHASES;
    hipLaunchKernelGGL(mk_fwd, dim3(grid), dim3(512), LDS_BYTES, stream, a);
#else
    for (int p = 0; p < NPHASES; ++p) { a.ph_lo = p; a.ph_hi = p + 1; hipLaunchKernelGGL(mk_fwd, dim3(grid), dim3(512), LDS_BYTES, stream, a); }
#endif
    const hipError_t le = hipPeekAtLastError();
    if (le != hipSuccess) fprintf(stderr, "kernel_launch: launch failed: %s\n", hipGetErrorName(le));
}
```
